# Optimizing an MI355X kernel written in HIP

```python
import jax, jax.numpy as jnp
from jax import lax
import numpy as np

D_MODEL = 1024
BATCH = 8
SEQ = 2048
DEPTH = 4

HEAD_DIM = 64
GRID_W = 64
Q_BLOCK = 128
EPS = 1e-6
NEG_BIG = -1e30
F_MIN = 1e-6
A_HEADS = 6
A_KV_HEADS = 2
ROPE_THETA = 10000.0
B_HEADS = 4
B_KEY_DIM = 64
B_CHUNK = 64
C_HEADS = 6
C_KV_HEADS = 2
C_BRANCHES = ((128, 1), (512, 4), (2048, 16))
D_FF = 2816
CONV_W = 3

A_W = A_HEADS * HEAD_DIM
B_W = B_HEADS * HEAD_DIM
B_K = B_HEADS * B_KEY_DIM
C_W = C_HEADS * HEAD_DIM
MIX_W = A_W + B_W + C_W
SPLITS = (A_W, A_KV_HEADS * HEAD_DIM, A_KV_HEADS * HEAD_DIM,
          B_K, B_K, B_K, B_W, B_W,
          C_W, C_KV_HEADS * HEAD_DIM, C_KV_HEADS * HEAD_DIM)
IN_W = sum(SPLITS)

kernel_name = "hybrid_parallel_rope_hgrn2_dilated_encoder"


def rms_norm(x, g):
    xf = x.astype(jnp.float32)
    y = xf * lax.rsqrt(jnp.mean(xf * xf, axis=-1, keepdims=True) + EPS)
    return (y * g.astype(jnp.float32)).astype(x.dtype)


def _rope_half(x, cos, sin):
    h = x.shape[-1] // 2
    x1, x2 = x[..., :h], x[..., h:]
    return jnp.concatenate([x1 * cos - x2 * sin, x2 * cos + x1 * sin], axis=-1)


def axial_rope(x):
    S = x.shape[1]
    n_rows = S // GRID_W
    row = jnp.repeat(jnp.arange(n_rows), GRID_W).astype(jnp.float32)
    col = jnp.tile(jnp.arange(GRID_W), n_rows).astype(jnp.float32)
    half = HEAD_DIM // 2
    inv = ROPE_THETA ** (-jnp.arange(0, half, 2, dtype=jnp.float32) / half)
    ang_r = (row[:, None] * inv)[:, None, :]
    ang_c = (col[:, None] * inv)[:, None, :]
    xf = x.astype(jnp.float32)
    xr = _rope_half(xf[..., :half], jnp.cos(ang_r), jnp.sin(ang_r))
    xc = _rope_half(xf[..., half:], jnp.cos(ang_c), jnp.sin(ang_c))
    return jnp.concatenate([xr, xc], axis=-1).astype(x.dtype)


def _to_query_blocks(q, n_kv):
    B_, S, H, D = q.shape
    nb = S // Q_BLOCK
    return q.reshape(B_, nb, Q_BLOCK, n_kv, H // n_kv, D).transpose(1, 0, 3, 4, 2, 5)


def _from_query_blocks(o):
    nb, B_, hk, g, qb, d = o.shape
    return o.transpose(1, 0, 4, 2, 3, 5).reshape(B_, nb * qb, hk * g * d)


def mixer_a(q, k, v, gq, gk):
    q = axial_rope(rms_norm(q, gq))
    k = axial_rope(rms_norm(k, gk))
    qb = _to_query_blocks(q, A_KV_HEADS)
    kt = k.transpose(0, 2, 1, 3)
    vt = v.transpose(0, 2, 1, 3)
    scale = HEAD_DIM ** -0.5

    def block(qi):
        s = jnp.einsum('bhgqd,bhkd->bhgqk', qi, kt).astype(jnp.float32) * scale
        p = jax.nn.softmax(s, axis=-1).astype(vt.dtype)
        return jnp.einsum('bhgqk,bhkd->bhgqd', p, vt)

    return _from_query_blocks(lax.map(block, qb))


def mixer_c(q, k, v, gq, gk):
    S = q.shape[1]
    q = rms_norm(q, gq)
    k = rms_norm(k, gk)
    qb = _to_query_blocks(q, C_KV_HEADS)
    kt = k.transpose(0, 2, 1, 3)
    vt = v.transpose(0, 2, 1, 3)
    nb = S // Q_BLOCK
    starts = jnp.arange(nb) * Q_BLOCK
    scale = HEAD_DIM ** -0.5
    slopes = (2.0 ** (-8.0 * np.arange(1, C_HEADS + 1) / C_HEADS)).astype(np.float32)
    slopes = jnp.asarray(slopes).reshape(C_KV_HEADS, C_HEADS // C_KV_HEADS, 1, 1)
    offsets = [r * np.arange(-(w // (2 * r)), w // (2 * r) + 1) for (w, r) in C_BRANCHES]

    def block(args):
        qi, t0 = args
        t = t0 + jnp.arange(Q_BLOCK)
        lses, outs = [], []
        for off in offsets:
            idx = t[:, None] + jnp.asarray(off)[None, :]
            valid = (idx >= 0) & (idx < S)
            idx = jnp.clip(idx, 0, S - 1)
            kg = kt[:, :, idx, :]
            vg = vt[:, :, idx, :]
            dist = jnp.asarray(np.abs(off).astype(np.float32))
            s = jnp.einsum('bhgqd,bhqkd->bhgqk', qi, kg).astype(jnp.float32) * scale - slopes * dist
            s = jnp.where(valid, s, NEG_BIG)
            lse = jax.nn.logsumexp(s, axis=-1)
            p = jnp.exp(s - lse[..., None]).astype(vg.dtype)
            outs.append(jnp.einsum('bhgqk,bhqkd->bhgqd', p, vg).astype(jnp.float32))
            lses.append(lse)
        w = jax.nn.softmax(jnp.stack(lses, axis=0), axis=0)
        o = jnp.einsum('nbhgq,nbhgqd->bhgqd', w, jnp.stack(outs, axis=0))
        return o.astype(qi.dtype)

    return _from_query_blocks(lax.map(block, (qb, starts)))


def hgrn2_scan(q, k, v, logf):
    B_, S, H, dk = q.shape
    dv = v.shape[-1]
    nc = S // B_CHUNK

    def to_chunks(a):
        return a.astype(jnp.float32).reshape(B_, nc, B_CHUNK, H, a.shape[-1]).transpose(1, 0, 3, 2, 4)

    qc, kc, vc, lc = to_chunks(q), to_chunks(k), to_chunks(v), to_chunks(logf)
    mask = jnp.tril(jnp.ones((B_CHUNK, B_CHUNK), dtype=bool))[:, :, None]

    def step(state, inp):
        q_, k_, v_, l_ = inp
        b = jnp.cumsum(l_, axis=2)
        o_inter = jnp.einsum('bhtk,bhkv->bhtv', q_ * jnp.exp(b), state)
        diff = b[:, :, :, None, :] - b[:, :, None, :, :]
        dec = jnp.where(mask, jnp.exp(jnp.where(mask, diff, 0.0)), 0.0)
        attn = jnp.einsum('bhtk,bhsk,bhtsk->bhts', q_, k_, dec)
        o_intra = jnp.einsum('bhts,bhsv->bhtv', attn, v_)
        b_last = b[:, :, -1:, :]
        new_state = jnp.exp(b_last[:, :, 0, :])[..., None] * state + \
            jnp.einsum('bhsk,bhsv->bhkv', k_ * jnp.exp(b_last - b), v_)
        return new_state, o_inter + o_intra

    state0 = jnp.zeros((B_, H, dk, dv), jnp.float32)
    _, o = lax.scan(step, state0, (qc, kc, vc, lc))
    return o.transpose(1, 0, 3, 2, 4).reshape(B_, S, H, dv).astype(v.dtype)


def mixer_b(q, f_fwd, f_bwd, i, g, lb_fwd, lb_bwd, g_norm):
    def log_forget(fpre, lb):
        lb = lb.reshape(B_HEADS, B_KEY_DIM)
        f = lb + (1.0 - lb) * jax.nn.sigmoid(fpre.astype(jnp.float32))
        return jnp.log(jnp.maximum(f, F_MIN))

    lff = log_forget(f_fwd, lb_fwd)
    lfb = log_forget(f_bwd, lb_bwd)
    o_f = hgrn2_scan(q, -jnp.expm1(lff), i, lff)
    flip = lambda a: jnp.flip(a, axis=1)
    o_b = flip(hgrn2_scan(flip(q), flip(-jnp.expm1(lfb)), flip(i), flip(lfb)))
    o = rms_norm(o_f + o_b, g_norm) * jax.nn.silu(g)
    return o.reshape(o.shape[0], o.shape[1], B_W)


def conv_ffn(h, w_up, conv_w, conv_b, w_down):
    u = h @ w_up
    up = jnp.pad(u, ((0, 0), (1, 1), (0, 0)))
    u = conv_w[0] * up[:, :-2] + conv_w[1] * up[:, 1:-1] + conv_w[2] * up[:, 2:] + conv_b
    a, b = jnp.split(u, 2, axis=-1)
    return (jax.nn.silu(a) * b) @ w_down


def setup_inputs(seed: int = 0) -> dict:
    key = jax.random.key(seed)
    ks = jax.random.split(key, 20)
    nrm = lambda k, shape, s: jax.random.normal(k, shape, jnp.float32) * s
    return {
        "x": nrm(ks[0], (BATCH, SEQ, D_MODEL), 1.0),
        "c": nrm(ks[1], (BATCH, D_MODEL), 1.0),
        "w_ada": nrm(ks[2], (DEPTH, D_MODEL, 6 * D_MODEL), D_MODEL ** -0.5),
        "b_ada": nrm(ks[3], (DEPTH, 6 * D_MODEL), 0.01),
        "norm_g": 1.0 + nrm(ks[4], (DEPTH, 2, D_MODEL), 0.01),
        "w_in": nrm(ks[5], (DEPTH, D_MODEL, IN_W), D_MODEL ** -0.5),
        "a_q_norm": 1.0 + nrm(ks[6], (DEPTH, HEAD_DIM), 0.01),
        "a_k_norm": 1.0 + nrm(ks[7], (DEPTH, HEAD_DIM), 0.01),
        "b_lb": nrm(ks[8], (2, DEPTH, B_K), 0.5),
        "b_out_norm": 1.0 + nrm(ks[9], (DEPTH, HEAD_DIM), 0.01),
        "c_q_norm": 1.0 + nrm(ks[10], (DEPTH, HEAD_DIM), 0.01),
        "c_k_norm": 1.0 + nrm(ks[11], (DEPTH, HEAD_DIM), 0.01),
        "w_out": nrm(ks[12], (DEPTH, MIX_W, D_MODEL), MIX_W ** -0.5),
        "w_up": nrm(ks[13], (DEPTH, D_MODEL, 2 * D_FF), D_MODEL ** -0.5),
        "conv_w": nrm(ks[14], (DEPTH, CONV_W, 2 * D_FF), CONV_W ** -0.5),
        "conv_b": nrm(ks[15], (DEPTH, 2 * D_FF), 0.01),
        "w_down": nrm(ks[16], (DEPTH, D_FF, D_MODEL), D_FF ** -0.5),
    }


def reference(x, c, w_ada, b_ada, norm_g, w_in, a_q_norm, a_k_norm, b_lb, b_out_norm,
              c_q_norm, c_k_norm, w_out, w_up, conv_w, conv_b, w_down):
    B_, S, _ = x.shape
    sm = jax.nn.softmax(b_lb.astype(jnp.float32), axis=1)
    lb_all = jnp.cumsum(sm, axis=1) - sm[:, :1]
    split_idx = np.cumsum(SPLITS)[:-1].tolist()
    for l in range(DEPTH):
        mod = jax.nn.silu(c) @ w_ada[l] + b_ada[l]
        sh1, sc1, g1, sh2, sc2, g2 = jnp.split(mod[:, None, :], 6, axis=-1)
        h = rms_norm(x, norm_g[l, 0]) * (1.0 + sc1) + sh1
        parts = jnp.split(h @ w_in[l], split_idx, axis=-1)
        hd = lambda a, n: a.reshape(B_, S, n, a.shape[-1] // n)
        aq, ak, av, bq, bff, bfb, bi, bg, cq, ck, cv = parts
        o_a = mixer_a(hd(aq, A_HEADS), hd(ak, A_KV_HEADS), hd(av, A_KV_HEADS), a_q_norm[l], a_k_norm[l])
        o_b = mixer_b(hd(bq, B_HEADS), hd(bff, B_HEADS), hd(bfb, B_HEADS), hd(bi, B_HEADS), hd(bg, B_HEADS),
                      lb_all[0, l], lb_all[1, l], b_out_norm[l])
        o_c = mixer_c(hd(cq, C_HEADS), hd(ck, C_KV_HEADS), hd(cv, C_KV_HEADS), c_q_norm[l], c_k_norm[l])
        mix = jnp.concatenate([o_a, o_b, o_c], axis=-1) @ w_out[l]
        x = x + g1 * mix
        h = rms_norm(x, norm_g[l, 1]) * (1.0 + sc2) + sh2
        x = x + g2 * conv_ffn(h, w_up[l], conv_w[l], conv_b[l], w_down[l])
    return x
```

```cpp
#include <hip/hip_runtime.h>
#include <hip/hip_cooperative_groups.h>
#include <cstdio>
#include <cstdint>
namespace cg = cooperative_groups;

#ifndef PROBE_DUP
#define PROBE_DUP 0
#endif
#ifndef MK_ONE_LAUNCH
#define MK_ONE_LAUNCH 1
#endif

#define LAS __attribute__((address_space(3)))
typedef unsigned short bf16_t;
typedef short bf16x8 __attribute__((ext_vector_type(8)));
typedef float f32x4 __attribute__((ext_vector_type(4)));
typedef float f32x16 __attribute__((ext_vector_type(16)));
typedef unsigned u32x4 __attribute__((ext_vector_type(4)));
typedef unsigned u32x2 __attribute__((ext_vector_type(2)));
typedef LAS unsigned char lds_u8;

constexpr int NB = 8, SEQ = 2048, DM = 1024, M = NB * SEQ, DEPTH = 4, INW = 2560, FF = 2816, UPW = 2 * FF;
constexpr float EPS = 1e-6f;
constexpr int C_AQ = 0, C_AK = 384, C_AV = 512, C_BQ = 640, C_BFF = 896, C_BFB = 1152, C_BI = 1408, C_BG = 1664, C_CQ = 1920, C_CK = 2304, C_CV = 2432;

constexpr size_t MiB = 1u << 20;
constexpr size_t WS_CTL = 0;
constexpr size_t WS_MOD = 1 * MiB;
constexpr size_t WS_ROPE = 2 * MiB;
constexpr size_t WS_WIN = 4 * MiB;
constexpr size_t WS_WOUT = 24 * MiB;
constexpr size_t WS_WUP = 32 * MiB;
constexpr size_t WS_WDN = 76 * MiB;
constexpr size_t WS_H = 98 * MiB;
constexpr size_t WS_PROJ = 130 * MiB;
constexpr size_t WS_MIX = 210 * MiB;
constexpr size_t WS_HL = 242 * MiB;
constexpr size_t WS_HD = 274 * MiB;
constexpr size_t WS_VT = 275 * MiB;
constexpr size_t WS_ACT = 190 * MiB;
constexpr size_t WS_HS = 283 * MiB;
constexpr size_t WS_PO = 300 * MiB;
constexpr size_t WS_PL = 326 * MiB;
constexpr size_t WS_XB = 332 * MiB;
constexpr size_t WS_U = 330 * MiB;
constexpr size_t WS_END = 366 * MiB;

constexpr int LDS_BYTES = 147456;
constexpr int NTHREADS = 512;

typedef float f32x2_t __attribute__((ext_vector_type(2))); typedef __bf16 bf16x2_t __attribute__((ext_vector_type(2)));
__device__ __forceinline__ unsigned pk2(float lo, float hi) { f32x2_t v = {lo, hi}; bf16x2_t b = __builtin_convertvector(v, bf16x2_t); return __builtin_bit_cast(unsigned, b); }
__device__ __forceinline__ unsigned f2bf(float f) { return pk2(f, 0.f) & 0xffffu; }
__device__ __forceinline__ float bf2f(unsigned short h) { return __builtin_bit_cast(float, (unsigned)h << 16); }
__device__ __forceinline__ float bflo(unsigned w) { return __builtin_bit_cast(float, w << 16); }
__device__ __forceinline__ float bfhi(unsigned w) { return __builtin_bit_cast(float, w & 0xffff0000u); }
__device__ __forceinline__ float wave_sum(float v) {
#pragma unroll
    for (int o = 1; o < 64; o <<= 1) v += __shfl_xor(v, o);
    return v;
}
__device__ __forceinline__ float fast_exp2(float x) { return __builtin_amdgcn_exp2f(x); }
__device__ __forceinline__ float fast_exp(float x) { return __builtin_amdgcn_exp2f(x * 1.4426950408889634f); }
__device__ __forceinline__ float silu_f(float x) { return x * __builtin_amdgcn_rcpf(1.0f + fast_exp2(-1.4426950408889634f * x)); }

__device__ __forceinline__ float dpp_ror1(float v) { return __builtin_bit_cast(float, __builtin_amdgcn_update_dpp(0, __builtin_bit_cast(int, v), 0x121, 0xf, 0xf, true)); }
__device__ __forceinline__ float dpp_ror15(float v) { return __builtin_bit_cast(float, __builtin_amdgcn_update_dpp(0, __builtin_bit_cast(int, v), 0x12f, 0xf, 0xf, true)); }
__device__ __forceinline__ float dpp_shr1(float old, float v) { return __builtin_bit_cast(float, __builtin_amdgcn_update_dpp(__builtin_bit_cast(int, old), __builtin_bit_cast(int, v), 0x111, 0xf, 0xf, false)); }
__device__ __forceinline__ float dpp_shl1(float old, float v) { return __builtin_bit_cast(float, __builtin_amdgcn_update_dpp(__builtin_bit_cast(int, old), __builtin_bit_cast(int, v), 0x101, 0xf, 0xf, false)); }

namespace pg8 {
constexpr int BM = 256, BK = 64, HALF = 128, HTB = HALF * BK * 2, STAGE_BYTES = 8 * HTB, NXCD = 8, WGM = 8;
__host__ __device__ __forceinline__ int lds_byte(int r, int c) { const int st = (r >> 4) * 2 + (c >> 5), rr = r & 15, cc = c & 31, ob = rr * 64 + cc * 2; return st * 1024 + (ob ^ (((ob >> 9) & 1) << 5)); }
__host__ __device__ __forceinline__ void stage_rc(int b, int& R, int& C) { const int st = b / 1024, sb = b % 1024, swz = sb ^ (((sb >> 9) & 1) << 5); R = (st >> 1) * 16 + swz / 64; C = (st & 1) * 32 + (swz % 64) / 2; }
__host__ __device__ __forceinline__ int perm32(int rho) { const int n = rho >> 4, i = rho & 15; return 8 * (i >> 2) + 4 * n + (i & 3); }

struct Unit { int pm, pn, ar; };
struct Gemm { const bf16_t* A; const bf16_t* Bt; int M, N, K; };

struct StaticOrder {
    int nM, nN, nwg, G, c, conv, Mrows;
    __host__ __device__ void init(int M_, int N_, int G_, int c_, int conv_ = 0) { conv = conv_; Mrows = M_; nM = conv_ ? (M_ + 253) / 254 : M_ / BM; nN = N_ / BM; nwg = nM * nN; G = G_; c = c_; }
    __host__ __device__ bool next(int i, Unit& u) const {
        const long L = (long)i * G + c; if (L >= nwg) return false;
        int wgid = (int)L; { const int q = nwg / NXCD, r = nwg % NXCD, xcd = wgid % NXCD, off = wgid / NXCD; wgid = (xcd < r ? xcd * (q + 1) : r * (q + 1) + (xcd - r) * q) + off; }
        const int nig = WGM * nN, gid = wgid / nig, fm = gid * WGM, gsz = (nM - fm) < WGM ? (nM - fm) : WGM;
        u.pm = fm + ((wgid % nig) % gsz); u.pn = (wgid % nig) / gsz;
        if (conv) { int s = 254 * u.pm - 1; s = s < 0 ? 0 : s; u.ar = s > Mrows - BM ? Mrows - BM : s; } else u.ar = u.pm * BM;
        return true;
    }
};

struct EpiStore {
    static constexpr bool PERM = true;
    bf16_t* O; int ldc;
    __device__ __forceinline__ void operator()(const f32x4 (&acc)[2][2][4][2], const Unit& u, int wr, int wc, int fr, int fq, lds_u8*) const {
        const int row0 = u.pm * BM + wr * 64 + fr, col0 = u.pn * BM + wc * 32 + 8 * fq;
#pragma unroll
        for (int ai = 0; ai < 2; ++ai)
#pragma unroll
            for (int m = 0; m < 4; ++m) { bf16_t* rowp = O + (size_t)(row0 + ai * HALF + m * 16) * ldc + col0;
#pragma unroll
                for (int bj = 0; bj < 2; ++bj) { const f32x4 v0 = acc[ai][bj][m][0], v1 = acc[ai][bj][m][1];
                    u32x4 w; w.x = pk2(v0[0], v0[1]); w.y = pk2(v0[2], v0[3]); w.z = pk2(v1[0], v1[1]); w.w = pk2(v1[2], v1[3]);
                    *(u32x4*)(rowp + bj * HALF) = w; } }
    }
};
struct EpiResid {
    static constexpr bool PERM = true;
    unsigned char* ws; const float* xin32; float* out32; const float* normg;
    int l, second, nfuse;
    __device__ __forceinline__ void operator()(f32x4 (&acc)[2][2][4][2], const Unit& u, int wr, int wc, int fr, int fq, lds_u8* lds) const {
        const int col0 = u.pn * BM + wc * 32 + 8 * fq;
        const int bidx = (u.pm * BM) / SEQ;
        bf16_t* const xb16 = (bf16_t*)(ws + WS_XB);
        const float* const modl = (const float*)(ws + WS_MOD) + (size_t)l * 8 * 6144;
        const float* const gate = modl + (second ? 5 : 2) * DM;
        const float* const ng = normg + (size_t)(second ? (l + 1) * 2 : l * 2 + 1) * DM;
        const float* const nmod = second ? modl + 8 * 6144 : modl + 3 * DM;
        const int nidx = nfuse ? l * 2 + second : -1;
        const float* gb = gate + (size_t)bidx * 6144 + col0;
        f32x4 gv[2][2];
#pragma unroll
        for (int bj = 0; bj < 2; ++bj)
#pragma unroll
            for (int n = 0; n < 2; ++n) gv[bj][n] = *(const f32x4*)(gb + bj * HALF + 4 * n);
#pragma unroll
        for (int ai = 0; ai < 2; ++ai)
#pragma unroll
            for (int m = 0; m < 4; ++m) { const size_t off = (size_t)(u.pm * BM + ai * HALF + wr * 64 + m * 16 + fr) * DM + col0;
#pragma unroll
                for (int bj = 0; bj < 2; ++bj) {
                    f32x4 x0, x1;
                    if (xin32) { x0 = *(const f32x4*)(xin32 + off + bj * HALF); x1 = *(const f32x4*)(xin32 + off + bj * HALF + 4); }
                    else { const u32x4 w = *(const u32x4*)(xb16 + off + bj * HALF); x0 = (f32x4){bflo(w.x), bfhi(w.x), bflo(w.y), bfhi(w.y)}; x1 = (f32x4){bflo(w.z), bfhi(w.z), bflo(w.w), bfhi(w.w)}; }
                    const f32x4 y0 = x0 + gv[bj][0] * acc[ai][bj][m][0], y1 = x1 + gv[bj][1] * acc[ai][bj][m][1];
                    acc[ai][bj][m][0] = y0; acc[ai][bj][m][1] = y1;
                    if (out32) { *(f32x4*)(out32 + off + bj * HALF) = y0; *(f32x4*)(out32 + off + bj * HALF + 4) = y1; }
                    else { u32x4 w; w.x = pk2(y0[0], y0[1]); w.y = pk2(y0[2], y0[3]); w.z = pk2(y1[0], y1[1]); w.w = pk2(y1[2], y1[3]); *(u32x4*)(xb16 + off + bj * HALF) = w; }
                } }
        if (nidx < 0) return;
        asm volatile("" : "+v"(fr), "+v"(fq));
        bf16_t* const hn = (bf16_t*)(ws + WS_H); float* const slots = (float*)(ws + WS_CTL + 512 * 1024); unsigned* const cnt = (unsigned*)(ws + WS_CTL) + 8192 + nidx * 1024;
        LAS float* P = (LAS float*)(lds + STAGE_BYTES);
        LAS float* S = P + 1024;
#pragma unroll
        for (int ai = 0; ai < 2; ++ai)
#pragma unroll
            for (int m = 0; m < 4; ++m) { float s = 0.f;
#pragma unroll
                for (int bj = 0; bj < 2; ++bj)
#pragma unroll
                    for (int n = 0; n < 2; ++n) { const f32x4 v = acc[ai][bj][m][n]; s += (v[0] * v[0] + v[1] * v[1]) + (v[2] * v[2] + v[3] * v[3]); }
                s += __shfl_xor(s, 16); s += __shfl_xor(s, 32);
                if (fq == 0) P[(ai * HALF + wr * 64 + m * 16 + fr) * 4 + wc] = s; }
        asm volatile("s_waitcnt lgkmcnt(0)" ::: "memory"); __builtin_amdgcn_s_barrier(); asm volatile("" ::: "memory");
        const int tid = (wr * 4 + wc) * 64 + fr + 16 * fq;
        unsigned* slot_u = (unsigned*)slots + ((size_t)u.pm * BM) * 4;
        if (tid < 256) { const float t = (P[tid * 4] + P[tid * 4 + 1]) + (P[tid * 4 + 2] + P[tid * 4 + 3]);
            __hip_atomic_store(slot_u + tid * 4 + u.pn, __builtin_bit_cast(unsigned, t), __ATOMIC_RELAXED, __HIP_MEMORY_SCOPE_AGENT); }
        asm volatile("s_waitcnt vmcnt(0)" ::: "memory"); __builtin_amdgcn_s_barrier(); asm volatile("" ::: "memory");
        if (tid == 0) {
            unsigned* c = cnt + u.pm * 16;
            __builtin_amdgcn_fence(__ATOMIC_RELEASE, "agent");
            asm volatile("s_waitcnt vmcnt(0)" ::: "memory");
            (void)__hip_atomic_fetch_add(c, 1u, __ATOMIC_RELAXED, __HIP_MEMORY_SCOPE_AGENT);
            unsigned sp = 0u;
            while (__hip_atomic_load(c, __ATOMIC_RELAXED, __HIP_MEMORY_SCOPE_AGENT) < 4u) { __builtin_amdgcn_s_sleep(1); if (++sp > (1u << 22)) break; }
            __builtin_amdgcn_fence(__ATOMIC_ACQUIRE, "agent");
            asm volatile("s_waitcnt vmcnt(0)" ::: "memory");
        }
        __builtin_amdgcn_s_barrier(); asm volatile("" ::: "memory");
        if (tid < 256) { float t = 0.f;
#pragma unroll
            for (int p = 0; p < 4; ++p) t += __builtin_bit_cast(float, __hip_atomic_load(slot_u + tid * 4 + p, __ATOMIC_RELAXED, __HIP_MEMORY_SCOPE_AGENT));
            S[tid] = rsqrtf(t * (1.f / DM) + EPS); }
        asm volatile("s_waitcnt lgkmcnt(0)" ::: "memory"); __builtin_amdgcn_s_barrier(); asm volatile("" ::: "memory");
        const float* shp = nmod + (size_t)bidx * 6144 + col0; const float* scp = shp + DM; const float* gp = ng + col0;
#pragma unroll
        for (int bj = 0; bj < 2; ++bj)
#pragma unroll
            for (int n = 0; n < 2; ++n) {
                const f32x4 gn = *(const f32x4*)(gp + bj * HALF + 4 * n) * (*(const f32x4*)(scp + bj * HALF + 4 * n) + 1.0f), sn = *(const f32x4*)(shp + bj * HALF + 4 * n);
#pragma unroll
                for (int ai = 0; ai < 2; ++ai)
#pragma unroll
                    for (int m = 0; m < 4; ++m) { const int rl = ai * HALF + wr * 64 + m * 16 + fr; const float rstd = S[rl];
                        const f32x4 h0 = acc[ai][bj][m][n] * rstd * gn + sn;
                        u32x2 w; w.x = pk2(h0[0], h0[1]); w.y = pk2(h0[2], h0[3]);
                        *(u32x2*)(hn + (size_t)(u.pm * BM + rl) * DM + col0 + bj * HALF + 4 * n) = w; }
            }
    }
};

struct EpiConvGate {
    static constexpr bool PERM = true;
    bf16_t* act; const float* cw; const float* cb;
    __device__ __forceinline__ void operator()(const f32x4 (&acc)[2][2][4][2], const Unit& u, int wr, int wc, int fr, int fq, lds_u8* lds) const {
        LAS float* xch = (LAS float*)(lds + STAGE_BYTES);
        int colw = wc * 32 + 8 * fq; asm volatile("" : "+v"(colw));
#pragma unroll
        for (int ai = 0; ai < 2; ++ai) { const int rho = 2 * ai + wr;
#pragma unroll
            for (int bj = 0; bj < 2; ++bj)
#pragma unroll
                for (int n = 0; n < 2; ++n) {
                    if (fr == 0) *(LAS f32x4*)(xch + (rho * 2) * 256 + bj * 128 + colw + 4 * n) = acc[ai][bj][0][n];
                    if (fr == 15) *(LAS f32x4*)(xch + (rho * 2 + 1) * 256 + bj * 128 + colw + 4 * n) = acc[ai][bj][3][n]; } }
        asm volatile("s_waitcnt lgkmcnt(0)" ::: "memory"); __builtin_amdgcn_s_barrier(); asm volatile("" ::: "memory");
        const int jcol = u.pn * 128 + colw;
        const int olo = 254 * u.pm, ohi = (olo + 254 < M) ? olo + 254 : M;
        const bool cross = (u.ar >> 11) != ((u.ar + 255) >> 11);
#pragma unroll
        for (int n = 0; n < 2; ++n) {
            const int ja = jcol + 4 * n, jb = FF + ja;
            const f32x4 wa0 = *(const f32x4*)(cw + ja), wa1 = *(const f32x4*)(cw + UPW + ja), wa2 = *(const f32x4*)(cw + 2 * UPW + ja), ba = *(const f32x4*)(cb + ja);
            const f32x4 wb0 = *(const f32x4*)(cw + jb), wb1 = *(const f32x4*)(cw + UPW + jb), wb2 = *(const f32x4*)(cw + 2 * UPW + jb), bb = *(const f32x4*)(cb + jb);
#pragma unroll
            for (int ai = 0; ai < 2; ++ai) {
                const int rho = 2 * ai + wr;
                const f32x4 z4 = (f32x4){0.f, 0.f, 0.f, 0.f};
#pragma unroll
                for (int m = 0; m < 4; ++m) {
                    f32x4 Xa = z4, Xb = z4, Ya = z4, Yb = z4;
                    if (m == 0 && rho > 0) { Xa = *(const LAS f32x4*)(xch + ((rho - 1) * 2 + 1) * 256 + colw + 4 * n); Xb = *(const LAS f32x4*)(xch + ((rho - 1) * 2 + 1) * 256 + 128 + colw + 4 * n); }
                    if (m == 3 && rho < 3) { Ya = *(const LAS f32x4*)(xch + ((rho + 1) * 2) * 256 + colw + 4 * n); Yb = *(const LAS f32x4*)(xch + ((rho + 1) * 2) * 256 + 128 + colw + 4 * n); }
                    const int gr = u.ar + ai * HALF + wr * 64 + m * 16 + fr;
                    const int t = gr & (SEQ - 1);
                    const bool hasp = t != 0, hasn = t != SEQ - 1;
                    const f32x4 va = acc[ai][0][m][n], vb = acc[ai][1][m][n];
                    f32x4 pa, pb, na, nb;
#pragma unroll
                    for (int j = 0; j < 4; ++j) {
                        pa[j] = dpp_shr1(m > 0 ? dpp_ror1(acc[ai][0][m > 0 ? m - 1 : 0][n][j]) : Xa[j], va[j]);
                        pb[j] = dpp_shr1(m > 0 ? dpp_ror1(acc[ai][1][m > 0 ? m - 1 : 0][n][j]) : Xb[j], vb[j]);
                        na[j] = dpp_shl1(m < 3 ? dpp_ror15(acc[ai][0][m < 3 ? m + 1 : 3][n][j]) : Ya[j], va[j]);
                        nb[j] = dpp_shl1(m < 3 ? dpp_ror15(acc[ai][1][m < 3 ? m + 1 : 3][n][j]) : Yb[j], vb[j]);
                    }
                    f32x4 w0a = wa0, w2a = wa2, w0b = wb0, w2b = wb2;
                    if (cross) {
                        const float fp = hasp ? 1.0f : 0.0f, fn = hasn ? 1.0f : 0.0f;
                        w0a = w0a * fp; w2a = w2a * fn; w0b = w0b * fp; w2b = w2b * fn;
                    }
                    const f32x4 ca = ba + w0a * pa + wa1 * va + w2a * na;
                    const f32x4 cbv = bb + w0b * pb + wb1 * vb + w2b * nb;
                    const f32x4 ex = ca * -1.4426950408889634f;
                    f32x4 ev;
#pragma unroll
                    for (int j = 0; j < 4; ++j) ev[j] = fast_exp2(ex[j]);
                    const f32x4 den = ev + 1.0f;
                    f32x4 sg;
#pragma unroll
                    for (int j = 0; j < 4; ++j) sg[j] = __builtin_amdgcn_rcpf(den[j]);
                    const f32x4 r = ca * sg * cbv;
                    if (gr >= olo && gr < ohi) { u32x2 w; w.x = pk2(r[0], r[1]); w.y = pk2(r[2], r[3]); *(u32x2*)(act + (size_t)gr * FF + ja) = w; }
                }
            }
        }
    }
};

template <class Epi, class Sched>
__device__ __forceinline__ void gemm_phase(lds_u8* lds, const Gemm g, const Sched& S, const Epi& E, const int tid) {
    const int wid = __builtin_amdgcn_readfirstlane(tid >> 6), lane = tid & 63, wr = wid >> 2, wc = wid & 3, fr = lane & 15, fq = lane >> 4;
    const int K = g.K, nt = K / BK;
    unsigned voffA[2], voffB[2];
#pragma unroll
    for (int i = 0; i < 2; ++i) { int R, C; stage_rc(tid * 16 + i * 8192, R, C); const int Rb = Epi::PERM ? ((R & ~31) + perm32(R & 31)) : R;
        voffA[i] = (unsigned)(R * K + C) * 2u; voffB[i] = (unsigned)(Rb * K + C) * 2u; }
    const size_t kstep = (size_t)(BK * 2);
    const size_t hstep = (size_t)HALF * K * 2;
    const size_t tstep = 2 * hstep;
    const unsigned ldsw = (unsigned)wid * 1024u;
    const int aoff = lds_byte(wr * 64 + fr, fq * 8), boff = lds_byte(wc * 32 + fr, fq * 8);
#define PG8_SA(b, h) (((b) * 2 + (h)) * HTB)
#define PG8_SB(b, h) ((4 + (b) * 2 + (h)) * HTB)
#define PG8_STAGE(bufoff, gbase, voff) do { _Pragma("unroll") for (int _i = 0; _i < 2; ++_i) \
        __builtin_amdgcn_global_load_lds((const unsigned*)((const char*)(gbase) + (voff)[_i]), (LAS unsigned*)(lds + (bufoff) + ldsw + _i * 8192), 16, 0, 0); } while (0)
#define PG8_LDA(dst, b, h) do { _Pragma("unroll") for (int m = 0; m < 4; ++m) _Pragma("unroll") for (int k = 0; k < 2; ++k) dst[m][k] = *(const LAS bf16x8*)(lds + PG8_SA(b, h) + aoff + m * 2048 + k * 1024); } while (0)
#define PG8_LDB(dst, b, h) do { _Pragma("unroll") for (int n = 0; n < 2; ++n) _Pragma("unroll") for (int k = 0; k < 2; ++k) dst[n][k] = *(const LAS bf16x8*)(lds + PG8_SB(b, h) + boff + n * 2048 + k * 1024); } while (0)
#define PG8_MMA(ai, bj, At, Bt) do { __builtin_amdgcn_s_setprio(1); _Pragma("unroll") for (int m = 0; m < 4; ++m) _Pragma("unroll") for (int n = 0; n < 2; ++n) _Pragma("unroll") for (int k = 0; k < 2; ++k) \
        acc[ai][bj][m][n] = __builtin_amdgcn_mfma_f32_16x16x32_bf16(Bt[n][k], At[m][k], acc[ai][bj][m][n], 0, 0, 0); __builtin_amdgcn_s_setprio(0); } while (0)
#define PG8_WAIT_V(n) asm volatile("s_waitcnt vmcnt(" #n ")" ::: "memory")
#define PG8_WAIT_L(n) asm volatile("s_waitcnt lgkmcnt(" #n ")" ::: "memory")
#define PG8_BAR __builtin_amdgcn_s_barrier()
#define PG8_SCHED __builtin_amdgcn_sched_barrier(0)
    Unit cur, nxt; int ui = 0;
    if (!S.next(0, cur)) return;
    f32x4 acc[2][2][4][2];
#pragma unroll
    for (int a = 0; a < 2; ++a)
#pragma unroll
        for (int b = 0; b < 2; ++b)
#pragma unroll
            for (int m = 0; m < 4; ++m)
#pragma unroll
                for (int n = 0; n < 2; ++n) acc[a][b][m][n] = (f32x4){0.f, 0.f, 0.f, 0.f};
    bf16x8 At[4][2], B0[2][2], B1[2][2];
    const char* cA = (const char*)g.A + (size_t)cur.ar * (size_t)(K * 2); const char* cB = (const char*)g.Bt + (size_t)cur.pn * tstep;
    PG8_STAGE(PG8_SB(0, 0), cB, voffB); PG8_STAGE(PG8_SB(0, 1), cB + hstep, voffB); PG8_STAGE(PG8_SA(0, 0), cA, voffA); PG8_STAGE(PG8_SA(0, 1), cA + hstep, voffA);
    if (wr == 1) PG8_BAR;
    PG8_WAIT_V(2); PG8_BAR;
    PG8_STAGE(PG8_SB(1, 0), cB + kstep, voffB); PG8_STAGE(PG8_SA(1, 0), cA + kstep, voffA); PG8_STAGE(PG8_SB(1, 1), cB + hstep + kstep, voffB);
    PG8_WAIT_V(6); PG8_BAR;
    for (;;) {
        const bool has_next = S.next(ui + 1, nxt);
        const char* nA = has_next ? (const char*)g.A + (size_t)nxt.ar * (size_t)(K * 2) : cA; const char* nB = has_next ? (const char*)g.Bt + (size_t)nxt.pn * tstep : cB;
        for (int t = 0; t < nt; t += 2) {
            const bool last = (t == nt - 2);
            const char* a1 = cA + (size_t)(t + 1) * kstep;
            const char* a2 = last ? nA : cA + (size_t)(t + 2) * kstep; const char* b2 = last ? nB : cB + (size_t)(t + 2) * kstep;
            const char* a3 = a2 + kstep; const char* b3 = b2 + kstep;
            PG8_LDB(B0, 0, 0); PG8_LDB(B1, 0, 1); PG8_SCHED; PG8_LDA(At, 0, 0); PG8_STAGE(PG8_SA(1, 1), a1 + hstep, voffA);
            PG8_WAIT_V(8); PG8_WAIT_L(0); PG8_BAR; PG8_MMA(0, 0, At, B0); PG8_MMA(0, 1, At, B1); PG8_BAR; PG8_SCHED;
            PG8_LDA(At, 0, 1); PG8_STAGE(PG8_SB(0, 0), b2, voffB); PG8_STAGE(PG8_SB(0, 1), b2 + hstep, voffB); PG8_STAGE(PG8_SA(0, 0), a2, voffA);
            PG8_WAIT_V(8); PG8_WAIT_L(0); PG8_BAR; PG8_MMA(1, 0, At, B0); PG8_MMA(1, 1, At, B1); PG8_BAR; PG8_SCHED;
            PG8_LDB(B0, 1, 0); PG8_LDB(B1, 1, 1); PG8_SCHED; PG8_LDA(At, 1, 0); PG8_STAGE(PG8_SA(0, 1), a2 + hstep, voffA);
            PG8_WAIT_V(8); PG8_WAIT_L(0); PG8_BAR; PG8_MMA(0, 0, At, B0); PG8_MMA(0, 1, At, B1); PG8_BAR; PG8_SCHED;
            PG8_LDA(At, 1, 1); PG8_STAGE(PG8_SB(1, 0), b3, voffB); PG8_STAGE(PG8_SB(1, 1), b3 + hstep, voffB); PG8_STAGE(PG8_SA(1, 0), a3, voffA);
            PG8_WAIT_V(8); PG8_WAIT_L(0); PG8_BAR; PG8_MMA(1, 0, At, B0); PG8_MMA(1, 1, At, B1); PG8_BAR; PG8_SCHED;
        }
        if (wr == 0) PG8_BAR;
        E(acc, cur, wr, wc, fr, fq, lds);
        if (!has_next) break;
#pragma unroll
        for (int a = 0; a < 2; ++a)
#pragma unroll
            for (int b = 0; b < 2; ++b)
#pragma unroll
                for (int m = 0; m < 4; ++m)
#pragma unroll
                    for (int n = 0; n < 2; ++n) acc[a][b][m][n] = (f32x4){0.f, 0.f, 0.f, 0.f};
        cur = nxt; cA = nA; cB = nB; ++ui;
        if (wr == 1) PG8_BAR;
    }
    PG8_WAIT_V(0);
    PG8_BAR;
#undef PG8_SA
#undef PG8_SB
#undef PG8_STAGE
#undef PG8_LDA
#undef PG8_LDB
#undef PG8_MMA
#undef PG8_WAIT_V
#undef PG8_WAIT_L
#undef PG8_BAR
#undef PG8_SCHED
}
}

struct Args {
    const float* in[17];
    float* out; unsigned char* ws;
    int ph_lo, ph_hi;
};
enum { I_X = 0, I_C, I_WADA, I_BADA, I_NORMG, I_WIN, I_AQN, I_AKN, I_BLB, I_BON, I_CQN, I_CKN, I_WOUT, I_WUP, I_CONVW, I_CONVB, I_WDOWN };

__device__ __forceinline__ void p0_transpose_item(const float* W, int K, int N, bf16_t* WT, int mode, LAS float* scr, int item, int lane) {
    const int nblk = N / 32, kb = item / nblk, nb = item % nblk, k0 = 64 * kb, n0 = 32 * nb;
    int rbase = n0;
    if (mode == 1) { const int isb = n0 / FF, j0 = n0 % FF; rbase = 256 * (j0 / 128) + (j0 % 128) + 128 * isb; }
    { float tmp[32];
#pragma unroll
      for (int i = 0; i < 32; ++i) { const int kk = 2 * i + (lane >> 5); tmp[i] = W[(size_t)(k0 + kk) * N + n0 + (lane & 31)]; }
#pragma unroll
      for (int i = 0; i < 32; ++i) { const int kk = 2 * i + (lane >> 5); scr[kk * 33 + (lane & 31)] = tmp[i]; } }
    asm volatile("s_waitcnt lgkmcnt(0)" ::: "memory");
    const int c = lane & 7;
#pragma unroll
    for (int j = 0; j < 4; ++j) { const int n = (lane >> 3) + 8 * j; const LAS float* s = scr + (8 * c) * 33 + n;
        u32x4 o; o.x = pk2(s[0 * 33], s[1 * 33]); o.y = pk2(s[2 * 33], s[3 * 33]); o.z = pk2(s[4 * 33], s[5 * 33]); o.w = pk2(s[6 * 33], s[7 * 33]);
        *(u32x4*)(WT + (size_t)(rbase + n) * K + k0 + 8 * c) = o; }
    asm volatile("s_waitcnt lgkmcnt(0)" ::: "memory");
}

__device__ __forceinline__ void phase_prologue(const Args& a, lds_u8* lds, int vcu, int G, const int tid, const int bx) {
    const int lane = tid & 63, wave = tid >> 6;
    unsigned char* ws = a.ws;
    if (bx == 0) {
        float* tb = (float*)(ws + WS_ROPE);
        for (int e = tid; e < 1024; e += NTHREADS) { const int pos = e >> 4, i = e & 15; const float inv = exp2f(-(float)i * (13.287712379549449f / 16.0f)); const float ang = (float)pos * inv;
            tb[2 * e] = cosf(ang); tb[2 * e + 1] = sinf(ang); }
    }
    {
        LAS float* sc = (LAS float*)(lds + 0);
        LAS float* red = (LAS float*)(lds + 32768);
        bool have = false;
        for (int it = vcu; it < DEPTH * 96; it += G) {
            if (!have) { const float* c = a.in[I_C];
                for (int e = tid; e < NB * DM; e += NTHREADS) { const int b = e >> 10, k = e & 1023; sc[k * 8 + b] = silu_f(c[e]); }
                have = true; __syncthreads(); }
            const int l = it / 96, n0 = 64 * (it % 96);
            const float* wp = a.in[I_WADA] + ((size_t)l * DM + 128 * wave) * 6144 + n0 + lane;
            float acc[8];
#pragma unroll
            for (int b = 0; b < 8; ++b) acc[b] = 0.f;
#pragma unroll 32
            for (int kk = 0; kk < 128; ++kk) { const float wv = wp[(size_t)kk * 6144]; const LAS f32x4* s4 = (const LAS f32x4*)(sc + (128 * wave + kk) * 8); const f32x4 s0 = s4[0], s1 = s4[1];
                acc[0] += s0[0] * wv; acc[1] += s0[1] * wv; acc[2] += s0[2] * wv; acc[3] += s0[3] * wv; acc[4] += s1[0] * wv; acc[5] += s1[1] * wv; acc[6] += s1[2] * wv; acc[7] += s1[3] * wv; }
#pragma unroll
            for (int b = 0; b < 8; ++b) red[(wave * 8 + b) * 64 + lane] = acc[b];
            __syncthreads();
            { const int b = tid >> 6, col = tid & 63; float s = 0.f;
#pragma unroll
              for (int w = 0; w < 8; ++w) s += red[(w * 8 + b) * 64 + col];
              ((float*)(ws + WS_MOD))[((size_t)l * 8 + b) * 6144 + n0 + col] = s + a.in[I_BADA][(size_t)l * 6144 + n0 + col]; }
            __syncthreads();
        }
        __syncthreads();
    }
    {
        LAS float* scr = (LAS float*)(lds + wave * 8448);
        const int gw = vcu * 8 + wave, NGW = G * 8;
        constexpr int I_IN = 16 * (INW / 32), I_OUT = 16 * (DM / 32), I_UP = 16 * (UPW / 32), I_DN = (FF / 64) * (DM / 32), I_LAYER = I_IN + I_OUT + I_UP + I_DN;
        for (int it = gw; it < DEPTH * I_LAYER; it += NGW) {
            const int l = it / I_LAYER; int r = it % I_LAYER;
            if (r < I_IN) { p0_transpose_item(a.in[I_WIN] + (size_t)l * DM * INW, DM, INW, (bf16_t*)(ws + WS_WIN) + (size_t)l * INW * DM, 0, scr, r, lane); continue; } r -= I_IN;
            if (r < I_OUT) { p0_transpose_item(a.in[I_WOUT] + (size_t)l * DM * DM, DM, DM, (bf16_t*)(ws + WS_WOUT) + (size_t)l * DM * DM, 0, scr, r, lane); continue; } r -= I_OUT;
            if (r < I_UP) { p0_transpose_item(a.in[I_WUP] + (size_t)l * DM * UPW, DM, UPW, (bf16_t*)(ws + WS_WUP) + (size_t)l * UPW * DM, 1, scr, r, lane); continue; } r -= I_UP;
            p0_transpose_item(a.in[I_WDOWN] + (size_t)l * FF * DM, FF, DM, (bf16_t*)(ws + WS_WDN) + (size_t)l * DM * FF, 0, scr, r, lane);
        }
    }
}

__device__ __forceinline__ void norm_rows4(const float* x, const float* g, const float* mod_l  , int which_sh, bf16_t* h, int m0, int lane) {
    const int b = m0 / SEQ;
    const f32x4* gr = (const f32x4*)g + lane;
    const f32x4* shr = (const f32x4*)(mod_l + (size_t)b * 6144 + which_sh * DM) + lane;
    const f32x4* scr = (const f32x4*)(mod_l + (size_t)b * 6144 + (which_sh + 1) * DM) + lane;
    f32x4 v[4][4];
#pragma unroll
    for (int r = 0; r < 4; ++r) { const f32x4* xr = (const f32x4*)(x + (size_t)(m0 + r) * DM) + lane;
#pragma unroll
        for (int j = 0; j < 4; ++j) v[r][j] = xr[64 * j]; }
    f32x4 gs[4], sh[4];
#pragma unroll
    for (int j = 0; j < 4; ++j) { gs[j] = gr[64 * j] * (scr[64 * j] + 1.0f); sh[j] = shr[64 * j]; }
#pragma unroll
    for (int r = 0; r < 4; ++r) {
        float s = 0.f;
#pragma unroll
        for (int j = 0; j < 4; ++j) s += (v[r][j].x * v[r][j].x + v[r][j].y * v[r][j].y) + (v[r][j].z * v[r][j].z + v[r][j].w * v[r][j].w);
        const float rstd = rsqrtf(wave_sum(s) * (1.f / DM) + EPS);
        u32x2* o8 = (u32x2*)(h + (size_t)(m0 + r) * DM) + lane;
#pragma unroll
        for (int j = 0; j < 4; ++j) { const f32x4 y = v[r][j] * rstd * gs[j] + sh[j];
            u32x2 w; w.x = pk2(y.x, y.y); w.y = pk2(y.z, y.w); o8[64 * j] = w; }
    }
}
__device__ __forceinline__ void norm_rows4_bf(const bf16_t* x, const float* g, const float* mod_l  , int which_sh, bf16_t* h, int m0, int lane) {
    const int b = m0 / SEQ;
    const float* shp = mod_l + (size_t)b * 6144 + which_sh * DM; const float* scp = shp + DM;
    u32x4 raw[4][2];
#pragma unroll
    for (int r = 0; r < 4; ++r) { const u32x4* xr = (const u32x4*)(x + (size_t)(m0 + r) * DM) + lane; raw[r][0] = xr[0]; raw[r][1] = xr[64]; }
    f32x4 gs[2][2], sh[2][2];
#pragma unroll
    for (int c = 0; c < 2; ++c)
#pragma unroll
        for (int q = 0; q < 2; ++q) { const int col = 512 * c + 8 * lane + 4 * q; gs[c][q] = *(const f32x4*)(g + col) * (*(const f32x4*)(scp + col) + 1.0f); sh[c][q] = *(const f32x4*)(shp + col); }
#pragma unroll
    for (int r = 0; r < 4; ++r) {
        f32x4 v[2][2]; float s = 0.f;
#pragma unroll
        for (int c = 0; c < 2; ++c) { const u32x4 w = raw[r][c]; v[c][0] = (f32x4){bflo(w.x), bfhi(w.x), bflo(w.y), bfhi(w.y)}; v[c][1] = (f32x4){bflo(w.z), bfhi(w.z), bflo(w.w), bfhi(w.w)};
#pragma unroll
            for (int q = 0; q < 2; ++q) s += (v[c][q].x * v[c][q].x + v[c][q].y * v[c][q].y) + (v[c][q].z * v[c][q].z + v[c][q].w * v[c][q].w); }
        const float rstd = rsqrtf(wave_sum(s) * (1.f / DM) + EPS);
        u32x4* o16 = (u32x4*)(h + (size_t)(m0 + r) * DM) + lane;
#pragma unroll
        for (int c = 0; c < 2; ++c) { const f32x4 y0 = v[c][0] * rstd * gs[c][0] + sh[c][0], y1 = v[c][1] * rstd * gs[c][1] + sh[c][1];
            u32x4 w; w.x = pk2(y0.x, y0.y); w.y = pk2(y0.z, y0.w); w.z = pk2(y1.x, y1.y); w.w = pk2(y1.z, y1.w); o16[64 * c] = w; }
    }
}
__device__ __forceinline__ void phase_norm_bf(const bf16_t* x, const float* g, const float* mod_l, int which_sh, bf16_t* h, int vcu, int G, const int tid) {
    const int lane = tid & 63, wave = tid >> 6;
    const int gw = vcu * 8 + wave, NGW = G * 8;
    for (int m0 = gw * 4; m0 < M; m0 += NGW * 4) norm_rows4_bf(x, g, mod_l, which_sh, h, m0, lane);
}
__device__ __forceinline__ void phase_norm(const float* x, const float* g, const float* mod_l, int which_sh, bf16_t* h, int vcu, int G, const int tid) {
    const int lane = tid & 63, wave = tid >> 6;
    const int gw = vcu * 8 + wave, NGW = G * 8;
    for (int m0 = gw * 4; m0 < M; m0 += NGW * 4) norm_rows4(x, g, mod_l, which_sh, h, m0, lane);
}

__device__ __forceinline__ float hgrn_lb(const float* b_lb, int dir, int l, int col) {
    const float* p = b_lb + (size_t)dir * DEPTH * 256 + col;
    const float v0 = p[0], v1 = p[256], v2 = p[512], v3 = p[768];
    const float mx = fmaxf(fmaxf(v0, v1), fmaxf(v2, v3));
    const float e0 = __expf(v0 - mx), e1 = __expf(v1 - mx), e2 = __expf(v2 - mx), e3 = __expf(v3 - mx);
    const float s = e0 + e1 + e2 + e3;
    float acc = 0.f; if (l >= 1) acc += e1; if (l >= 2) acc += e2; if (l >= 3) acc += e3;
    return acc / s;
}
__device__ __forceinline__ void hgrn_fk(float xpre, float lb, float& lf, float& kk) {
    float f = lb + (1.0f - lb) * __builtin_amdgcn_rcpf(1.0f + fast_exp2(-1.4426950408889634f * xpre));
    f = fmaxf(f, 1e-6f);
    lf = __builtin_amdgcn_logf(f); kk = 1.0f - f;
}

__device__ __forceinline__ void phase_prep(const Args& a, lds_u8* lds, int l, int vcu, int G, const int tid, const bool dry) {
    const int lane = tid & 63, wave = tid >> 6;
    const int gw = vcu * 8 + wave, NGW = G * 8;
    unsigned char* ws = a.ws;
    bf16_t* proj = (bf16_t*)(ws + WS_PROJ);
    const float* rope = (const float*)(ws + WS_ROPE);
    {
        const float gak = a.in[I_AKN][l * 64 + lane], gck = a.in[I_CKN][l * 64 + lane];
        const int half = lane >> 5, side = (lane >> 4) & 1, i = lane & 15;
        for (int m0 = gw * 4; m0 < M; m0 += NGW * 4) {
            unsigned short raw[4][4];
#pragma unroll
            for (int r = 0; r < 4; ++r) { const bf16_t* row = proj + (size_t)(m0 + r) * INW;
                raw[r][0] = row[C_AK + lane]; raw[r][1] = row[C_AK + 64 + lane]; raw[r][2] = row[C_CK + lane]; raw[r][3] = row[C_CK + 64 + lane]; }
#pragma unroll
            for (int r = 0; r < 4; ++r) {
                const int m = m0 + r, t = m & (SEQ - 1);
                bf16_t* wrow = (dry ? (bf16_t*)(ws + WS_U) : proj) + (size_t)m * INW;
                const int pos = half ? (t & 63) : (t >> 6);
                const float cs = rope[(pos * 16 + i) * 2], sn = rope[(pos * 16 + i) * 2 + 1];
#pragma unroll
                for (int hh = 0; hh < 2; ++hh) {
                    float v = bf2f(raw[r][hh]);
                    const float ss = wave_sum(v * v);
                    v = v * rsqrtf(ss * (1.f / 64) + EPS) * gak;
                    const float pr = __shfl_xor(v, 16);
                    const float o = side ? (v * cs + pr * sn) : (v * cs - pr * sn);
                    wrow[C_AK + hh * 64 + lane] = (bf16_t)f2bf(o);
                }
#pragma unroll
                for (int hh = 0; hh < 2; ++hh) {
                    float v = bf2f(raw[r][2 + hh]);
                    const float ss = wave_sum(v * v);
                    v = v * rsqrtf(ss * (1.f / 64) + EPS) * gck;
                    wrow[C_CK + hh * 64 + lane] = (bf16_t)f2bf(v);
                }
            }
        }
    }
    {
        LAS bf16_t* scr = (LAS bf16_t*)(lds + wave * 9216);
        bf16_t* vt = (bf16_t*)(ws + WS_VT);
        for (int it = gw; it < NB * 4 * 32; it += NGW) {
            const int b = it >> 7, kv4 = (it >> 5) & 3, tb = it & 31;
            const int col0 = (kv4 < 2 ? C_AV : C_CV) + (kv4 & 1) * 64;
            const bf16_t* src = proj + ((size_t)b * SEQ + tb * 64) * INW + col0 + lane;
#pragma unroll
            for (int rb = 0; rb < 64; rb += 32) { unsigned short tmp[32];
#pragma unroll
              for (int r = 0; r < 32; ++r) tmp[r] = src[(size_t)(rb + r) * INW];
#pragma unroll
              for (int r = 0; r < 32; ++r) scr[(rb + r) * 66 + lane] = tmp[r]; }
            asm volatile("s_waitcnt lgkmcnt(0)" ::: "memory");
            bf16_t* dst = vt + (((size_t)b * 4 + kv4) * 64) * SEQ + tb * 64 + lane;
#pragma unroll 16
            for (int d = 0; d < 64; ++d) dst[(size_t)d * SEQ] = scr[lane * 66 + d];
            asm volatile("s_waitcnt lgkmcnt(0)" ::: "memory");
        }
    }
    {
        LAS bf16_t* klt = (LAS bf16_t*)(lds + wave * 9216);
        float* HL = (float*)(ws + WS_HL); float* HDp = (float*)(ws + WS_HD);
        const int r16 = lane & 15, q4 = lane >> 4;
        for (int it = gw; it < NB * 4 * 2 * 32; it += NGW) {
            const int c = it & 31, dir = (it >> 5) & 1, hh = (it >> 6) & 3, b = it >> 8;
            const float lb = hgrn_lb(a.in[I_BLB], dir, l, hh * 64 + lane);
            const size_t rbase = (size_t)b * SEQ + c * 64;
            const int fcol = (dir ? C_BFB : C_BFF) + hh * 64 + lane;
            unsigned fpk[32];
#pragma unroll
            for (int s = 0; s < 64; s += 2) { const int t0 = dir ? (63 - s) : s, t1 = dir ? (62 - s) : s + 1; fpk[s >> 1] = (unsigned)proj[(rbase + t0) * INW + fcol] | ((unsigned)proj[(rbase + t1) * INW + fcol] << 16); }
            float total = 0.f;
#pragma unroll
            for (int s = 63; s >= 0; --s) { float lf, kk; hgrn_fk((s & 1) ? bfhi(fpk[s >> 1]) : bflo(fpk[s >> 1]), lb, lf, kk);
                klt[lane * 72 + s] = (bf16_t)f2bf(kk * fast_exp2(total)); total += lf; }
            asm volatile("s_waitcnt lgkmcnt(0)" ::: "memory");
            HDp[(size_t)it * 64 + lane] = fast_exp2(total);
            const int vcol = C_BI + hh * 64;
            float* Lo = HL + (size_t)it * 4096;
#pragma unroll
            for (int mi = 0; mi < 4; ++mi) {
                bf16x8 af[2];
#pragma unroll
                for (int ks = 0; ks < 2; ++ks)
#pragma unroll
                    for (int j = 0; j < 8; ++j) { const int s = 32 * ks + 8 * q4 + j; const int tk = dir ? (63 - s) : s; af[ks][j] = (short)proj[(rbase + tk) * INW + vcol + 16 * mi + r16]; }
#pragma unroll
                for (int ni = 0; ni < 4; ++ni) {
                    f32x4 acc = (f32x4){0.f, 0.f, 0.f, 0.f};
#pragma unroll
                    for (int ks = 0; ks < 2; ++ks) { const bf16x8 bfr = *(const LAS bf16x8*)(klt + (16 * ni + r16) * 72 + 32 * ks + 8 * q4);
                        acc = __builtin_amdgcn_mfma_f32_16x16x32_bf16(af[ks], bfr, acc, 0, 0, 0); }
#pragma unroll
                    for (int j = 0; j < 4; ++j) Lo[(16 * mi + 4 * q4 + j) * 64 + 16 * ni + r16] = acc[j];
                }
            }
            asm volatile("s_waitcnt lgkmcnt(0)" ::: "memory");
        }
    }
}

constexpr int AT_KV = 18432;
constexpr int AT_TBL = 4 * AT_KV;
__device__ __forceinline__ int pi32(int m) { return (m & ~12) | ((m & 4) << 1) | ((m & 8) >> 1); }

template <bool BIAS>
__device__ __forceinline__ void attn_unit(lds_u8* lds, const bf16_t* proj, const bf16_t* vt, bf16_t* mix, const bf16_t* po_far, const float* pl, const float* gq, const float* gk, const float* rope,
                                          int b, int h, int qblk, int qcol0, int kcol0, int vsel0, int mixcol0, const int tid) {
    const int lane = tid & 63, wave = __builtin_amdgcn_readfirstlane(tid >> 6);
    const int r32 = lane & 31, hi = lane >> 5;
    const int kvh = h / 3;
    const int q0 = qblk * 256;
    const int qp = q0 + 32 * wave + r32;
    int tlo = 0, ntile = SEQ / 64;
    if (BIAS) { const int klo = q0 - 256 < 0 ? 0 : q0 - 256, khi_ = q0 + 255 + 256 > SEQ - 1 ? SEQ - 1 : q0 + 255 + 256; tlo = klo >> 6; ntile = (khi_ >> 6) - tlo + 1; }
    const bf16_t* kbase = proj + (size_t)b * SEQ * INW + kcol0 + kvh * 64;
    const bf16_t* vbase = vt + ((size_t)b * 4 + vsel0 + kvh) * 64 * SEQ;
    const int lrow_ = tid >> 3, lc16 = tid & 7;
    u32x4 kreg, vreg;
#define AT_LOAD(tile) do { const int key0_ = (tile) * 64; kreg = *(const u32x4*)(kbase + (size_t)(key0_ + lrow_) * INW + lc16 * 8); vreg = *(const u32x4*)(vbase + (size_t)lrow_ * SEQ + key0_ + lc16 * 8); } while (0)
#define AT_STORE(bufi) do { lds_u8* bb_ = lds + (bufi) * AT_KV; *(LAS u32x4*)(bb_ + lrow_ * 144 + lc16 * 16) = kreg; *(LAS u32x4*)(bb_ + 9216 + lrow_ * 144 + lc16 * 16) = vreg; } while (0)
    u32x4 qraw[4];
    { const bf16_t* qrow = proj + ((size_t)b * SEQ + qp) * INW + qcol0 + h * 64 + 8 * hi;
#pragma unroll
      for (int d0 = 0; d0 < 4; ++d0) qraw[d0] = *(const u32x4*)(qrow + 16 * d0); }
    AT_LOAD(tlo);
    const float gql = gq[lane], gkl = gk[lane];
    f32x4 gqv[4][2];
#pragma unroll
    for (int d0 = 0; d0 < 4; ++d0) { gqv[d0][0] = *(const f32x4*)(gq + 16 * d0 + 8 * hi); gqv[d0][1] = *(const f32x4*)(gq + 16 * d0 + 8 * hi + 4); }
    f32x4 rpr[4], rpc[4];
    if (!BIAS) { const int pr = qp >> 6, pc = qp & 63;
#pragma unroll
        for (int j4 = 0; j4 < 4; ++j4) { rpr[j4] = *(const f32x4*)(rope + (pr * 16 + 8 * hi) * 2 + 4 * j4); rpc[j4] = *(const f32x4*)(rope + (pc * 16 + 8 * hi) * 2 + 4 * j4); } }
    float ref;
    { float a = fabsf(gql), c = fabsf(gkl);
#pragma unroll
      for (int o = 1; o < 64; o <<= 1) { a = fmaxf(a, __shfl_xor(a, o)); c = fmaxf(c, __shfl_xor(c, o)); }
      ref = 64.0f * 0.125f * 1.4426950408889634f * 1.02f * a * c + (BIAS ? 1.6f : 0.0f); }
    if (BIAS) {
        LAS float* tbl = (LAS float*)(lds + AT_TBL);
        const float slope = fast_exp2(-(float)(h + 1) * (4.0f / 3.0f));
        for (int e = tid; e < 4096; e += NTHREADS) { const int d = e - 2048, ad = d < 0 ? -d : d;
            const int mult = ad > 256 ? 0 : (ad <= 64 ? 1 : 0) + ((ad & 3) == 0 ? 1 : 0) + ((ad & 15) == 0 ? 1 : 0);
            const float lg = mult == 3 ? 1.5849625007211562f : (mult == 2 ? 1.0f : 0.0f);
            tbl[e] = mult ? (lg - slope * (float)ad * 1.4426950408889634f - ref) : -1e30f; }
    }
    bf16x8 qr[4];
    {
        float v[4][8]; float ss = 0.f;
#pragma unroll
        for (int d0 = 0; d0 < 4; ++d0) { const u32x4 w = qraw[d0];
            v[d0][0] = bflo(w.x); v[d0][1] = bfhi(w.x); v[d0][2] = bflo(w.y); v[d0][3] = bfhi(w.y); v[d0][4] = bflo(w.z); v[d0][5] = bfhi(w.z); v[d0][6] = bflo(w.w); v[d0][7] = bfhi(w.w);
#pragma unroll
            for (int j = 0; j < 8; ++j) ss += v[d0][j] * v[d0][j]; }
        ss += __shfl_xor(ss, 32);
        const float rstd = rsqrtf(ss * (1.f / 64) + EPS);
#pragma unroll
        for (int d0 = 0; d0 < 4; ++d0)
#pragma unroll
            for (int j = 0; j < 8; ++j) v[d0][j] *= rstd * gqv[d0][j >> 2][j & 3];
        if (!BIAS) {
#pragma unroll
            for (int j = 0; j < 8; ++j) {
                { const float c = rpr[j >> 1][2 * (j & 1)], s = rpr[j >> 1][2 * (j & 1) + 1]; const float x1 = v[0][j], x2 = v[1][j]; v[0][j] = x1 * c - x2 * s; v[1][j] = x2 * c + x1 * s; }
                { const float c = rpc[j >> 1][2 * (j & 1)], s = rpc[j >> 1][2 * (j & 1) + 1]; const float x1 = v[2][j], x2 = v[3][j]; v[2][j] = x1 * c - x2 * s; v[3][j] = x2 * c + x1 * s; } }
        }
        const float qsc = 0.125f * 1.4426950408889634f;
#pragma unroll
        for (int d0 = 0; d0 < 4; ++d0) { u32x4 w; w.x = pk2(v[d0][0] * qsc, v[d0][1] * qsc); w.y = pk2(v[d0][2] * qsc, v[d0][3] * qsc); w.z = pk2(v[d0][4] * qsc, v[d0][5] * qsc); w.w = pk2(v[d0][6] * qsc, v[d0][7] * qsc);
            qr[d0] = __builtin_bit_cast(bf16x8, w); }
    }
    AT_STORE(0);
    __syncthreads();
    float lrow = 0.f;
    f32x16 o0, o1, negref;
#pragma unroll
    for (int i = 0; i < 16; ++i) { o0[i] = 0.f; o1[i] = 0.f; negref[i] = -ref; }
    const int krow = pi32(r32);
    for (int step = 0; step < ntile; ++step) {
        const bool ldn = (step + 1 < ntile);
        if (ldn) AT_LOAD(tlo + step + 1);
        {
            const lds_u8* kb = lds + (step & 1) * AT_KV;
            const lds_u8* vb = kb + 9216;
            f32x16 p0, p1;
            if (BIAS) {
                const LAS float* tbl = (const LAS float*)(lds + AT_TBL) + ((tlo + step) * 64 + 8 * hi - qp + 2048);
#pragma unroll
                for (int i = 0; i < 16; ++i) { p0[i] = tbl[(i & 7) + 16 * (i >> 3)]; p1[i] = tbl[(i & 7) + 16 * (i >> 3) + 32]; }
            } else { p0 = negref; p1 = negref; }
#pragma unroll
            for (int d0 = 0; d0 < 4; ++d0) {
                const bf16x8 k0 = *(const LAS bf16x8*)(kb + krow * 144 + 32 * d0 + 16 * hi);
                const bf16x8 k1 = *(const LAS bf16x8*)(kb + (32 + krow) * 144 + 32 * d0 + 16 * hi);
                p0 = __builtin_amdgcn_mfma_f32_32x32x16_bf16(k0, qr[d0], p0, 0, 0, 0);
                p1 = __builtin_amdgcn_mfma_f32_32x32x16_bf16(k1, qr[d0], p1, 0, 0, 0);
            }
            float rs0 = 0.f, rs1 = 0.f;
#pragma unroll
            for (int i = 0; i < 16; ++i) { p0[i] = fast_exp2(p0[i]); p1[i] = fast_exp2(p1[i]); rs0 += p0[i]; rs1 += p1[i]; }
            lrow += rs0 + rs1;
            bf16x8 pb[2][2];
#pragma unroll
            for (int ks = 0; ks < 2; ++ks) {
                u32x4 w; w.x = pk2(p0[8 * ks + 0], p0[8 * ks + 1]); w.y = pk2(p0[8 * ks + 2], p0[8 * ks + 3]); w.z = pk2(p0[8 * ks + 4], p0[8 * ks + 5]); w.w = pk2(p0[8 * ks + 6], p0[8 * ks + 7]);
                pb[0][ks] = __builtin_bit_cast(bf16x8, w);
                u32x4 w1; w1.x = pk2(p1[8 * ks + 0], p1[8 * ks + 1]); w1.y = pk2(p1[8 * ks + 2], p1[8 * ks + 3]); w1.z = pk2(p1[8 * ks + 4], p1[8 * ks + 5]); w1.w = pk2(p1[8 * ks + 6], p1[8 * ks + 7]);
                pb[1][ks] = __builtin_bit_cast(bf16x8, w1);
            }
#pragma unroll
            for (int sub = 0; sub < 2; ++sub)
#pragma unroll
                for (int ks = 0; ks < 2; ++ks) {
                    const bf16x8 v0 = *(const LAS bf16x8*)(vb + r32 * 144 + (32 * sub + 16 * ks + 8 * hi) * 2);
                    const bf16x8 v1 = *(const LAS bf16x8*)(vb + (32 + r32) * 144 + (32 * sub + 16 * ks + 8 * hi) * 2);
                    o0 = __builtin_amdgcn_mfma_f32_32x32x16_bf16(v0, pb[sub][ks], o0, 0, 0, 0);
                    o1 = __builtin_amdgcn_mfma_f32_32x32x16_bf16(v1, pb[sub][ks], o1, 0, 0, 0);
                }
        }
        if (ldn) AT_STORE((step + 1) & 1);
        __syncthreads();
    }
#undef AT_LOAD
#undef AT_STORE
    lrow += __shfl_xor(lrow, 32);
    {
        const size_t grow = (size_t)b * SEQ + qp;
        const bf16_t* fpo = BIAS ? po_far + grow * 384 + h * 64 + 4 * hi : nullptr;
        const float inv = 1.0f / (lrow + (BIAS ? pl[grow * 6 + h] : 0.0f));
        bf16_t* orow = mix + grow * DM + mixcol0 + h * 64 + 4 * hi;
#pragma unroll
        for (int g4 = 0; g4 < 4; ++g4) {
            u32x2 f0 = (u32x2){0u, 0u}, f1 = (u32x2){0u, 0u};
            if (BIAS) { f0 = *(const u32x2*)(fpo + 8 * g4); f1 = *(const u32x2*)(fpo + 32 + 8 * g4); }
            { const float x0 = (o0[4 * g4] + bflo(f0.x)) * inv, x1 = (o0[4 * g4 + 1] + bfhi(f0.x)) * inv, x2 = (o0[4 * g4 + 2] + bflo(f0.y)) * inv, x3 = (o0[4 * g4 + 3] + bfhi(f0.y)) * inv;
              u32x2 w; w.x = pk2(x0, x1); w.y = pk2(x2, x3); *(u32x2*)(orow + 8 * g4) = w; }
            { const float x0 = (o1[4 * g4] + bflo(f1.x)) * inv, x1 = (o1[4 * g4 + 1] + bfhi(f1.x)) * inv, x2 = (o1[4 * g4 + 2] + bflo(f1.y)) * inv, x3 = (o1[4 * g4 + 3] + bfhi(f1.y)) * inv;
              u32x2 w; w.x = pk2(x0, x1); w.y = pk2(x2, x3); *(u32x2*)(orow + 32 + 8 * g4) = w; }
        }
    }
}

__device__ __forceinline__ void attn_r16_unit(lds_u8* lds, const bf16_t* proj, bf16_t* po, float* pl, const float* gq, const float* gk, int b, int kvh, int rho, const int tid) {
    const int lane = tid & 63, wave = __builtin_amdgcn_readfirstlane(tid >> 6);
    const int qs = wave & 3, kh = wave >> 2, r32 = lane & 31, hi = lane >> 5;
    const int iq = 32 * qs + r32;
    const size_t qrow_g = (size_t)b * SEQ + rho + 16 * iq;
    const bf16_t* qrow0 = proj + qrow_g * INW + C_CQ + (kvh * 3) * 64 + 8 * hi;
    u32x4 qcur[4], qnxt[4];
#pragma unroll
    for (int d0 = 0; d0 < 4; ++d0) { qcur[d0] = *(const u32x4*)(qrow0 + 16 * d0); qnxt[d0] = qcur[d0]; }
    u32x4 kst[2], vst[2];
    const int th = tid & 255;
#pragma unroll
    for (int i_ = 0; i_ < 2; ++i_) { const int c_ = th + 256 * i_, row_ = c_ >> 3, c16_ = c_ & 7;
        const bf16_t* src = proj + ((size_t)b * SEQ + rho + 16 * (64 * kh + row_)) * INW + kvh * 64 + c16_ * 8;
        kst[i_] = *(const u32x4*)(src + C_CK); vst[i_] = *(const u32x4*)(src + C_CV); }
    const float gql = gq[lane], gkl = gk[lane];
    float ref;
    { float a = fabsf(gql), c = fabsf(gkl);
#pragma unroll
      for (int o = 1; o < 64; o <<= 1) { a = fmaxf(a, __shfl_xor(a, o)); c = fmaxf(c, __shfl_xor(c, o)); }
      ref = 64.0f * 0.125f * 1.4426950408889634f * 1.02f * a * c + 1.6f; }
    LAS float* tb = (LAS float*)(lds + 40960);
    for (int e = tid; e < 768; e += NTHREADS) { const int hq = e >> 8, d = (e & 255) - 128, ad = d < 0 ? -d : d; const float slope = fast_exp2(-(float)(kvh * 3 + hq + 1) * (4.0f / 3.0f));
        tb[e] = (ad > 16 && ad <= 64) ? (-slope * 16.0f * (float)ad * 1.4426950408889634f - ref) : -1e30f; }
    lds_u8* hb = lds + kh * AT_KV;
#pragma unroll
    for (int i_ = 0; i_ < 2; ++i_) { const int c_ = th + 256 * i_, row_ = c_ >> 3, c16_ = c_ & 7;
        *(LAS u32x4*)(hb + row_ * 144 + c16_ * 16) = kst[i_]; *(LAS u32x4*)(hb + 9216 + row_ * 144 + c16_ * 16) = vst[i_]; }
    __syncthreads();
    const int krow = pi32(r32);
    bf16x8 kf[8], vf[8];
#pragma unroll
    for (int d0 = 0; d0 < 4; ++d0) { kf[2 * d0] = *(const LAS bf16x8*)(hb + krow * 144 + 32 * d0 + 16 * hi); kf[2 * d0 + 1] = *(const LAS bf16x8*)(hb + (32 + krow) * 144 + 32 * d0 + 16 * hi); }
    { const LAS bf16_t* vbase = (const LAS bf16_t*)(hb + 9216);
#pragma unroll
      for (int sub = 0; sub < 2; ++sub)
#pragma unroll
        for (int ks = 0; ks < 2; ++ks)
#pragma unroll
            for (int j = 0; j < 8; ++j) { const int key = 32 * sub + 16 * ks + 8 * hi + j;
                vf[(sub * 2 + ks) * 2][j] = (short)vbase[key * 72 + r32]; vf[(sub * 2 + ks) * 2 + 1][j] = (short)vbase[key * 72 + 32 + r32]; } }
    __syncthreads();
    LAS float* cs = (LAS float*)(lds) + (qs * 64 + lane) * 35;
#pragma unroll 1
    for (int hq = 0; hq < 3; ++hq) {
        const int h = kvh * 3 + hq;
        if (hq < 2) {
#pragma unroll
            for (int d0 = 0; d0 < 4; ++d0) qnxt[d0] = *(const u32x4*)(qrow0 + (hq + 1) * 64 + 16 * d0); }
        bf16x8 qr[4];
        {
            f32x4 gqv[4][2];
#pragma unroll
            for (int d0 = 0; d0 < 4; ++d0) { gqv[d0][0] = *(const f32x4*)(gq + 16 * d0 + 8 * hi); gqv[d0][1] = *(const f32x4*)(gq + 16 * d0 + 8 * hi + 4); }
            float v[4][8]; float ss = 0.f;
#pragma unroll
            for (int d0 = 0; d0 < 4; ++d0) { const u32x4 w = qcur[d0];
                v[d0][0] = bflo(w.x); v[d0][1] = bfhi(w.x); v[d0][2] = bflo(w.y); v[d0][3] = bfhi(w.y); v[d0][4] = bflo(w.z); v[d0][5] = bfhi(w.z); v[d0][6] = bflo(w.w); v[d0][7] = bfhi(w.w);
#pragma unroll
                for (int j = 0; j < 8; ++j) ss += v[d0][j] * v[d0][j]; }
            ss += __shfl_xor(ss, 32);
            const float rstd = rsqrtf(ss * (1.f / 64) + EPS) * (0.125f * 1.4426950408889634f);
#pragma unroll
            for (int d0 = 0; d0 < 4; ++d0) { float y[8];
#pragma unroll
                for (int j = 0; j < 8; ++j) y[j] = v[d0][j] * rstd * gqv[d0][j >> 2][j & 3];
                u32x4 w; w.x = pk2(y[0], y[1]); w.y = pk2(y[2], y[3]); w.z = pk2(y[4], y[5]); w.w = pk2(y[6], y[7]); qr[d0] = __builtin_bit_cast(bf16x8, w); }
        }
        f32x16 p0, p1;
        { const LAS float* tbl = tb + hq * 256 + (64 * kh + 8 * hi - iq + 128);
#pragma unroll
          for (int i = 0; i < 16; ++i) { p0[i] = tbl[(i & 7) + 16 * (i >> 3)]; p1[i] = tbl[(i & 7) + 16 * (i >> 3) + 32]; } }
#pragma unroll
        for (int d0 = 0; d0 < 4; ++d0) {
            p0 = __builtin_amdgcn_mfma_f32_32x32x16_bf16(kf[2 * d0], qr[d0], p0, 0, 0, 0);
            p1 = __builtin_amdgcn_mfma_f32_32x32x16_bf16(kf[2 * d0 + 1], qr[d0], p1, 0, 0, 0);
        }
        float lrow = 0.f;
#pragma unroll
        for (int i = 0; i < 16; ++i) { p0[i] = fast_exp2(p0[i]); p1[i] = fast_exp2(p1[i]); lrow += p0[i] + p1[i]; }
        bf16x8 pb[2][2];
#pragma unroll
        for (int ks = 0; ks < 2; ++ks) {
            u32x4 w; w.x = pk2(p0[8 * ks + 0], p0[8 * ks + 1]); w.y = pk2(p0[8 * ks + 2], p0[8 * ks + 3]); w.z = pk2(p0[8 * ks + 4], p0[8 * ks + 5]); w.w = pk2(p0[8 * ks + 6], p0[8 * ks + 7]);
            pb[0][ks] = __builtin_bit_cast(bf16x8, w);
            u32x4 w1; w1.x = pk2(p1[8 * ks + 0], p1[8 * ks + 1]); w1.y = pk2(p1[8 * ks + 2], p1[8 * ks + 3]); w1.z = pk2(p1[8 * ks + 4], p1[8 * ks + 5]); w1.w = pk2(p1[8 * ks + 6], p1[8 * ks + 7]);
            pb[1][ks] = __builtin_bit_cast(bf16x8, w1);
        }
        f32x16 o0, o1;
#pragma unroll
        for (int i = 0; i < 16; ++i) { o0[i] = 0.f; o1[i] = 0.f; }
#pragma unroll
        for (int sub = 0; sub < 2; ++sub)
#pragma unroll
            for (int ks = 0; ks < 2; ++ks) {
                o0 = __builtin_amdgcn_mfma_f32_32x32x16_bf16(vf[(sub * 2 + ks) * 2], pb[sub][ks], o0, 0, 0, 0);
                o1 = __builtin_amdgcn_mfma_f32_32x32x16_bf16(vf[(sub * 2 + ks) * 2 + 1], pb[sub][ks], o1, 0, 0, 0);
            }
        lrow += __shfl_xor(lrow, 32);
        if (kh == 1) { cs[1] = lrow;
#pragma unroll
            for (int i = 0; i < 16; ++i) { cs[2 + i] = o0[i]; cs[18 + i] = o1[i]; } }
        __syncthreads();
        if (kh == 0) {
            bf16_t* orow = po + qrow_g * 384 + h * 64 + 4 * hi;
            if (hi == 0) pl[qrow_g * 6 + h] = lrow + cs[1];
#pragma unroll
            for (int g4 = 0; g4 < 4; ++g4) {
                { u32x2 w; w.x = pk2(o0[4 * g4] + cs[2 + 4 * g4], o0[4 * g4 + 1] + cs[3 + 4 * g4]); w.y = pk2(o0[4 * g4 + 2] + cs[4 + 4 * g4], o0[4 * g4 + 3] + cs[5 + 4 * g4]); *(u32x2*)(orow + 8 * g4) = w; }
                { u32x2 w; w.x = pk2(o1[4 * g4] + cs[18 + 4 * g4], o1[4 * g4 + 1] + cs[19 + 4 * g4]); w.y = pk2(o1[4 * g4 + 2] + cs[20 + 4 * g4], o1[4 * g4 + 3] + cs[21 + 4 * g4]); *(u32x2*)(orow + 32 + 8 * g4) = w; }
            }
        }
        __syncthreads();
#pragma unroll
        for (int d0 = 0; d0 < 4; ++d0) qcur[d0] = qnxt[d0];
    }
}

__device__ __forceinline__ void phase_scan(const Args& a, int vcu, int G, const int tid) {
    const float* HL = (const float*)(a.ws + WS_HL); const float* HDp = (const float*)(a.ws + WS_HD); bf16_t* HS = (bf16_t*)(a.ws + WS_HS);
    for (int e = vcu * NTHREADS + tid; e < 64 * 4096; e += G * NTHREADS) {
        const int seq = e >> 12, idx = e & 4095, k = idx & 63, dir = seq & 1;
        float st = 0.f;
        for (int cb = 0; cb < 32; cb += 8) {
            float hd[8], hl[8];
#pragma unroll
            for (int j = 0; j < 8; ++j) { const int c = dir ? 31 - (cb + j) : cb + j; const size_t o = (size_t)seq * 32 + c; hd[j] = HDp[o * 64 + k]; hl[j] = HL[o * 4096 + idx]; }
#pragma unroll
            for (int j = 0; j < 8; ++j) { const int c = dir ? 31 - (cb + j) : cb + j; const size_t o = (size_t)seq * 32 + c; HS[o * 4096 + idx] = (bf16_t)f2bf(st); st = hd[j] * st + hl[j]; }
        }
    }
}

constexpr int HG_OACC = 0, HG_QS = 65536, HG_QD = HG_QS + 9216, HG_KD = HG_QD + 9216, HG_KE = HG_KD + 9216, HG_Q2 = HG_KE + 9216, HG_K2 = HG_Q2 + 4608,
              HG_VT = HG_K2 + 4608, HG_AT = HG_VT + 9216, HG_ST = HG_AT + 9216, HG_GT = HG_ST + 9216, HG_END = HG_GT + 2048;
static_assert(HG_END <= LDS_BYTES, "HGRN LDS map");

__device__ __forceinline__ void hgrn_out_item(const Args& a, lds_u8* lds, int l, int item, const int tid) {
    const int lane = tid & 63, wave = __builtin_amdgcn_readfirstlane(tid >> 6);
    const int k = lane, rg = wave;
    const int b = item >> 5, hh = (item >> 3) & 3, grp = item & 7;
    const int c0 = grp * 4;
    unsigned char* ws = a.ws;
    const bf16_t* proj = (const bf16_t*)(ws + WS_PROJ);
    const float* HL = (const float*)(ws + WS_HL); const float* HDp = (const float*)(ws + WS_HD);
    LAS float* oacc = (LAS float*)(lds + HG_OACC);
    LAS bf16_t* Qs = (LAS bf16_t*)(lds + HG_QS); LAS bf16_t* Qd = (LAS bf16_t*)(lds + HG_QD); LAS bf16_t* Kd = (LAS bf16_t*)(lds + HG_KD); LAS bf16_t* Ke = (LAS bf16_t*)(lds + HG_KE);
    LAS bf16_t* Q2 = (LAS bf16_t*)(lds + HG_Q2); LAS bf16_t* K2 = (LAS bf16_t*)(lds + HG_K2); LAS bf16_t* VT = (LAS bf16_t*)(lds + HG_VT); LAS bf16_t* AT = (LAS bf16_t*)(lds + HG_AT);
    LAS bf16_t* ST = (LAS bf16_t*)(lds + HG_ST); LAS float* gt = (LAS float*)(lds + HG_GT);
    const int r16 = lane & 15, q4 = lane >> 4;
    const float lbv0 = hgrn_lb(a.in[I_BLB], 0, l, hh * 64 + k), lbv1 = hgrn_lb(a.in[I_BLB], 1, l, hh * 64 + k);
    unsigned short rq[8], rf[8], rv[8];
#define HG_LOADRAW(dir_, c_) do { const size_t rb_ = (size_t)b * SEQ + (c_) * 64; _Pragma("unroll") for (int i = 0; i < 8; ++i) { const int s_ = 8 * rg + i; const int tk_ = (dir_) ? (63 - s_) : s_; \
        const bf16_t* rp_ = proj + (rb_ + tk_) * INW; rq[i] = rp_[C_BQ + hh * 64 + k]; rf[i] = rp_[((dir_) ? C_BFB : C_BFF) + hh * 64 + k]; rv[i] = rp_[C_BI + hh * 64 + k]; } } while (0)
    HG_LOADRAW(0, c0);
    float st[8];
#pragma unroll
    for (int i = 0; i < 8; ++i) st[i] = 0.f;
    for (int stp = 0; stp < 8; ++stp) {
        {
            const int dir = stp >> 2, ci = stp & 3;
            const float lb = dir ? lbv1 : lbv0;
            const size_t sbase = (((size_t)b * 4 + hh) * 2 + dir) * 32;
            const int c = dir ? (c0 + 3 - ci) : (c0 + ci);
            if (ci == 0) { const bf16_t* HSp = (const bf16_t*)(ws + WS_HS) + (sbase + c) * 4096 + (8 * wave) * 64 + k;
#pragma unroll
                for (int i = 0; i < 8; ++i) st[i] = bf2f(HSp[i * 64]); }
            float qv[8], lf[8], kk[8];
            u32x4 vpk;
#pragma unroll
            for (int i = 0; i < 8; ++i) { qv[i] = bf2f(rq[i]); hgrn_fk(bf2f(rf[i]), lb, lf[i], kk[i]); }
            vpk.x = rv[0] | ((unsigned)rv[1] << 16); vpk.y = rv[2] | ((unsigned)rv[3] << 16); vpk.z = rv[4] | ((unsigned)rv[5] << 16); vpk.w = rv[6] | ((unsigned)rv[7] << 16);
            const float dk = HDp[(sbase + c) * 64 + k];
            float Ln[8];
            { const float* Lp = HL + (sbase + c) * 4096 + (8 * wave) * 64 + k;
#pragma unroll
              for (int i = 0; i < 8; ++i) Ln[i] = Lp[i * 64]; }
            if (stp < 7) { const int nd = (stp + 1) >> 2, nci = (stp + 1) & 3; const int nc = nd ? (c0 + 3 - nci) : (c0 + nci); HG_LOADRAW(nd, nc); }
#pragma unroll
            for (int i = 1; i < 8; ++i) lf[i] += lf[i - 1];
            gt[rg * 64 + k] = lf[7];
#pragma unroll
            for (int i = 0; i < 8; ++i) ST[(8 * wave + i) * 72 + k] = (bf16_t)f2bf(st[i]);
            __syncthreads();
            float gsum[9]; gsum[0] = 0.f;
#pragma unroll
            for (int g = 0; g < 8; ++g) gsum[g + 1] = gsum[g] + gt[g * 64 + k];
            float off = 0.f, bS = 0.f, bE = 0.f;
#pragma unroll
            for (int g = 0; g < 8; ++g) { if (g == rg) off = gsum[g]; if (g == (rg & ~1)) { bS = gsum[g]; bE = gsum[g + 2]; } }
            const float b31 = gsum[4];
#pragma unroll
            for (int i = 0; i < 8; ++i) {
                const int s = 8 * rg + i; const float bb = off + lf[i];
                Qs[s * 72 + k] = (bf16_t)f2bf(qv[i] * fast_exp2(bb));
                Qd[s * 72 + k] = (bf16_t)f2bf(qv[i] * fast_exp2(bb - bS));
                Kd[s * 72 + k] = (bf16_t)f2bf(kk[i] * fast_exp2(fminf(bS - bb, 115.f)));
                Ke[s * 72 + k] = (bf16_t)f2bf(kk[i] * fast_exp2(bE - bb));
                { const bool hi2 = rg >= 4; LAS bf16_t* T2 = hi2 ? Q2 + (s - 32) * 72 + k : K2 + s * 72 + k;
                  *T2 = (bf16_t)f2bf((hi2 ? qv[i] : kk[i]) * fast_exp2(hi2 ? bb - b31 : b31 - bb)); }
            }
            *(LAS u32x4*)(VT + k * 72 + 8 * rg) = vpk;
            __syncthreads();
            {
                const int I = wave >> 1;
#pragma unroll
                for (int jj = 0; jj < 2; ++jj) {
                    const int J = 2 * (wave & 1) + jj;
                    f32x4 acc = (f32x4){0.f, 0.f, 0.f, 0.f};
                    if (J <= I) {
                        const LAS bf16_t* Ap; const LAS bf16_t* Bp;
                        if (J == I) { Ap = Qd + (16 * I + r16) * 72; Bp = Kd + (16 * J + r16) * 72; }
                        else if ((I >> 1) == (J >> 1)) { Ap = Qd + (16 * I + r16) * 72; Bp = Ke + (16 * J + r16) * 72; }
                        else { Ap = Q2 + (16 * (I - 2) + r16) * 72; Bp = K2 + (16 * J + r16) * 72; }
#pragma unroll
                        for (int ks = 0; ks < 2; ++ks) { const bf16x8 af = *(const LAS bf16x8*)(Ap + 32 * ks + 8 * q4); const bf16x8 bfr = *(const LAS bf16x8*)(Bp + 32 * ks + 8 * q4);
                            acc = __builtin_amdgcn_mfma_f32_16x16x32_bf16(af, bfr, acc, 0, 0, 0); }
                        if (J == I) {
#pragma unroll
                            for (int j = 0; j < 4; ++j) if (r16 > 4 * q4 + j) acc[j] = 0.f;
                        }
                    }
#pragma unroll
                    for (int j = 0; j < 4; ++j) AT[(16 * I + 4 * q4 + j) * 72 + 16 * J + r16] = (bf16_t)f2bf(acc[j]);
                }
            }
            __syncthreads();
            {
                const int mi = wave >> 1;
#pragma unroll
                for (int jj = 0; jj < 2; ++jj) {
                    const int ni = 2 * (wave & 1) + jj;
                    f32x4 acc = (f32x4){0.f, 0.f, 0.f, 0.f};
#pragma unroll
                    for (int ks = 0; ks < 2; ++ks) { const bf16x8 af = *(const LAS bf16x8*)(Qs + (16 * mi + r16) * 72 + 32 * ks + 8 * q4); const bf16x8 bfr = *(const LAS bf16x8*)(ST + (16 * ni + r16) * 72 + 32 * ks + 8 * q4);
                        acc = __builtin_amdgcn_mfma_f32_16x16x32_bf16(af, bfr, acc, 0, 0, 0); }
#pragma unroll
                    for (int ks = 0; ks < 2; ++ks) { const bf16x8 af = *(const LAS bf16x8*)(AT + (16 * mi + r16) * 72 + 32 * ks + 8 * q4); const bf16x8 bfr = *(const LAS bf16x8*)(VT + (16 * ni + r16) * 72 + 32 * ks + 8 * q4);
                        acc = __builtin_amdgcn_mfma_f32_16x16x32_bf16(af, bfr, acc, 0, 0, 0); }
#pragma unroll
                    for (int j = 0; j < 4; ++j) { const int t = 16 * mi + 4 * q4 + j; const int tl = (c - c0) * 64 + (dir ? (63 - t) : t);
                        LAS float* op = oacc + tl * 64 + 16 * ni + r16;
                        if (dir == 0) *op = acc[j]; else *op += acc[j]; }
                }
            }
#pragma unroll
            for (int i = 0; i < 8; ++i) st[i] = dk * st[i] + Ln[i];
            __syncthreads();
        }
    }
#undef HG_LOADRAW

    {
        const float gn = a.in[I_BON][l * 64 + lane];
        bf16_t* mix = (bf16_t*)(ws + WS_MIX);
        for (int rb = 0; rb < 32; rb += 8) {
            unsigned short gv[8];
#pragma unroll
            for (int r = 0; r < 8; ++r) gv[r] = proj[((size_t)b * SEQ + c0 * 64 + 32 * wave + rb + r) * INW + C_BG + hh * 64 + lane];
#pragma unroll
            for (int r = 0; r < 8; ++r) {
                const int tl = 32 * wave + rb + r;
                const size_t row = (size_t)b * SEQ + c0 * 64 + tl;
                const float o = oacc[tl * 64 + lane];
                const float ss = wave_sum(o * o);
                mix[row * DM + 384 + hh * 64 + lane] = (bf16_t)f2bf(o * rsqrtf(ss * (1.f / 64) + EPS) * gn * silu_f(bf2f(gv[r])));
            }
        }
    }
    __syncthreads();
}

__device__ __forceinline__ void phase_mixers(const Args& a, lds_u8* lds, int l, int vcu, int G, const int tid) {
    unsigned char* ws = a.ws;
    const bf16_t* proj = (const bf16_t*)(ws + WS_PROJ); const bf16_t* vt = (const bf16_t*)(ws + WS_VT); bf16_t* mix = (bf16_t*)(ws + WS_MIX);
    const float* rope = (const float*)(ws + WS_ROPE);
    for (int rp = 0; rp < ((PROBE_DUP & 256) ? 2 : 1); ++rp)
    for (int it = vcu; it < NB * 4 * 8; it += G) hgrn_out_item(a, lds, l, it, tid);
    const bf16_t* po_far = (const bf16_t*)(ws + WS_PO); const float* pl_far = (const float*)(ws + WS_PL);
    for (int u = vcu; u < 768; u += G) {
        const int mixer = u / 384, r = u % 384, b = r / 48, rr = r % 48, kvh = rr / 24, r3 = rr % 24, hq = r3 / 8, qblk = r3 % 8;
        const int h = kvh * 3 + hq;
        if (mixer == 0) attn_unit<false>(lds, proj, vt, mix, nullptr, nullptr, a.in[I_AQN] + l * 64, a.in[I_AKN] + l * 64, rope, b, h, qblk, C_AQ, C_AK, 0, 0, tid);
        else attn_unit<true>(lds, proj, vt, mix, po_far, pl_far, a.in[I_CQN] + l * 64, a.in[I_CKN] + l * 64, rope, b, h, qblk, C_CQ, C_CK, 2, 640, tid);
    }
}

__device__ __forceinline__ void phase_mixc(const Args& a, lds_u8* lds, int l, int vcu, int G, const int tid) {
    unsigned char* ws = a.ws;
    const bf16_t* proj = (const bf16_t*)(ws + WS_PROJ);
    bf16_t* po = (bf16_t*)(ws + WS_PO); float* pl = (float*)(ws + WS_PL);
    for (int u = vcu; u < 256; u += G) {
        const int b = u >> 5, kvh = (u >> 4) & 1, rho = u & 15;
        attn_r16_unit(lds, proj, po, pl, a.in[I_CQN] + l * 64, a.in[I_CKN] + l * 64, b, kvh, rho, tid);
    }
}

#define XB_TMO      128
#define XB_XCNT(j)  (256  + 64 * (j))
#define XB_XSUB(j)  (1280 + 64 * (j))
#define XB_XGEN(j)  (2304 + 64 * (j))
#define XB_TOP      3328
#define XB_TOPGEN   3392
#define XCD_BAR_WORDS 3456
#define XB_SPIN_CAP (1u << 18)
__device__ __forceinline__ unsigned xb_ld(unsigned* p)              { return __hip_atomic_load(p, __ATOMIC_RELAXED, __HIP_MEMORY_SCOPE_AGENT); }
__device__ __forceinline__ unsigned xb_add(unsigned* p, unsigned v) { return __hip_atomic_fetch_add(p, v, __ATOMIC_RELAXED, __HIP_MEMORY_SCOPE_AGENT); }
__device__ __forceinline__ unsigned xb_xcc_id() { return (unsigned)__builtin_amdgcn_s_getreg((3 << 11) | 20) & 0xFu; }
#define XB_SPIN(cond, bar) do { unsigned _sp = 0; while (cond) { __builtin_amdgcn_s_sleep(1); \
    if ((++_sp & 255u) == 0u) { if (xb_ld(&(bar)[XB_TMO])) break; if (_sp > XB_SPIN_CAP) { atomicAdd(&(bar)[XB_TMO], 1u); break; } } } } while (0)
struct XcdBarrier { unsigned* bar; unsigned x; volatile LAS unsigned* st; int wave; };
__device__ __forceinline__ int lane_id() { return (int)__builtin_amdgcn_mbcnt_hi(~0u, __builtin_amdgcn_mbcnt_lo(~0u, 0u)); }
__device__ __forceinline__ XcdBarrier xcd_barrier_post(unsigned* bar, volatile LAS unsigned* st, int wave) {
    XcdBarrier b; b.bar = bar; b.x = xb_xcc_id(); b.st = st; b.wave = wave;
    if (wave == 0 && lane_id() == 0) (void)xb_add(&bar[XB_XCNT(b.x)], 1u);
    return b;
}
__device__ __forceinline__ void xcd_barrier_complete(unsigned* bar, unsigned x, unsigned& nloc, unsigned& nx) {
    const unsigned G = gridDim.x * gridDim.y * gridDim.z;
    unsigned sum, cnt, mine, sp = 0u;
    for (;;) {
        sum = 0u; cnt = 0u; mine = 0u;
#pragma unroll
        for (unsigned j = 0; j < 16; ++j) { const unsigned c = xb_ld(&bar[XB_XCNT(j)]); sum += c; cnt += (c > 0u) ? 1u : 0u; mine = (j == x) ? c : mine; }
        if (sum == G) break;
        __builtin_amdgcn_s_sleep(1);
        if ((++sp & 255u) == 0u) { if (xb_ld(&bar[XB_TMO])) break; if (sp > XB_SPIN_CAP) { atomicAdd(&bar[XB_TMO], 1u); break; } }
    }
    nloc = mine > 0u ? mine : 1u; nx = cnt > 0u ? cnt : 1u;
}
__device__ __forceinline__ void xcd_barrier(const XcdBarrier& b) {
    asm volatile("s_waitcnt vmcnt(0)" ::: "memory");
    __syncthreads();
    if (b.wave == 0 && lane_id() == 0) {
        unsigned* bar = b.bar;
        __builtin_amdgcn_s_waitcnt(0);
        unsigned nloc = b.st[0], nx = b.st[1];
        if (nloc == 0u) { xcd_barrier_complete(bar, b.x, nloc, nx); b.st[0] = nloc; b.st[1] = nx; }
        const unsigned old = xb_add(&bar[XB_XSUB(b.x)], 1u);
        const unsigned gen = old / nloc;
        if (old + 1u == (gen + 1u) * nloc) {
            __builtin_amdgcn_fence(__ATOMIC_RELEASE, "agent");
            asm volatile("s_waitcnt vmcnt(0)" ::: "memory");
            const unsigned og = xb_add(&bar[XB_TOP], 1u);
            const unsigned tg = og / nx;
            if (og + 1u == (tg + 1u) * nx) xb_add(&bar[XB_TOPGEN], 1u);
            else XB_SPIN(xb_ld(&bar[XB_TOPGEN]) == tg, bar);
            __builtin_amdgcn_fence(__ATOMIC_ACQUIRE, "agent");
            xb_add(&bar[XB_XGEN(b.x)], 1u);
            asm volatile("s_waitcnt vmcnt(0)" ::: "memory");
        } else {
            XB_SPIN(xb_ld(&bar[XB_XGEN(b.x)]) == gen, bar);
            __builtin_amdgcn_fence(__ATOMIC_ACQUIRE, "agent");
            asm volatile("s_waitcnt vmcnt(0)" ::: "memory");
        }
    }
    __syncthreads();
}
__device__ __forceinline__ void panel_norm(unsigned* cnt, const bf16_t* x, const float* g, const float* mod_l, int which_sh, bf16_t* h, int pm, int pn, const int tid) {
    asm volatile("s_waitcnt vmcnt(0)" ::: "memory");
    __syncthreads();
    if (tid == 0) {
        __builtin_amdgcn_fence(__ATOMIC_RELEASE, "agent");
        asm volatile("s_waitcnt vmcnt(0)" ::: "memory");
        (void)xb_add(cnt, 1u);
        unsigned sp = 0u;
        while (xb_ld(cnt) < 4u) { __builtin_amdgcn_s_sleep(1); if (++sp > (1u << 22)) break; }
        __builtin_amdgcn_fence(__ATOMIC_ACQUIRE, "agent");
        asm volatile("s_waitcnt vmcnt(0)" ::: "memory");
    }
    __syncthreads();
    const int lane = tid & 63, wave = tid >> 6;
    for (int r = 0; r < 8; r += 4) norm_rows4_bf(x, g, mod_l, which_sh, h, pm * 256 + pn * 64 + wave * 8 + r, lane);
}
constexpr int MISC_OFF = LDS_BYTES - 64;

constexpr int NPHASES = 2 + 9 * DEPTH - 1;

typedef const Args __attribute__((address_space(4))) KArgs;
template <int KMASK> __global__ void __launch_bounds__(NTHREADS, 2) fwd_kernel_t(Args a0) {
    extern __shared__ __attribute__((aligned(16))) unsigned char lds_raw[];
    lds_u8* lds = (lds_u8*)lds_raw;
    const int G = gridDim.x;
    unsigned char* ws = a0.ws;
    const int ph_lo = a0.ph_lo, ph_hi = a0.ph_hi;
    const float* mod = (const float*)(ws + WS_MOD);
    const int wave_s = __builtin_amdgcn_readfirstlane((int)(threadIdx.x >> 6));
    if (wave_s == 0 && lane_id() < 16) ((LAS unsigned*)(lds + MISC_OFF))[lane_id()] = 0u;
    __syncthreads();
    XcdBarrier bar = xcd_barrier_post((unsigned*)(ws + WS_CTL) + 4096, (volatile LAS unsigned*)(lds + MISC_OFF), wave_s);
    const bool fuse_norm = MK_ONE_LAUNCH && !PROBE_DUP && (G == 256);
    for (int ph = ph_lo; ph < ph_hi; ++ph) {
        KArgs* kap = (KArgs*)__builtin_amdgcn_kernarg_segment_ptr(); asm volatile("" : "+s"(kap));
        Args a;
#pragma unroll
        for (int i_ = 0; i_ < 17; ++i_) a.in[i_] = kap->in[i_];
        a.out = kap->out; a.ws = kap->ws; a.ph_lo = ph_lo; a.ph_hi = ph_hi;
        if (fuse_norm && ph >= 2 && ((ph - 2) % 9 == 5 || (ph - 2) % 9 == 8)) continue;
        int kbit = 0;
        if (PROBE_DUP) { if (ph == 0) kbit = 1; else if (ph == 1) kbit = 2; else { const int s_ = (ph - 2) % 9; kbit = s_ == 0 ? 4 : (s_ == 4 || s_ == 7) ? 8 : s_ == 1 ? 16 : s_ == 3 ? 32 : s_ == 6 ? 64 : s_ == 2 ? 128 : 2; } }
        const int nrep = (PROBE_DUP & kbit) ? 2 : 1;
        for (int rep = 0; rep < nrep; ++rep) {
        const bool dry = (rep + 1 < nrep); if (rep) __syncthreads();
        int tid = threadIdx.x; asm volatile("" : "+v"(tid));
        int bx = blockIdx.x; asm volatile("" : "+s"(bx));
        const int vcu = (G % 8 == 0) ? (bx % 8) * (G / 8) + bx / 8 : bx;
        if (ph == 0) { if (KMASK & 1) phase_prologue(a, lds, vcu, G, tid, bx); }
        else if (ph == 1) { if (KMASK & 2) phase_norm(a.in[I_X], a.in[I_NORMG], mod, 0, (bf16_t*)(ws + WS_H), vcu, G, tid); }
        else {
            const int l = (ph - 2) / 9, s = (ph - 2) % 9;
            const float* mod_l = mod + (size_t)l * 8 * 6144;
            if ((KMASK & 4) && s == 0) {
                const pg8::Gemm g{(const bf16_t*)(ws + WS_H), (const bf16_t*)(ws + WS_WIN) + (size_t)l * INW * DM, M, INW, DM}; const pg8::EpiStore E{(bf16_t*)(ws + WS_PROJ), INW};
                pg8::StaticOrder S; S.init(g.M, g.N, G, bx);
                pg8::gemm_phase<pg8::EpiStore, pg8::StaticOrder>(lds, g, S, E, tid);
            } else if ((KMASK & 64) && s == 6) {
                const pg8::Gemm g{(const bf16_t*)(ws + WS_H), (const bf16_t*)(ws + WS_WUP) + (size_t)l * UPW * DM, M, UPW, DM};
                const pg8::EpiConvGate E{(bf16_t*)(ws + WS_ACT), a.in[I_CONVW] + (size_t)l * 3 * UPW, a.in[I_CONVB] + (size_t)l * UPW};
                pg8::StaticOrder S; S.init(g.M, g.N, G, bx, 1);
                pg8::gemm_phase<pg8::EpiConvGate, pg8::StaticOrder>(lds, g, S, E, tid);
            } else if ((KMASK & 8) && (s == 4 || s == 7)) {
                pg8::Gemm g; pg8::EpiResid E;
                const bool nfuse = fuse_norm && !dry && !(s == 7 && l == DEPTH - 1);
                if (s == 4) { g = pg8::Gemm{(const bf16_t*)(ws + WS_MIX), (const bf16_t*)(ws + WS_WOUT) + (size_t)l * DM * DM, M, DM, DM};
                    E = pg8::EpiResid{ws, l == 0 ? a.in[I_X] : nullptr, nullptr, a.in[I_NORMG], l, 0, nfuse ? 1 : 0}; }
                else { g = pg8::Gemm{(const bf16_t*)(ws + WS_ACT), (const bf16_t*)(ws + WS_WDN) + (size_t)l * DM * FF, M, DM, FF};
                    E = pg8::EpiResid{ws, nullptr, (l == DEPTH - 1) ? a.out : nullptr, a.in[I_NORMG], l, 1, nfuse ? 1 : 0}; }
                pg8::StaticOrder S; S.init(g.M, g.N, G, bx);
                pg8::gemm_phase<pg8::EpiResid, pg8::StaticOrder>(lds, g, S, E, tid);
            } else if ((KMASK & 16) && s == 1) phase_prep(a, lds, l, vcu, G, tid, dry);
            else if ((KMASK & 16) && s == 2) { phase_scan(a, vcu, G, tid); phase_mixc(a, lds, l, vcu, G, tid); }
            else if ((KMASK & 32) && s == 3) phase_mixers(a, lds, l, vcu, G, tid);
            else if ((KMASK & 2) && s == 5) phase_norm_bf((const bf16_t*)(ws + WS_XB), a.in[I_NORMG] + (size_t)(l * 2 + 1) * DM, mod_l, 3, (bf16_t*)(ws + WS_H), vcu, G, tid);
            else if ((KMASK & 2) && s == 8) phase_norm_bf((const bf16_t*)(ws + WS_XB), a.in[I_NORMG] + (size_t)((l + 1) * 2) * DM, mod_l + 8 * 6144, 0, (bf16_t*)(ws + WS_H), vcu, G, tid);
        }
        }
        if (ph + 1 < ph_hi) { if (ph == 0) { __syncthreads(); cg::this_grid().sync(); } else xcd_barrier(bar); }
    }
}

typedef void (*kern_t)(Args);
static int phase_kind(int ph) { if (ph == 0) return 0; if (ph == 1) return 1; const int s = (ph - 2) % 9; return s == 0 ? 2 : s == 4 || s == 7 ? 3 : s == 1 || s == 2 ? 4 : s == 3 ? 5 : s == 6 ? 6 : 1; }
extern "C" void kernel_launch(void* const* d_in, const int* in_sizes, int n_in, void* d_out, int out_size, void* d_ws, size_t ws_size, hipStream_t stream) {
    static int grid = 0;
#if MK_ONE_LAUNCH
    static const kern_t kerns[1] = {fwd_kernel_t<127>}; constexpr int NK = 1;
#else
    static const kern_t kerns[7] = {fwd_kernel_t<1>, fwd_kernel_t<2>, fwd_kernel_t<4>, fwd_kernel_t<8>, fwd_kernel_t<16>, fwd_kernel_t<32>, fwd_kernel_t<64>}; constexpr int NK = 7;
#endif
    if (grid == 0) {
        if (n_in != 17 || out_size != M * DM || ws_size < WS_END) { fprintf(stderr, "kernel_launch: unexpected shapes (n_in %d, out %d, ws %zu)\n", n_in, out_size, ws_size); grid = -1; return; }
        int dev = 0, cus = 0;
        if (hipGetDevice(&dev) != hipSuccess || hipDeviceGetAttribute(&cus, hipDeviceAttributeMultiprocessorCount, dev) != hipSuccess) { grid = -1; return; }
        for (int i = 0; i < NK; ++i)
            if (hipFuncSetAttribute((const void*)kerns[i], hipFuncAttributeMaxDynamicSharedMemorySize, LDS_BYTES) != hipSuccess) { fprintf(stderr, "kernel_launch: hipFuncSetAttribute failed\n"); grid = -1; return; }
        int per_cu = 0;
        if (hipOccupancyMaxActiveBlocksPerMultiprocessor(&per_cu, (const void*)kerns[0], NTHREADS, LDS_BYTES) != hipSuccess || per_cu < 1) { fprintf(stderr, "kernel_launch: occupancy query says %d\n", per_cu); (void)hipGetLastError(); }
        grid = cus;
    }
    if (grid < 0) return;
    Args a{};
    for (int i = 0; i < 17; ++i) a.in[i] = (const float*)d_in[i];
    a.out = (float*)d_out; a.ws = (unsigned char*)d_ws;
#if MK_ONE_LAUNCH
    if (hipMemsetAsync((char*)d_ws + WS_CTL, 0, 65536, stream) != hipSuccess) { fprintf(stderr, "kernel_launch: memset failed\n"); return; }
    a.ph_lo = 0; a.ph_hi = NPHASES;
    void* args[] = {&a};
    hipError_t e = hipLaunchCooperativeKernel((const void*)kerns[0], dim3(grid), dim3(NTHREADS), args, LDS_BYTES, stream);
    if (e != hipSuccess) fprintf(stderr, "cooperative launch failed: %s (grid %d)\n", hipGetErrorString(e), grid);
#else
    for (int ph = 0; ph < NPHASES; ++ph) {
        a.ph_lo = ph; a.ph_hi = ph + 1;
        hipLaunchKernelGGL(kerns[phase_kind(ph)], dim3(grid), dim3(NTHREADS), LDS_BYTES, stream, a);
    }
#endif
}
```

```cpp
#include <hip/hip_runtime.h>
#include <hip/hip_cooperative_groups.h>
#include <cstdio>
#include <cstdint>
namespace cg = cooperative_groups;

#ifndef PROBE_DUP
#define PROBE_DUP 0
#endif
#ifndef MK_ONE_LAUNCH
#define MK_ONE_LAUNCH 1
#endif

#define LAS __attribute__((address_space(3)))
typedef unsigned short bf16_t;
typedef short bf16x8 __attribute__((ext_vector_type(8)));
typedef float f32x4 __attribute__((ext_vector_type(4)));
typedef float f32x16 __attribute__((ext_vector_type(16)));
typedef unsigned u32x4 __attribute__((ext_vector_type(4)));
typedef unsigned u32x2 __attribute__((ext_vector_type(2)));
typedef LAS unsigned char lds_u8;

constexpr int NB = 8, SEQ = 2048, DM = 1024, M = NB * SEQ, DEPTH = 4, INW = 2560, FF = 2816, UPW = 2 * FF;
constexpr float EPS = 1e-6f;
constexpr int C_AQ = 0, C_AK = 384, C_AV = 512, C_BQ = 640, C_BFF = 896, C_BFB = 1152, C_BI = 1408, C_BG = 1664, C_CQ = 1920, C_CK = 2304, C_CV = 2432;

constexpr size_t MiB = 1u << 20;
constexpr size_t WS_CTL = 0;
constexpr size_t WS_MOD = 1 * MiB;
constexpr size_t WS_ROPE = 2 * MiB;
constexpr size_t WS_WIN = 4 * MiB;
constexpr size_t WS_WOUT = 24 * MiB;
constexpr size_t WS_WUP = 32 * MiB;
constexpr size_t WS_WDN = 76 * MiB;
constexpr size_t WS_H = 98 * MiB;
constexpr size_t WS_PROJ = 130 * MiB;
constexpr size_t WS_MIX = 210 * MiB;
constexpr size_t WS_HL = 242 * MiB;
constexpr size_t WS_HD = 274 * MiB;
constexpr size_t WS_VT = 275 * MiB;
constexpr size_t WS_ACT = 190 * MiB;
constexpr size_t WS_HS = 283 * MiB;
constexpr size_t WS_PO = 300 * MiB;
constexpr size_t WS_PL = 326 * MiB;
constexpr size_t WS_XB = 332 * MiB;
constexpr size_t WS_U = 330 * MiB;
constexpr size_t WS_END = 366 * MiB;

constexpr int LDS_BYTES = 147456;
constexpr int NTHREADS = 512;

typedef float f32x2_t __attribute__((ext_vector_type(2))); typedef __bf16 bf16x2_t __attribute__((ext_vector_type(2)));
__device__ __forceinline__ unsigned pk2(float lo, float hi) { f32x2_t v = {lo, hi}; bf16x2_t b = __builtin_convertvector(v, bf16x2_t); return __builtin_bit_cast(unsigned, b); }
__device__ __forceinline__ unsigned f2bf(float f) { return pk2(f, 0.f) & 0xffffu; }
__device__ __forceinline__ float bf2f(unsigned short h) { return __builtin_bit_cast(float, (unsigned)h << 16); }
__device__ __forceinline__ float bflo(unsigned w) { return __builtin_bit_cast(float, w << 16); }
__device__ __forceinline__ float bfhi(unsigned w) { return __builtin_bit_cast(float, w & 0xffff0000u); }
__device__ __forceinline__ float wave_sum(float v) {
#pragma unroll
    for (int o = 1; o < 64; o <<= 1) v += __shfl_xor(v, o);
    return v;
}
__device__ __forceinline__ float fast_exp2(float x) { return __builtin_amdgcn_exp2f(x); }
__device__ __forceinline__ float fast_exp(float x) { return __builtin_amdgcn_exp2f(x * 1.4426950408889634f); }
__device__ __forceinline__ float silu_f(float x) { return x * __builtin_amdgcn_rcpf(1.0f + fast_exp2(-1.4426950408889634f * x)); }

__device__ __forceinline__ float dpp_ror1(float v) { return __builtin_bit_cast(float, __builtin_amdgcn_update_dpp(0, __builtin_bit_cast(int, v), 0x121, 0xf, 0xf, true)); }
__device__ __forceinline__ float dpp_ror15(float v) { return __builtin_bit_cast(float, __builtin_amdgcn_update_dpp(0, __builtin_bit_cast(int, v), 0x12f, 0xf, 0xf, true)); }
__device__ __forceinline__ float dpp_shr1(float old, float v) { return __builtin_bit_cast(float, __builtin_amdgcn_update_dpp(__builtin_bit_cast(int, old), __builtin_bit_cast(int, v), 0x111, 0xf, 0xf, false)); }
__device__ __forceinline__ float dpp_shl1(float old, float v) { return __builtin_bit_cast(float, __builtin_amdgcn_update_dpp(__builtin_bit_cast(int, old), __builtin_bit_cast(int, v), 0x101, 0xf, 0xf, false)); }

namespace pg8 {
constexpr int BM = 256, BK = 64, HALF = 128, HTB = HALF * BK * 2, STAGE_BYTES = 8 * HTB, NXCD = 8, WGM = 8;
__host__ __device__ __forceinline__ int lds_byte(int r, int c) { const int st = (r >> 4) * 2 + (c >> 5), rr = r & 15, cc = c & 31, ob = rr * 64 + cc * 2; return st * 1024 + (ob ^ (((ob >> 9) & 1) << 5)); }
__host__ __device__ __forceinline__ void stage_rc(int b, int& R, int& C) { const int st = b / 1024, sb = b % 1024, swz = sb ^ (((sb >> 9) & 1) << 5); R = (st >> 1) * 16 + swz / 64; C = (st & 1) * 32 + (swz % 64) / 2; }
__host__ __device__ __forceinline__ int perm32(int rho) { const int n = rho >> 4, i = rho & 15; return 8 * (i >> 2) + 4 * n + (i & 3); }

struct Unit { int pm, pn, ar; };
struct Gemm { const bf16_t* A; const bf16_t* Bt; int M, N, K; };

struct StaticOrder {
    int nM, nN, nwg, G, c, conv, Mrows;
    __host__ __device__ void init(int M_, int N_, int G_, int c_, int conv_ = 0) { conv = conv_; Mrows = M_; nM = conv_ ? (M_ + 253) / 254 : M_ / BM; nN = N_ / BM; nwg = nM * nN; G = G_; c = c_; }
    __host__ __device__ bool next(int i, Unit& u) const {
        const long L = (long)i * G + c; if (L >= nwg) return false;
        int wgid = (int)L; { const int q = nwg / NXCD, r = nwg % NXCD, xcd = wgid % NXCD, off = wgid / NXCD; wgid = (xcd < r ? xcd * (q + 1) : r * (q + 1) + (xcd - r) * q) + off; }
        const int nig = WGM * nN, gid = wgid / nig, fm = gid * WGM, gsz = (nM - fm) < WGM ? (nM - fm) : WGM;
        u.pm = fm + ((wgid % nig) % gsz); u.pn = (wgid % nig) / gsz;
        if (conv) { int s = 254 * u.pm - 1; s = s < 0 ? 0 : s; u.ar = s > Mrows - BM ? Mrows - BM : s; } else u.ar = u.pm * BM;
        return true;
    }
};

struct EpiStore {
    static constexpr bool PERM = true;
    bf16_t* O; int ldc;
    __device__ __forceinline__ void operator()(const f32x4 (&acc)[2][2][4][2], const Unit& u, int wr, int wc, int fr, int fq, lds_u8*) const {
        const int row0 = u.pm * BM + wr * 64 + fr, col0 = u.pn * BM + wc * 32 + 8 * fq;
#pragma unroll
        for (int ai = 0; ai < 2; ++ai)
#pragma unroll
            for (int m = 0; m < 4; ++m) { bf16_t* rowp = O + (size_t)(row0 + ai * HALF + m * 16) * ldc + col0;
#pragma unroll
                for (int bj = 0; bj < 2; ++bj) { const f32x4 v0 = acc[ai][bj][m][0], v1 = acc[ai][bj][m][1];
                    u32x4 w; w.x = pk2(v0[0], v0[1]); w.y = pk2(v0[2], v0[3]); w.z = pk2(v1[0], v1[1]); w.w = pk2(v1[2], v1[3]);
                    *(u32x4*)(rowp + bj * HALF) = w; } }
    }
};
struct EpiResid {
    static constexpr bool PERM = true;
    unsigned char* ws; const float* xin32; float* out32; const float* normg;
    int l, second, nfuse;
    __device__ __forceinline__ void operator()(f32x4 (&acc)[2][2][4][2], const Unit& u, int wr, int wc, int fr, int fq, lds_u8* lds) const {
        const int col0 = u.pn * BM + wc * 32 + 8 * fq;
        const int bidx = (u.pm * BM) / SEQ;
        bf16_t* const xb16 = (bf16_t*)(ws + WS_XB);
        const float* const modl = (const float*)(ws + WS_MOD) + (size_t)l * 8 * 6144;
        const float* const gate = modl + (second ? 5 : 2) * DM;
        const float* const ng = normg + (size_t)(second ? (l + 1) * 2 : l * 2 + 1) * DM;
        const float* const nmod = second ? modl + 8 * 6144 : modl + 3 * DM;
        const int nidx = nfuse ? l * 2 + second : -1;
        const float* gb = gate + (size_t)bidx * 6144 + col0;
        f32x4 gv[2][2];
#pragma unroll
        for (int bj = 0; bj < 2; ++bj)
#pragma unroll
            for (int n = 0; n < 2; ++n) gv[bj][n] = *(const f32x4*)(gb + bj * HALF + 4 * n);
#pragma unroll
        for (int ai = 0; ai < 2; ++ai)
#pragma unroll
            for (int m = 0; m < 4; ++m) { const size_t off = (size_t)(u.pm * BM + ai * HALF + wr * 64 + m * 16 + fr) * DM + col0;
#pragma unroll
                for (int bj = 0; bj < 2; ++bj) {
                    f32x4 x0, x1;
                    if (xin32) { x0 = *(const f32x4*)(xin32 + off + bj * HALF); x1 = *(const f32x4*)(xin32 + off + bj * HALF + 4); }
                    else { const u32x4 w = *(const u32x4*)(xb16 + off + bj * HALF); x0 = (f32x4){bflo(w.x), bfhi(w.x), bflo(w.y), bfhi(w.y)}; x1 = (f32x4){bflo(w.z), bfhi(w.z), bflo(w.w), bfhi(w.w)}; }
                    const f32x4 y0 = x0 + gv[bj][0] * acc[ai][bj][m][0], y1 = x1 + gv[bj][1] * acc[ai][bj][m][1];
                    acc[ai][bj][m][0] = y0; acc[ai][bj][m][1] = y1;
                    if (out32) { __builtin_nontemporal_store(y0, (f32x4*)(out32 + off + bj * HALF)); __builtin_nontemporal_store(y1, (f32x4*)(out32 + off + bj * HALF + 4)); }
                    else { u32x4 w; w.x = pk2(y0[0], y0[1]); w.y = pk2(y0[2], y0[3]); w.z = pk2(y1[0], y1[1]); w.w = pk2(y1[2], y1[3]); *(u32x4*)(xb16 + off + bj * HALF) = w; }
                } }
        if (nidx < 0) return;
        asm volatile("" : "+v"(fr), "+v"(fq));
        bf16_t* const hn = (bf16_t*)(ws + WS_H); float* const slots = (float*)(ws + WS_CTL + 512 * 1024); unsigned* const cnt = (unsigned*)(ws + WS_CTL) + 8192 + nidx * 1024;
        LAS float* P = (LAS float*)(lds + STAGE_BYTES);
        LAS float* S = P + 1024;
#pragma unroll
        for (int ai = 0; ai < 2; ++ai)
#pragma unroll
            for (int m = 0; m < 4; ++m) { float s = 0.f;
#pragma unroll
                for (int bj = 0; bj < 2; ++bj)
#pragma unroll
                    for (int n = 0; n < 2; ++n) { const f32x4 v = acc[ai][bj][m][n]; s += (v[0] * v[0] + v[1] * v[1]) + (v[2] * v[2] + v[3] * v[3]); }
                s += __shfl_xor(s, 16); s += __shfl_xor(s, 32);
                if (fq == 0) P[(ai * HALF + wr * 64 + m * 16 + fr) * 4 + wc] = s; }
        asm volatile("s_waitcnt lgkmcnt(0)" ::: "memory"); __builtin_amdgcn_s_barrier(); asm volatile("" ::: "memory");
        const int tid = (wr * 4 + wc) * 64 + fr + 16 * fq;
        unsigned* slot_u = (unsigned*)slots + ((size_t)u.pm * BM) * 4;
        if (tid < 256) { const float t = (P[tid * 4] + P[tid * 4 + 1]) + (P[tid * 4 + 2] + P[tid * 4 + 3]);
            __hip_atomic_store(slot_u + tid * 4 + u.pn, __builtin_bit_cast(unsigned, t), __ATOMIC_RELAXED, __HIP_MEMORY_SCOPE_AGENT); }
        asm volatile("s_waitcnt vmcnt(0)" ::: "memory"); __builtin_amdgcn_s_barrier(); asm volatile("" ::: "memory");
        if (tid == 0) {
            unsigned* c = cnt + u.pm * 16;
            __builtin_amdgcn_fence(__ATOMIC_RELEASE, "agent");
            asm volatile("s_waitcnt vmcnt(0)" ::: "memory");
            (void)__hip_atomic_fetch_add(c, 1u, __ATOMIC_RELAXED, __HIP_MEMORY_SCOPE_AGENT);
            unsigned sp = 0u;
            while (__hip_atomic_load(c, __ATOMIC_RELAXED, __HIP_MEMORY_SCOPE_AGENT) < 4u) { __builtin_amdgcn_s_sleep(1); if (++sp > (1u << 22)) break; }
            __builtin_amdgcn_fence(__ATOMIC_ACQUIRE, "agent");
            asm volatile("s_waitcnt vmcnt(0)" ::: "memory");
        }
        __builtin_amdgcn_s_barrier(); asm volatile("" ::: "memory");
        if (tid < 256) { float t = 0.f;
#pragma unroll
            for (int p = 0; p < 4; ++p) t += __builtin_bit_cast(float, __hip_atomic_load(slot_u + tid * 4 + p, __ATOMIC_RELAXED, __HIP_MEMORY_SCOPE_AGENT));
            S[tid] = rsqrtf(t * (1.f / DM) + EPS); }
        asm volatile("s_waitcnt lgkmcnt(0)" ::: "memory"); __builtin_amdgcn_s_barrier(); asm volatile("" ::: "memory");
        const float* shp = nmod + (size_t)bidx * 6144 + col0; const float* scp = shp + DM; const float* gp = ng + col0;
#pragma unroll
        for (int bj = 0; bj < 2; ++bj)
#pragma unroll
            for (int n = 0; n < 2; ++n) {
                const f32x4 gn = *(const f32x4*)(gp + bj * HALF + 4 * n) * (*(const f32x4*)(scp + bj * HALF + 4 * n) + 1.0f), sn = *(const f32x4*)(shp + bj * HALF + 4 * n);
#pragma unroll
                for (int ai = 0; ai < 2; ++ai)
#pragma unroll
                    for (int m = 0; m < 4; ++m) { const int rl = ai * HALF + wr * 64 + m * 16 + fr; const float rstd = S[rl];
                        const f32x4 h0 = acc[ai][bj][m][n] * rstd * gn + sn;
                        u32x2 w; w.x = pk2(h0[0], h0[1]); w.y = pk2(h0[2], h0[3]);
                        *(u32x2*)(hn + (size_t)(u.pm * BM + rl) * DM + col0 + bj * HALF + 4 * n) = w; }
            }
    }
};

struct EpiConvGate {
    static constexpr bool PERM = true;
    bf16_t* act; const float* cw; const float* cb;
    __device__ __forceinline__ void operator()(const f32x4 (&acc)[2][2][4][2], const Unit& u, int wr, int wc, int fr, int fq, lds_u8* lds) const {
        LAS float* xch = (LAS float*)(lds + STAGE_BYTES);
        int colw = wc * 32 + 8 * fq; asm volatile("" : "+v"(colw));
#pragma unroll
        for (int ai = 0; ai < 2; ++ai) { const int rho = 2 * ai + wr;
#pragma unroll
            for (int bj = 0; bj < 2; ++bj)
#pragma unroll
                for (int n = 0; n < 2; ++n) {
                    if (fr == 0) *(LAS f32x4*)(xch + (rho * 2) * 256 + bj * 128 + colw + 4 * n) = acc[ai][bj][0][n];
                    if (fr == 15) *(LAS f32x4*)(xch + (rho * 2 + 1) * 256 + bj * 128 + colw + 4 * n) = acc[ai][bj][3][n]; } }
        asm volatile("s_waitcnt lgkmcnt(0)" ::: "memory"); __builtin_amdgcn_s_barrier(); asm volatile("" ::: "memory");
        const int jcol = u.pn * 128 + colw;
        const int olo = 254 * u.pm, ohi = (olo + 254 < M) ? olo + 254 : M;
#pragma unroll
        for (int n = 0; n < 2; ++n) {
            const int ja = jcol + 4 * n, jb = FF + ja;
            const f32x4 wa0 = *(const f32x4*)(cw + ja), wa1 = *(const f32x4*)(cw + UPW + ja), wa2 = *(const f32x4*)(cw + 2 * UPW + ja), ba = *(const f32x4*)(cb + ja);
            const f32x4 wb0 = *(const f32x4*)(cw + jb), wb1 = *(const f32x4*)(cw + UPW + jb), wb2 = *(const f32x4*)(cw + 2 * UPW + jb), bb = *(const f32x4*)(cb + jb);
#pragma unroll
            for (int ai = 0; ai < 2; ++ai) {
                const int rho = 2 * ai + wr;
                const f32x4 z4 = (f32x4){0.f, 0.f, 0.f, 0.f};
#pragma unroll
                for (int m = 0; m < 4; ++m) {
                    f32x4 Xa = z4, Xb = z4, Ya = z4, Yb = z4;
                    if (m == 0 && rho > 0) { Xa = *(const LAS f32x4*)(xch + ((rho - 1) * 2 + 1) * 256 + colw + 4 * n); Xb = *(const LAS f32x4*)(xch + ((rho - 1) * 2 + 1) * 256 + 128 + colw + 4 * n); }
                    if (m == 3 && rho < 3) { Ya = *(const LAS f32x4*)(xch + ((rho + 1) * 2) * 256 + colw + 4 * n); Yb = *(const LAS f32x4*)(xch + ((rho + 1) * 2) * 256 + 128 + colw + 4 * n); }
                    const int gr = u.ar + ai * HALF + wr * 64 + m * 16 + fr;
                    const int t = gr & (SEQ - 1);
                    const bool hasp = t != 0, hasn = t != SEQ - 1;
                    const f32x4 va = acc[ai][0][m][n], vb = acc[ai][1][m][n];
                    f32x4 pa, pb, na, nb;
#pragma unroll
                    for (int j = 0; j < 4; ++j) {
                        pa[j] = dpp_shr1(m > 0 ? dpp_ror1(acc[ai][0][m > 0 ? m - 1 : 0][n][j]) : Xa[j], va[j]);
                        pb[j] = dpp_shr1(m > 0 ? dpp_ror1(acc[ai][1][m > 0 ? m - 1 : 0][n][j]) : Xb[j], vb[j]);
                        na[j] = dpp_shl1(m < 3 ? dpp_ror15(acc[ai][0][m < 3 ? m + 1 : 3][n][j]) : Ya[j], va[j]);
                        nb[j] = dpp_shl1(m < 3 ? dpp_ror15(acc[ai][1][m < 3 ? m + 1 : 3][n][j]) : Yb[j], vb[j]);
                    }
                    const float fp = hasp ? 1.0f : 0.0f, fn = hasn ? 1.0f : 0.0f;
                    const f32x4 ca = ba + (wa0 * fp) * pa + wa1 * va + (wa2 * fn) * na;
                    const f32x4 cbv = bb + (wb0 * fp) * pb + wb1 * vb + (wb2 * fn) * nb;
                    const f32x4 ex = ca * -1.4426950408889634f;
                    f32x4 sg;
#pragma unroll
                    for (int j = 0; j < 4; ++j) sg[j] = __builtin_amdgcn_rcpf(1.0f + fast_exp2(ex[j]));
                    const f32x4 r = ca * sg * cbv;
                    if (gr >= olo && gr < ohi) { u32x2 w; w.x = pk2(r[0], r[1]); w.y = pk2(r[2], r[3]); *(u32x2*)(act + (size_t)gr * FF + ja) = w; }
                }
            }
        }
    }
};

template <class Epi, class Sched>
__device__ __forceinline__ void gemm_phase(lds_u8* lds, const Gemm g, const Sched& S, const Epi& E, const int tid) {
    const int wid = __builtin_amdgcn_readfirstlane(tid >> 6), lane = tid & 63, wr = wid >> 2, wc = wid & 3, fr = lane & 15, fq = lane >> 4;
    const int K = g.K, nt = K / BK;
    unsigned voffA[2], voffB[2];
#pragma unroll
    for (int i = 0; i < 2; ++i) { int R, C; stage_rc(tid * 16 + i * 8192, R, C); const int Rb = Epi::PERM ? ((R & ~31) + perm32(R & 31)) : R;
        voffA[i] = (unsigned)(R * K + C) * 2u; voffB[i] = (unsigned)(Rb * K + C) * 2u; }
    const size_t kstep = (size_t)(BK * 2);
    const size_t hstep = (size_t)HALF * K * 2;
    const size_t tstep = 2 * hstep;
    const unsigned ldsw = (unsigned)wid * 1024u;
    const int aoff = lds_byte(wr * 64 + fr, fq * 8), boff = lds_byte(wc * 32 + fr, fq * 8);
#define PG8_SA(b, h) (((b) * 2 + (h)) * HTB)
#define PG8_SB(b, h) ((4 + (b) * 2 + (h)) * HTB)
#define PG8_STAGE(bufoff, gbase, voff) do { _Pragma("unroll") for (int _i = 0; _i < 2; ++_i) \
        __builtin_amdgcn_global_load_lds((const unsigned*)((const char*)(gbase) + (voff)[_i]), (LAS unsigned*)(lds + (bufoff) + ldsw + _i * 8192), 16, 0, 0); } while (0)
#define PG8_LDA(dst, b, h) do { _Pragma("unroll") for (int m = 0; m < 4; ++m) _Pragma("unroll") for (int k = 0; k < 2; ++k) dst[m][k] = *(const LAS bf16x8*)(lds + PG8_SA(b, h) + aoff + m * 2048 + k * 1024); } while (0)
#define PG8_LDB(dst, b, h) do { _Pragma("unroll") for (int n = 0; n < 2; ++n) _Pragma("unroll") for (int k = 0; k < 2; ++k) dst[n][k] = *(const LAS bf16x8*)(lds + PG8_SB(b, h) + boff + n * 2048 + k * 1024); } while (0)
#define PG8_MMA(ai, bj, At, Bt) do { __builtin_amdgcn_s_setprio(1); _Pragma("unroll") for (int m = 0; m < 4; ++m) _Pragma("unroll") for (int n = 0; n < 2; ++n) _Pragma("unroll") for (int k = 0; k < 2; ++k) \
        acc[ai][bj][m][n] = __builtin_amdgcn_mfma_f32_16x16x32_bf16(Bt[n][k], At[m][k], acc[ai][bj][m][n], 0, 0, 0); __builtin_amdgcn_s_setprio(0); } while (0)
#define PG8_WAIT_V(n) asm volatile("s_waitcnt vmcnt(" #n ")" ::: "memory")
#define PG8_WAIT_L(n) asm volatile("s_waitcnt lgkmcnt(" #n ")" ::: "memory")
#define PG8_BAR __builtin_amdgcn_s_barrier()
#define PG8_SCHED __builtin_amdgcn_sched_barrier(0)
    Unit cur, nxt; int ui = 0;
    if (!S.next(0, cur)) return;
    f32x4 acc[2][2][4][2];
#pragma unroll
    for (int a = 0; a < 2; ++a)
#pragma unroll
        for (int b = 0; b < 2; ++b)
#pragma unroll
            for (int m = 0; m < 4; ++m)
#pragma unroll
                for (int n = 0; n < 2; ++n) acc[a][b][m][n] = (f32x4){0.f, 0.f, 0.f, 0.f};
    bf16x8 At[4][2], B0[2][2], B1[2][2];
    const char* cA = (const char*)g.A + (size_t)cur.ar * (size_t)(K * 2); const char* cB = (const char*)g.Bt + (size_t)cur.pn * tstep;
    PG8_STAGE(PG8_SB(0, 0), cB, voffB); PG8_STAGE(PG8_SB(0, 1), cB + hstep, voffB); PG8_STAGE(PG8_SA(0, 0), cA, voffA); PG8_STAGE(PG8_SA(0, 1), cA + hstep, voffA);
    if (wr == 1) PG8_BAR;
    PG8_WAIT_V(2); PG8_BAR;
    PG8_STAGE(PG8_SB(1, 0), cB + kstep, voffB); PG8_STAGE(PG8_SA(1, 0), cA + kstep, voffA); PG8_STAGE(PG8_SB(1, 1), cB + hstep + kstep, voffB);
    PG8_WAIT_V(6); PG8_BAR;
    for (;;) {
        const bool has_next = S.next(ui + 1, nxt);
        const char* nA = has_next ? (const char*)g.A + (size_t)nxt.ar * (size_t)(K * 2) : cA; const char* nB = has_next ? (const char*)g.Bt + (size_t)nxt.pn * tstep : cB;
        for (int t = 0; t < nt; t += 2) {
            const bool last = (t == nt - 2);
            const char* a1 = cA + (size_t)(t + 1) * kstep;
            const char* a2 = last ? nA : cA + (size_t)(t + 2) * kstep; const char* b2 = last ? nB : cB + (size_t)(t + 2) * kstep;
            const char* a3 = a2 + kstep; const char* b3 = b2 + kstep;
            PG8_LDB(B0, 0, 0); PG8_LDB(B1, 0, 1); PG8_SCHED; PG8_LDA(At, 0, 0); PG8_STAGE(PG8_SA(1, 1), a1 + hstep, voffA);
            PG8_WAIT_V(8); PG8_WAIT_L(0); PG8_BAR; PG8_MMA(0, 0, At, B0); PG8_MMA(0, 1, At, B1); PG8_BAR; PG8_SCHED;
            PG8_LDA(At, 0, 1); PG8_STAGE(PG8_SB(0, 0), b2, voffB); PG8_STAGE(PG8_SB(0, 1), b2 + hstep, voffB); PG8_STAGE(PG8_SA(0, 0), a2, voffA);
            PG8_WAIT_V(8); PG8_WAIT_L(0); PG8_BAR; PG8_MMA(1, 0, At, B0); PG8_MMA(1, 1, At, B1); PG8_BAR; PG8_SCHED;
            PG8_LDB(B0, 1, 0); PG8_LDB(B1, 1, 1); PG8_SCHED; PG8_LDA(At, 1, 0); PG8_STAGE(PG8_SA(0, 1), a2 + hstep, voffA);
            PG8_WAIT_V(8); PG8_WAIT_L(0); PG8_BAR; PG8_MMA(0, 0, At, B0); PG8_MMA(0, 1, At, B1); PG8_BAR; PG8_SCHED;
            PG8_LDA(At, 1, 1); PG8_STAGE(PG8_SB(1, 0), b3, voffB); PG8_STAGE(PG8_SB(1, 1), b3 + hstep, voffB); PG8_STAGE(PG8_SA(1, 0), a3, voffA);
            PG8_WAIT_V(8); PG8_WAIT_L(0); PG8_BAR; PG8_MMA(1, 0, At, B0); PG8_MMA(1, 1, At, B1); PG8_BAR; PG8_SCHED;
        }
        if (wr == 0) PG8_BAR;
        E(acc, cur, wr, wc, fr, fq, lds);
        if (!has_next) break;
#pragma unroll
        for (int a = 0; a < 2; ++a)
#pragma unroll
            for (int b = 0; b < 2; ++b)
#pragma unroll
                for (int m = 0; m < 4; ++m)
#pragma unroll
                    for (int n = 0; n < 2; ++n) acc[a][b][m][n] = (f32x4){0.f, 0.f, 0.f, 0.f};
        cur = nxt; cA = nA; cB = nB; ++ui;
        if (wr == 1) PG8_BAR;
    }
    PG8_WAIT_V(0);
    PG8_BAR;
#undef PG8_SA
#undef PG8_SB
#undef PG8_STAGE
#undef PG8_LDA
#undef PG8_LDB
#undef PG8_MMA
#undef PG8_WAIT_V
#undef PG8_WAIT_L
#undef PG8_BAR
#undef PG8_SCHED
}
}

struct Args {
    const float* in[17];
    float* out; unsigned char* ws;
    int ph_lo, ph_hi;
};
enum { I_X = 0, I_C, I_WADA, I_BADA, I_NORMG, I_WIN, I_AQN, I_AKN, I_BLB, I_BON, I_CQN, I_CKN, I_WOUT, I_WUP, I_CONVW, I_CONVB, I_WDOWN };

__device__ __forceinline__ void p0_transpose_item(const float* W, int K, int N, bf16_t* WT, int mode, LAS float* scr, int item, int lane) {
    const int nblk = N / 32, kb = item / nblk, nb = item % nblk, k0 = 64 * kb, n0 = 32 * nb;
    int rbase = n0;
    if (mode == 1) { const int isb = n0 / FF, j0 = n0 % FF; rbase = 256 * (j0 / 128) + (j0 % 128) + 128 * isb; }
    { float tmp[32];
#pragma unroll
      for (int i = 0; i < 32; ++i) { const int kk = 2 * i + (lane >> 5); tmp[i] = __builtin_nontemporal_load(&W[(size_t)(k0 + kk) * N + n0 + (lane & 31)]); }
#pragma unroll
      for (int i = 0; i < 32; ++i) { const int kk = 2 * i + (lane >> 5); scr[kk * 33 + (lane & 31)] = tmp[i]; } }
    asm volatile("s_waitcnt lgkmcnt(0)" ::: "memory");
    const int c = lane & 7;
#pragma unroll
    for (int j = 0; j < 4; ++j) { const int n = (lane >> 3) + 8 * j; const LAS float* s = scr + (8 * c) * 33 + n;
        u32x4 o; o.x = pk2(s[0 * 33], s[1 * 33]); o.y = pk2(s[2 * 33], s[3 * 33]); o.z = pk2(s[4 * 33], s[5 * 33]); o.w = pk2(s[6 * 33], s[7 * 33]);
        *(u32x4*)(WT + (size_t)(rbase + n) * K + k0 + 8 * c) = o; }
    asm volatile("s_waitcnt lgkmcnt(0)" ::: "memory");
}

__device__ __forceinline__ void phase_prologue(const Args& a, lds_u8* lds, int vcu, int G, const int tid, const int bx) {
    const int lane = tid & 63, wave = tid >> 6;
    unsigned char* ws = a.ws;
    if (bx == 0) {
        float* tb = (float*)(ws + WS_ROPE);
        for (int e = tid; e < 1024; e += NTHREADS) { const int pos = e >> 4, i = e & 15; const float inv = exp2f(-(float)i * (13.287712379549449f / 16.0f)); const float ang = (float)pos * inv;
            tb[2 * e] = cosf(ang); tb[2 * e + 1] = sinf(ang); }
    }
    {
        LAS float* sc = (LAS float*)(lds + 0);
        LAS float* red = (LAS float*)(lds + 32768);
        bool have = false;
        for (int it = vcu; it < DEPTH * 96; it += G) {
            if (!have) { const float* c = a.in[I_C];
                for (int e = tid; e < NB * DM; e += NTHREADS) { const int b = e >> 10, k = e & 1023; sc[k * 8 + b] = silu_f(c[e]); }
                have = true; __syncthreads(); }
            const int l = it / 96, n0 = 64 * (it % 96);
            const float* wp = a.in[I_WADA] + ((size_t)l * DM + 128 * wave) * 6144 + n0 + lane;
            float acc[8];
#pragma unroll
            for (int b = 0; b < 8; ++b) acc[b] = 0.f;
#pragma unroll 32
            for (int kk = 0; kk < 128; ++kk) { const float wv = __builtin_nontemporal_load(&wp[(size_t)kk * 6144]); const LAS f32x4* s4 = (const LAS f32x4*)(sc + (128 * wave + kk) * 8); const f32x4 s0 = s4[0], s1 = s4[1];
                acc[0] += s0[0] * wv; acc[1] += s0[1] * wv; acc[2] += s0[2] * wv; acc[3] += s0[3] * wv; acc[4] += s1[0] * wv; acc[5] += s1[1] * wv; acc[6] += s1[2] * wv; acc[7] += s1[3] * wv; }
#pragma unroll
            for (int b = 0; b < 8; ++b) red[(wave * 8 + b) * 64 + lane] = acc[b];
            __syncthreads();
            { const int b = tid >> 6, col = tid & 63; float s = 0.f;
#pragma unroll
              for (int w = 0; w < 8; ++w) s += red[(w * 8 + b) * 64 + col];
              ((float*)(ws + WS_MOD))[((size_t)l * 8 + b) * 6144 + n0 + col] = s + a.in[I_BADA][(size_t)l * 6144 + n0 + col]; }
            __syncthreads();
        }
        __syncthreads();
    }
    {
        LAS float* scr = (LAS float*)(lds + wave * 8448);
        const int gw = vcu * 8 + wave, NGW = G * 8;
        constexpr int I_IN = 16 * (INW / 32), I_OUT = 16 * (DM / 32), I_UP = 16 * (UPW / 32), I_DN = (FF / 64) * (DM / 32), I_LAYER = I_IN + I_OUT + I_UP + I_DN;
        for (int it = gw; it < DEPTH * I_LAYER; it += NGW) {
            const int l = it / I_LAYER; int r = it % I_LAYER;
            if (r < I_IN) { p0_transpose_item(a.in[I_WIN] + (size_t)l * DM * INW, DM, INW, (bf16_t*)(ws + WS_WIN) + (size_t)l * INW * DM, 0, scr, r, lane); continue; } r -= I_IN;
            if (r < I_OUT) { p0_transpose_item(a.in[I_WOUT] + (size_t)l * DM * DM, DM, DM, (bf16_t*)(ws + WS_WOUT) + (size_t)l * DM * DM, 0, scr, r, lane); continue; } r -= I_OUT;
            if (r < I_UP) { p0_transpose_item(a.in[I_WUP] + (size_t)l * DM * UPW, DM, UPW, (bf16_t*)(ws + WS_WUP) + (size_t)l * UPW * DM, 1, scr, r, lane); continue; } r -= I_UP;
            p0_transpose_item(a.in[I_WDOWN] + (size_t)l * FF * DM, FF, DM, (bf16_t*)(ws + WS_WDN) + (size_t)l * DM * FF, 0, scr, r, lane);
        }
    }
}

__device__ __forceinline__ void norm_rows4(const float* x, const float* g, const float* mod_l  , int which_sh, bf16_t* h, int m0, int lane) {
    const int b = m0 / SEQ;
    const f32x4* gr = (const f32x4*)g + lane;
    const f32x4* shr = (const f32x4*)(mod_l + (size_t)b * 6144 + which_sh * DM) + lane;
    const f32x4* scr = (const f32x4*)(mod_l + (size_t)b * 6144 + (which_sh + 1) * DM) + lane;
    f32x4 v[4][4];
#pragma unroll
    for (int r = 0; r < 4; ++r) { const f32x4* xr = (const f32x4*)(x + (size_t)(m0 + r) * DM) + lane;
#pragma unroll
        for (int j = 0; j < 4; ++j) v[r][j] = xr[64 * j]; }
    f32x4 gs[4], sh[4];
#pragma unroll
    for (int j = 0; j < 4; ++j) { gs[j] = gr[64 * j] * (scr[64 * j] + 1.0f); sh[j] = shr[64 * j]; }
#pragma unroll
    for (int r = 0; r < 4; ++r) {
        float s = 0.f;
#pragma unroll
        for (int j = 0; j < 4; ++j) s += (v[r][j].x * v[r][j].x + v[r][j].y * v[r][j].y) + (v[r][j].z * v[r][j].z + v[r][j].w * v[r][j].w);
        const float rstd = rsqrtf(wave_sum(s) * (1.f / DM) + EPS);
        u32x2* o8 = (u32x2*)(h + (size_t)(m0 + r) * DM) + lane;
#pragma unroll
        for (int j = 0; j < 4; ++j) { const f32x4 y = v[r][j] * rstd * gs[j] + sh[j];
            u32x2 w; w.x = pk2(y.x, y.y); w.y = pk2(y.z, y.w); o8[64 * j] = w; }
    }
}
__device__ __forceinline__ void norm_rows4_bf(const bf16_t* x, const float* g, const float* mod_l  , int which_sh, bf16_t* h, int m0, int lane) {
    const int b = m0 / SEQ;
    const float* shp = mod_l + (size_t)b * 6144 + which_sh * DM; const float* scp = shp + DM;
    u32x4 raw[4][2];
#pragma unroll
    for (int r = 0; r < 4; ++r) { const u32x4* xr = (const u32x4*)(x + (size_t)(m0 + r) * DM) + lane; raw[r][0] = xr[0]; raw[r][1] = xr[64]; }
    f32x4 gs[2][2], sh[2][2];
#pragma unroll
    for (int c = 0; c < 2; ++c)
#pragma unroll
        for (int q = 0; q < 2; ++q) { const int col = 512 * c + 8 * lane + 4 * q; gs[c][q] = *(const f32x4*)(g + col) * (*(const f32x4*)(scp + col) + 1.0f); sh[c][q] = *(const f32x4*)(shp + col); }
#pragma unroll
    for (int r = 0; r < 4; ++r) {
        f32x4 v[2][2]; float s = 0.f;
#pragma unroll
        for (int c = 0; c < 2; ++c) { const u32x4 w = raw[r][c]; v[c][0] = (f32x4){bflo(w.x), bfhi(w.x), bflo(w.y), bfhi(w.y)}; v[c][1] = (f32x4){bflo(w.z), bfhi(w.z), bflo(w.w), bfhi(w.w)};
#pragma unroll
            for (int q = 0; q < 2; ++q) s += (v[c][q].x * v[c][q].x + v[c][q].y * v[c][q].y) + (v[c][q].z * v[c][q].z + v[c][q].w * v[c][q].w); }
        const float rstd = rsqrtf(wave_sum(s) * (1.f / DM) + EPS);
        u32x4* o16 = (u32x4*)(h + (size_t)(m0 + r) * DM) + lane;
#pragma unroll
        for (int c = 0; c < 2; ++c) { const f32x4 y0 = v[c][0] * rstd * gs[c][0] + sh[c][0], y1 = v[c][1] * rstd * gs[c][1] + sh[c][1];
            u32x4 w; w.x = pk2(y0.x, y0.y); w.y = pk2(y0.z, y0.w); w.z = pk2(y1.x, y1.y); w.w = pk2(y1.z, y1.w); o16[64 * c] = w; }
    }
}
__device__ __forceinline__ void phase_norm_bf(const bf16_t* x, const float* g, const float* mod_l, int which_sh, bf16_t* h, int vcu, int G, const int tid) {
    const int lane = tid & 63, wave = tid >> 6;
    const int gw = vcu * 8 + wave, NGW = G * 8;
    for (int m0 = gw * 4; m0 < M; m0 += NGW * 4) norm_rows4_bf(x, g, mod_l, which_sh, h, m0, lane);
}
__device__ __forceinline__ void phase_norm(const float* x, const float* g, const float* mod_l, int which_sh, bf16_t* h, int vcu, int G, const int tid) {
    const int lane = tid & 63, wave = tid >> 6;
    const int gw = vcu * 8 + wave, NGW = G * 8;
    for (int m0 = gw * 4; m0 < M; m0 += NGW * 4) norm_rows4(x, g, mod_l, which_sh, h, m0, lane);
}

__device__ __forceinline__ float hgrn_lb(const float* b_lb, int dir, int l, int col) {
    const float* p = b_lb + (size_t)dir * DEPTH * 256 + col;
    const float v0 = p[0], v1 = p[256], v2 = p[512], v3 = p[768];
    const float mx = fmaxf(fmaxf(v0, v1), fmaxf(v2, v3));
    const float e0 = __expf(v0 - mx), e1 = __expf(v1 - mx), e2 = __expf(v2 - mx), e3 = __expf(v3 - mx);
    const float s = e0 + e1 + e2 + e3;
    float acc = 0.f; if (l >= 1) acc += e1; if (l >= 2) acc += e2; if (l >= 3) acc += e3;
    return acc / s;
}
__device__ __forceinline__ void hgrn_fk(float xpre, float lb, float& lf, float& kk) {
    float f = lb + (1.0f - lb) * __builtin_amdgcn_rcpf(1.0f + fast_exp2(-1.4426950408889634f * xpre));
    f = fmaxf(f, 1e-6f);
    lf = __builtin_amdgcn_logf(f); kk = 1.0f - f;
}

__device__ __forceinline__ void phase_prep(const Args& a, lds_u8* lds, int l, int vcu, int G, const int tid, const bool dry) {
    const int lane = tid & 63, wave = tid >> 6;
    const int gw = vcu * 8 + wave, NGW = G * 8;
    unsigned char* ws = a.ws;
    bf16_t* proj = (bf16_t*)(ws + WS_PROJ);
    const float* rope = (const float*)(ws + WS_ROPE);
    {
        const float gak = a.in[I_AKN][l * 64 + lane], gck = a.in[I_CKN][l * 64 + lane];
        const int half = lane >> 5, side = (lane >> 4) & 1, i = lane & 15;
        for (int m0 = gw * 4; m0 < M; m0 += NGW * 4) {
            unsigned short raw[4][4];
#pragma unroll
            for (int r = 0; r < 4; ++r) { const bf16_t* row = proj + (size_t)(m0 + r) * INW;
                raw[r][0] = row[C_AK + lane]; raw[r][1] = row[C_AK + 64 + lane]; raw[r][2] = row[C_CK + lane]; raw[r][3] = row[C_CK + 64 + lane]; }
#pragma unroll
            for (int r = 0; r < 4; ++r) {
                const int m = m0 + r, t = m & (SEQ - 1);
                bf16_t* wrow = (dry ? (bf16_t*)(ws + WS_U) : proj) + (size_t)m * INW;
                const int pos = half ? (t & 63) : (t >> 6);
                const float cs = rope[(pos * 16 + i) * 2], sn = rope[(pos * 16 + i) * 2 + 1];
#pragma unroll
                for (int hh = 0; hh < 2; ++hh) {
                    float v = bf2f(raw[r][hh]);
                    const float ss = wave_sum(v * v);
                    v = v * rsqrtf(ss * (1.f / 64) + EPS) * gak;
                    const float pr = __shfl_xor(v, 16);
                    const float o = side ? (v * cs + pr * sn) : (v * cs - pr * sn);
                    wrow[C_AK + hh * 64 + lane] = (bf16_t)f2bf(o);
                }
#pragma unroll
                for (int hh = 0; hh < 2; ++hh) {
                    float v = bf2f(raw[r][2 + hh]);
                    const float ss = wave_sum(v * v);
                    v = v * rsqrtf(ss * (1.f / 64) + EPS) * gck;
                    wrow[C_CK + hh * 64 + lane] = (bf16_t)f2bf(v);
                }
            }
        }
    }
    {
        LAS bf16_t* scr = (LAS bf16_t*)(lds + wave * 9216);
        bf16_t* vt = (bf16_t*)(ws + WS_VT);
        for (int it = gw; it < NB * 4 * 32; it += NGW) {
            const int b = it >> 7, kv4 = (it >> 5) & 3, tb = it & 31;
            const int col0 = (kv4 < 2 ? C_AV : C_CV) + (kv4 & 1) * 64;
            const bf16_t* src = proj + ((size_t)b * SEQ + tb * 64) * INW + col0 + lane;
#pragma unroll
            for (int rb = 0; rb < 64; rb += 32) { unsigned short tmp[32];
#pragma unroll
              for (int r = 0; r < 32; ++r) tmp[r] = src[(size_t)(rb + r) * INW];
#pragma unroll
              for (int r = 0; r < 32; ++r) scr[(rb + r) * 66 + lane] = tmp[r]; }
            asm volatile("s_waitcnt lgkmcnt(0)" ::: "memory");
            bf16_t* dst = vt + (((size_t)b * 4 + kv4) * 64) * SEQ + tb * 64 + lane;
#pragma unroll 16
            for (int d = 0; d < 64; ++d) dst[(size_t)d * SEQ] = scr[lane * 66 + d];
            asm volatile("s_waitcnt lgkmcnt(0)" ::: "memory");
        }
    }
    {
        LAS bf16_t* klt = (LAS bf16_t*)(lds + wave * 9216);
        float* HL = (float*)(ws + WS_HL); float* HDp = (float*)(ws + WS_HD);
        const int r16 = lane & 15, q4 = lane >> 4;
        for (int it = gw; it < NB * 4 * 2 * 32; it += NGW) {
            const int c = it & 31, dir = (it >> 5) & 1, hh = (it >> 6) & 3, b = it >> 8;
            const float lb = hgrn_lb(a.in[I_BLB], dir, l, hh * 64 + lane);
            const size_t rbase = (size_t)b * SEQ + c * 64;
            const int fcol = (dir ? C_BFB : C_BFF) + hh * 64 + lane;
            unsigned fpk[32];
#pragma unroll
            for (int s = 0; s < 64; s += 2) { const int t0 = dir ? (63 - s) : s, t1 = dir ? (62 - s) : s + 1; fpk[s >> 1] = (unsigned)proj[(rbase + t0) * INW + fcol] | ((unsigned)proj[(rbase + t1) * INW + fcol] << 16); }
            float total = 0.f;
#pragma unroll
            for (int s = 63; s >= 0; --s) { float lf, kk; hgrn_fk((s & 1) ? bfhi(fpk[s >> 1]) : bflo(fpk[s >> 1]), lb, lf, kk);
                klt[lane * 72 + s] = (bf16_t)f2bf(kk * fast_exp2(total)); total += lf; }
            asm volatile("s_waitcnt lgkmcnt(0)" ::: "memory");
            HDp[(size_t)it * 64 + lane] = fast_exp2(total);
            const int vcol = C_BI + hh * 64;
            float* Lo = HL + (size_t)it * 4096;
#pragma unroll
            for (int mi = 0; mi < 4; ++mi) {
                bf16x8 af[2];
#pragma unroll
                for (int ks = 0; ks < 2; ++ks)
#pragma unroll
                    for (int j = 0; j < 8; ++j) { const int s = 32 * ks + 8 * q4 + j; const int tk = dir ? (63 - s) : s; af[ks][j] = (short)proj[(rbase + tk) * INW + vcol + 16 * mi + r16]; }
#pragma unroll
                for (int ni = 0; ni < 4; ++ni) {
                    f32x4 acc = (f32x4){0.f, 0.f, 0.f, 0.f};
#pragma unroll
                    for (int ks = 0; ks < 2; ++ks) { const bf16x8 bfr = *(const LAS bf16x8*)(klt + (16 * ni + r16) * 72 + 32 * ks + 8 * q4);
                        acc = __builtin_amdgcn_mfma_f32_16x16x32_bf16(af[ks], bfr, acc, 0, 0, 0); }
#pragma unroll
                    for (int j = 0; j < 4; ++j) Lo[(16 * mi + 4 * q4 + j) * 64 + 16 * ni + r16] = acc[j];
                }
            }
            asm volatile("s_waitcnt lgkmcnt(0)" ::: "memory");
        }
    }
}

constexpr int AT_KV = 18432;
constexpr int AT_TBL = 4 * AT_KV;
__device__ __forceinline__ int pi32(int m) { return (m & ~12) | ((m & 4) << 1) | ((m & 8) >> 1); }

template <bool BIAS>
__device__ __forceinline__ void attn_unit(lds_u8* lds, const bf16_t* proj, const bf16_t* vt, bf16_t* mix, const bf16_t* po_far, const float* pl, const float* gq, const float* gk, const float* rope,
                                          int b, int h, int qblk, int qcol0, int kcol0, int vsel0, int mixcol0, const int tid) {
    const int lane = tid & 63, wave = __builtin_amdgcn_readfirstlane(tid >> 6);
    const int r32 = lane & 31, hi = lane >> 5;
    const int kvh = h / 3;
    const int q0 = qblk * 256;
    const int qp = q0 + 32 * wave + r32;
    int tlo = 0, ntile = SEQ / 64;
    if (BIAS) { const int klo = q0 - 256 < 0 ? 0 : q0 - 256, khi_ = q0 + 255 + 256 > SEQ - 1 ? SEQ - 1 : q0 + 255 + 256; tlo = klo >> 6; ntile = (khi_ >> 6) - tlo + 1; }
    const bf16_t* kbase = proj + (size_t)b * SEQ * INW + kcol0 + kvh * 64;
    const bf16_t* vbase = vt + ((size_t)b * 4 + vsel0 + kvh) * 64 * SEQ;
    const int lrow_ = tid >> 3, lc16 = tid & 7;
    u32x4 kreg, vreg;
#define AT_LOAD(tile) do { const int key0_ = (tile) * 64; kreg = *(const u32x4*)(kbase + (size_t)(key0_ + lrow_) * INW + lc16 * 8); vreg = *(const u32x4*)(vbase + (size_t)lrow_ * SEQ + key0_ + lc16 * 8); } while (0)
#define AT_STORE(bufi) do { lds_u8* bb_ = lds + (bufi) * AT_KV; *(LAS u32x4*)(bb_ + lrow_ * 144 + lc16 * 16) = kreg; *(LAS u32x4*)(bb_ + 9216 + lrow_ * 144 + lc16 * 16) = vreg; } while (0)
    u32x4 qraw[4];
    { const bf16_t* qrow = proj + ((size_t)b * SEQ + qp) * INW + qcol0 + h * 64 + 8 * hi;
#pragma unroll
      for (int d0 = 0; d0 < 4; ++d0) qraw[d0] = *(const u32x4*)(qrow + 16 * d0); }
    AT_LOAD(tlo);
    const float gql = gq[lane], gkl = gk[lane];
    f32x4 gqv[4][2];
#pragma unroll
    for (int d0 = 0; d0 < 4; ++d0) { gqv[d0][0] = *(const f32x4*)(gq + 16 * d0 + 8 * hi); gqv[d0][1] = *(const f32x4*)(gq + 16 * d0 + 8 * hi + 4); }
    f32x4 rpr[4], rpc[4];
    if (!BIAS) { const int pr = qp >> 6, pc = qp & 63;
#pragma unroll
        for (int j4 = 0; j4 < 4; ++j4) { rpr[j4] = *(const f32x4*)(rope + (pr * 16 + 8 * hi) * 2 + 4 * j4); rpc[j4] = *(const f32x4*)(rope + (pc * 16 + 8 * hi) * 2 + 4 * j4); } }
    float ref;
    { float a = fabsf(gql), c = fabsf(gkl);
#pragma unroll
      for (int o = 1; o < 64; o <<= 1) { a = fmaxf(a, __shfl_xor(a, o)); c = fmaxf(c, __shfl_xor(c, o)); }
      ref = 64.0f * 0.125f * 1.4426950408889634f * 1.02f * a * c + (BIAS ? 1.6f : 0.0f); }
    if (BIAS) {
        LAS float* tbl = (LAS float*)(lds + AT_TBL);
        const float slope = fast_exp2(-(float)(h + 1) * (4.0f / 3.0f));
        for (int e = tid; e < 4096; e += NTHREADS) { const int d = e - 2048, ad = d < 0 ? -d : d;
            const int mult = ad > 256 ? 0 : (ad <= 64 ? 1 : 0) + ((ad & 3) == 0 ? 1 : 0) + ((ad & 15) == 0 ? 1 : 0);
            const float lg = mult == 3 ? 1.5849625007211562f : (mult == 2 ? 1.0f : 0.0f);
            tbl[e] = mult ? (lg - slope * (float)ad * 1.4426950408889634f - ref) : -1e30f; }
    }
    bf16x8 qr[4];
    {
        float v[4][8]; float ss = 0.f;
#pragma unroll
        for (int d0 = 0; d0 < 4; ++d0) { const u32x4 w = qraw[d0];
            v[d0][0] = bflo(w.x); v[d0][1] = bfhi(w.x); v[d0][2] = bflo(w.y); v[d0][3] = bfhi(w.y); v[d0][4] = bflo(w.z); v[d0][5] = bfhi(w.z); v[d0][6] = bflo(w.w); v[d0][7] = bfhi(w.w);
#pragma unroll
            for (int j = 0; j < 8; ++j) ss += v[d0][j] * v[d0][j]; }
        ss += __shfl_xor(ss, 32);
        const float rstd = rsqrtf(ss * (1.f / 64) + EPS);
#pragma unroll
        for (int d0 = 0; d0 < 4; ++d0)
#pragma unroll
            for (int j = 0; j < 8; ++j) v[d0][j] *= rstd * gqv[d0][j >> 2][j & 3];
        if (!BIAS) {
#pragma unroll
            for (int j = 0; j < 8; ++j) {
                { const float c = rpr[j >> 1][2 * (j & 1)], s = rpr[j >> 1][2 * (j & 1) + 1]; const float x1 = v[0][j], x2 = v[1][j]; v[0][j] = x1 * c - x2 * s; v[1][j] = x2 * c + x1 * s; }
                { const float c = rpc[j >> 1][2 * (j & 1)], s = rpc[j >> 1][2 * (j & 1) + 1]; const float x1 = v[2][j], x2 = v[3][j]; v[2][j] = x1 * c - x2 * s; v[3][j] = x2 * c + x1 * s; } }
        }
        const float qsc = 0.125f * 1.4426950408889634f;
#pragma unroll
        for (int d0 = 0; d0 < 4; ++d0) { u32x4 w; w.x = pk2(v[d0][0] * qsc, v[d0][1] * qsc); w.y = pk2(v[d0][2] * qsc, v[d0][3] * qsc); w.z = pk2(v[d0][4] * qsc, v[d0][5] * qsc); w.w = pk2(v[d0][6] * qsc, v[d0][7] * qsc);
            qr[d0] = __builtin_bit_cast(bf16x8, w); }
    }
    AT_STORE(0);
    __syncthreads();
    float lrow = 0.f;
    f32x16 o0, o1, negref;
#pragma unroll
    for (int i = 0; i < 16; ++i) { o0[i] = 0.f; o1[i] = 0.f; negref[i] = -ref; }
    const int krow = pi32(r32);
    for (int step = 0; step < ntile; ++step) {
        const bool ldn = (step + 1 < ntile);
        if (ldn) AT_LOAD(tlo + step + 1);
        {
            const lds_u8* kb = lds + (step & 1) * AT_KV;
            const lds_u8* vb = kb + 9216;
            f32x16 p0, p1;
            if (BIAS) {
                const LAS float* tbl = (const LAS float*)(lds + AT_TBL) + ((tlo + step) * 64 + 8 * hi - qp + 2048);
#pragma unroll
                for (int i = 0; i < 16; ++i) { p0[i] = tbl[(i & 7) + 16 * (i >> 3)]; p1[i] = tbl[(i & 7) + 16 * (i >> 3) + 32]; }
            } else { p0 = negref; p1 = negref; }
#pragma unroll
            for (int d0 = 0; d0 < 4; ++d0) {
                const bf16x8 k0 = *(const LAS bf16x8*)(kb + krow * 144 + 32 * d0 + 16 * hi);
                const bf16x8 k1 = *(const LAS bf16x8*)(kb + (32 + krow) * 144 + 32 * d0 + 16 * hi);
                p0 = __builtin_amdgcn_mfma_f32_32x32x16_bf16(k0, qr[d0], p0, 0, 0, 0);
                p1 = __builtin_amdgcn_mfma_f32_32x32x16_bf16(k1, qr[d0], p1, 0, 0, 0);
            }
            float rs0 = 0.f, rs1 = 0.f;
#pragma unroll
            for (int i = 0; i < 16; ++i) { p0[i] = fast_exp2(p0[i]); p1[i] = fast_exp2(p1[i]); rs0 += p0[i]; rs1 += p1[i]; }
            lrow += rs0 + rs1;
            bf16x8 pb[2][2];
#pragma unroll
            for (int ks = 0; ks < 2; ++ks) {
                u32x4 w; w.x = pk2(p0[8 * ks + 0], p0[8 * ks + 1]); w.y = pk2(p0[8 * ks + 2], p0[8 * ks + 3]); w.z = pk2(p0[8 * ks + 4], p0[8 * ks + 5]); w.w = pk2(p0[8 * ks + 6], p0[8 * ks + 7]);
                pb[0][ks] = __builtin_bit_cast(bf16x8, w);
                u32x4 w1; w1.x = pk2(p1[8 * ks + 0], p1[8 * ks + 1]); w1.y = pk2(p1[8 * ks + 2], p1[8 * ks + 3]); w1.z = pk2(p1[8 * ks + 4], p1[8 * ks + 5]); w1.w = pk2(p1[8 * ks + 6], p1[8 * ks + 7]);
                pb[1][ks] = __builtin_bit_cast(bf16x8, w1);
            }
#pragma unroll
            for (int sub = 0; sub < 2; ++sub)
#pragma unroll
                for (int ks = 0; ks < 2; ++ks) {
                    const bf16x8 v0 = *(const LAS bf16x8*)(vb + r32 * 144 + (32 * sub + 16 * ks + 8 * hi) * 2);
                    const bf16x8 v1 = *(const LAS bf16x8*)(vb + (32 + r32) * 144 + (32 * sub + 16 * ks + 8 * hi) * 2);
                    o0 = __builtin_amdgcn_mfma_f32_32x32x16_bf16(v0, pb[sub][ks], o0, 0, 0, 0);
                    o1 = __builtin_amdgcn_mfma_f32_32x32x16_bf16(v1, pb[sub][ks], o1, 0, 0, 0);
                }
        }
        if (ldn) AT_STORE((step + 1) & 1);
        __syncthreads();
    }
#undef AT_LOAD
#undef AT_STORE
    lrow += __shfl_xor(lrow, 32);
    {
        const size_t grow = (size_t)b * SEQ + qp;
        const bf16_t* fpo = BIAS ? po_far + grow * 384 + h * 64 + 4 * hi : nullptr;
        const float inv = 1.0f / (lrow + (BIAS ? pl[grow * 6 + h] : 0.0f));
        bf16_t* orow = mix + grow * DM + mixcol0 + h * 64 + 4 * hi;
#pragma unroll
        for (int g4 = 0; g4 < 4; ++g4) {
            u32x2 f0 = (u32x2){0u, 0u}, f1 = (u32x2){0u, 0u};
            if (BIAS) { f0 = *(const u32x2*)(fpo + 8 * g4); f1 = *(const u32x2*)(fpo + 32 + 8 * g4); }
            { const float x0 = (o0[4 * g4] + bflo(f0.x)) * inv, x1 = (o0[4 * g4 + 1] + bfhi(f0.x)) * inv, x2 = (o0[4 * g4 + 2] + bflo(f0.y)) * inv, x3 = (o0[4 * g4 + 3] + bfhi(f0.y)) * inv;
              u32x2 w; w.x = pk2(x0, x1); w.y = pk2(x2, x3); *(u32x2*)(orow + 8 * g4) = w; }
            { const float x0 = (o1[4 * g4] + bflo(f1.x)) * inv, x1 = (o1[4 * g4 + 1] + bfhi(f1.x)) * inv, x2 = (o1[4 * g4 + 2] + bflo(f1.y)) * inv, x3 = (o1[4 * g4 + 3] + bfhi(f1.y)) * inv;
              u32x2 w; w.x = pk2(x0, x1); w.y = pk2(x2, x3); *(u32x2*)(orow + 32 + 8 * g4) = w; }
        }
    }
}

__device__ __forceinline__ void attn_r16_unit(lds_u8* lds, const bf16_t* proj, bf16_t* po, float* pl, const float* gq, const float* gk, int b, int kvh, int rho, const int tid) {
    const int lane = tid & 63, wave = __builtin_amdgcn_readfirstlane(tid >> 6);
    const int qs = wave & 3, kh = wave >> 2, r32 = lane & 31, hi = lane >> 5;
    const int iq = 32 * qs + r32;
    const size_t qrow_g = (size_t)b * SEQ + rho + 16 * iq;
    const bf16_t* qrow0 = proj + qrow_g * INW + C_CQ + (kvh * 3) * 64 + 8 * hi;
    u32x4 qcur[4], qnxt[4];
#pragma unroll
    for (int d0 = 0; d0 < 4; ++d0) { qcur[d0] = *(const u32x4*)(qrow0 + 16 * d0); qnxt[d0] = qcur[d0]; }
    u32x4 kst[2], vst[2];
    const int th = tid & 255;
#pragma unroll
    for (int i_ = 0; i_ < 2; ++i_) { const int c_ = th + 256 * i_, row_ = c_ >> 3, c16_ = c_ & 7;
        const bf16_t* src = proj + ((size_t)b * SEQ + rho + 16 * (64 * kh + row_)) * INW + kvh * 64 + c16_ * 8;
        kst[i_] = *(const u32x4*)(src + C_CK); vst[i_] = *(const u32x4*)(src + C_CV); }
    const float gql = gq[lane], gkl = gk[lane];
    float ref;
    { float a = fabsf(gql), c = fabsf(gkl);
#pragma unroll
      for (int o = 1; o < 64; o <<= 1) { a = fmaxf(a, __shfl_xor(a, o)); c = fmaxf(c, __shfl_xor(c, o)); }
      ref = 64.0f * 0.125f * 1.4426950408889634f * 1.02f * a * c + 1.6f; }
    LAS float* tb = (LAS float*)(lds + 40960);
    for (int e = tid; e < 768; e += NTHREADS) { const int hq = e >> 8, d = (e & 255) - 128, ad = d < 0 ? -d : d; const float slope = fast_exp2(-(float)(kvh * 3 + hq + 1) * (4.0f / 3.0f));
        tb[e] = (ad > 16 && ad <= 64) ? (-slope * 16.0f * (float)ad * 1.4426950408889634f - ref) : -1e30f; }
    lds_u8* hb = lds + kh * AT_KV;
#pragma unroll
    for (int i_ = 0; i_ < 2; ++i_) { const int c_ = th + 256 * i_, row_ = c_ >> 3, c16_ = c_ & 7;
        *(LAS u32x4*)(hb + row_ * 144 + c16_ * 16) = kst[i_]; *(LAS u32x4*)(hb + 9216 + row_ * 144 + c16_ * 16) = vst[i_]; }
    __syncthreads();
    const int krow = pi32(r32);
    bf16x8 kf[8], vf[8];
#pragma unroll
    for (int d0 = 0; d0 < 4; ++d0) { kf[2 * d0] = *(const LAS bf16x8*)(hb + krow * 144 + 32 * d0 + 16 * hi); kf[2 * d0 + 1] = *(const LAS bf16x8*)(hb + (32 + krow) * 144 + 32 * d0 + 16 * hi); }
    { const LAS bf16_t* vbase = (const LAS bf16_t*)(hb + 9216);
#pragma unroll
      for (int sub = 0; sub < 2; ++sub)
#pragma unroll
        for (int ks = 0; ks < 2; ++ks)
#pragma unroll
            for (int j = 0; j < 8; ++j) { const int key = 32 * sub + 16 * ks + 8 * hi + j;
                vf[(sub * 2 + ks) * 2][j] = (short)vbase[key * 72 + r32]; vf[(sub * 2 + ks) * 2 + 1][j] = (short)vbase[key * 72 + 32 + r32]; } }
    __syncthreads();
    LAS float* cs = (LAS float*)(lds) + (qs * 64 + lane) * 35;
#pragma unroll 1
    for (int hq = 0; hq < 3; ++hq) {
        const int h = kvh * 3 + hq;
        if (hq < 2) {
#pragma unroll
            for (int d0 = 0; d0 < 4; ++d0) qnxt[d0] = *(const u32x4*)(qrow0 + (hq + 1) * 64 + 16 * d0); }
        bf16x8 qr[4];
        {
            f32x4 gqv[4][2];
#pragma unroll
            for (int d0 = 0; d0 < 4; ++d0) { gqv[d0][0] = *(const f32x4*)(gq + 16 * d0 + 8 * hi); gqv[d0][1] = *(const f32x4*)(gq + 16 * d0 + 8 * hi + 4); }
            float v[4][8]; float ss = 0.f;
#pragma unroll
            for (int d0 = 0; d0 < 4; ++d0) { const u32x4 w = qcur[d0];
                v[d0][0] = bflo(w.x); v[d0][1] = bfhi(w.x); v[d0][2] = bflo(w.y); v[d0][3] = bfhi(w.y); v[d0][4] = bflo(w.z); v[d0][5] = bfhi(w.z); v[d0][6] = bflo(w.w); v[d0][7] = bfhi(w.w);
#pragma unroll
                for (int j = 0; j < 8; ++j) ss += v[d0][j] * v[d0][j]; }
            ss += __shfl_xor(ss, 32);
            const float rstd = rsqrtf(ss * (1.f / 64) + EPS) * (0.125f * 1.4426950408889634f);
#pragma unroll
            for (int d0 = 0; d0 < 4; ++d0) { float y[8];
#pragma unroll
                for (int j = 0; j < 8; ++j) y[j] = v[d0][j] * rstd * gqv[d0][j >> 2][j & 3];
                u32x4 w; w.x = pk2(y[0], y[1]); w.y = pk2(y[2], y[3]); w.z = pk2(y[4], y[5]); w.w = pk2(y[6], y[7]); qr[d0] = __builtin_bit_cast(bf16x8, w); }
        }
        f32x16 p0, p1;
        { const LAS float* tbl = tb + hq * 256 + (64 * kh + 8 * hi - iq + 128);
#pragma unroll
          for (int i = 0; i < 16; ++i) { p0[i] = tbl[(i & 7) + 16 * (i >> 3)]; p1[i] = tbl[(i & 7) + 16 * (i >> 3) + 32]; } }
#pragma unroll
        for (int d0 = 0; d0 < 4; ++d0) {
            p0 = __builtin_amdgcn_mfma_f32_32x32x16_bf16(kf[2 * d0], qr[d0], p0, 0, 0, 0);
            p1 = __builtin_amdgcn_mfma_f32_32x32x16_bf16(kf[2 * d0 + 1], qr[d0], p1, 0, 0, 0);
        }
        float lrow = 0.f;
#pragma unroll
        for (int i = 0; i < 16; ++i) { p0[i] = fast_exp2(p0[i]); p1[i] = fast_exp2(p1[i]); lrow += p0[i] + p1[i]; }
        bf16x8 pb[2][2];
#pragma unroll
        for (int ks = 0; ks < 2; ++ks) {
            u32x4 w; w.x = pk2(p0[8 * ks + 0], p0[8 * ks + 1]); w.y = pk2(p0[8 * ks + 2], p0[8 * ks + 3]); w.z = pk2(p0[8 * ks + 4], p0[8 * ks + 5]); w.w = pk2(p0[8 * ks + 6], p0[8 * ks + 7]);
            pb[0][ks] = __builtin_bit_cast(bf16x8, w);
            u32x4 w1; w1.x = pk2(p1[8 * ks + 0], p1[8 * ks + 1]); w1.y = pk2(p1[8 * ks + 2], p1[8 * ks + 3]); w1.z = pk2(p1[8 * ks + 4], p1[8 * ks + 5]); w1.w = pk2(p1[8 * ks + 6], p1[8 * ks + 7]);
            pb[1][ks] = __builtin_bit_cast(bf16x8, w1);
        }
        f32x16 o0, o1;
#pragma unroll
        for (int i = 0; i < 16; ++i) { o0[i] = 0.f; o1[i] = 0.f; }
#pragma unroll
        for (int sub = 0; sub < 2; ++sub)
#pragma unroll
            for (int ks = 0; ks < 2; ++ks) {
                o0 = __builtin_amdgcn_mfma_f32_32x32x16_bf16(vf[(sub * 2 + ks) * 2], pb[sub][ks], o0, 0, 0, 0);
                o1 = __builtin_amdgcn_mfma_f32_32x32x16_bf16(vf[(sub * 2 + ks) * 2 + 1], pb[sub][ks], o1, 0, 0, 0);
            }
        lrow += __shfl_xor(lrow, 32);
        if (kh == 1) { cs[1] = lrow;
#pragma unroll
            for (int i = 0; i < 16; ++i) { cs[2 + i] = o0[i]; cs[18 + i] = o1[i]; } }
        __syncthreads();
        if (kh == 0) {
            bf16_t* orow = po + qrow_g * 384 + h * 64 + 4 * hi;
            if (hi == 0) pl[qrow_g * 6 + h] = lrow + cs[1];
#pragma unroll
            for (int g4 = 0; g4 < 4; ++g4) {
                { u32x2 w; w.x = pk2(o0[4 * g4] + cs[2 + 4 * g4], o0[4 * g4 + 1] + cs[3 + 4 * g4]); w.y = pk2(o0[4 * g4 + 2] + cs[4 + 4 * g4], o0[4 * g4 + 3] + cs[5 + 4 * g4]); *(u32x2*)(orow + 8 * g4) = w; }
                { u32x2 w; w.x = pk2(o1[4 * g4] + cs[18 + 4 * g4], o1[4 * g4 + 1] + cs[19 + 4 * g4]); w.y = pk2(o1[4 * g4 + 2] + cs[20 + 4 * g4], o1[4 * g4 + 3] + cs[21 + 4 * g4]); *(u32x2*)(orow + 32 + 8 * g4) = w; }
            }
        }
        __syncthreads();
#pragma unroll
        for (int d0 = 0; d0 < 4; ++d0) qcur[d0] = qnxt[d0];
    }
}

__device__ __forceinline__ void phase_scan(const Args& a, int vcu, int G, const int tid) {
    const float* HL = (const float*)(a.ws + WS_HL); const float* HDp = (const float*)(a.ws + WS_HD); bf16_t* HS = (bf16_t*)(a.ws + WS_HS);
    for (int e = vcu * NTHREADS + tid; e < 64 * 4096; e += G * NTHREADS) {
        const int seq = e >> 12, idx = e & 4095, k = idx & 63, dir = seq & 1;
        float st = 0.f;
        for (int cb = 0; cb < 32; cb += 8) {
            float hd[8], hl[8];
#pragma unroll
            for (int j = 0; j < 8; ++j) { const int c = dir ? 31 - (cb + j) : cb + j; const size_t o = (size_t)seq * 32 + c; hd[j] = HDp[o * 64 + k]; hl[j] = HL[o * 4096 + idx]; }
#pragma unroll
            for (int j = 0; j < 8; ++j) { const int c = dir ? 31 - (cb + j) : cb + j; const size_t o = (size_t)seq * 32 + c; HS[o * 4096 + idx] = (bf16_t)f2bf(st); st = hd[j] * st + hl[j]; }
        }
    }
}

constexpr int HG_OACC = 0, HG_QS = 65536, HG_QD = HG_QS + 9216, HG_KD = HG_QD + 9216, HG_KE = HG_KD + 9216, HG_Q2 = HG_KE + 9216, HG_K2 = HG_Q2 + 4608,
              HG_VT = HG_K2 + 4608, HG_AT = HG_VT + 9216, HG_ST = HG_AT + 9216, HG_GT = HG_ST + 9216, HG_END = HG_GT + 2048;
static_assert(HG_END <= LDS_BYTES, "HGRN LDS map");

__device__ __forceinline__ void hgrn_out_item(const Args& a, lds_u8* lds, int l, int item, const int tid) {
    const int lane = tid & 63, wave = __builtin_amdgcn_readfirstlane(tid >> 6);
    const int k = lane, rg = wave;
    const int b = item >> 5, hh = (item >> 3) & 3, grp = item & 7;
    const int c0 = grp * 4;
    unsigned char* ws = a.ws;
    const bf16_t* proj = (const bf16_t*)(ws + WS_PROJ);
    const float* HL = (const float*)(ws + WS_HL); const float* HDp = (const float*)(ws + WS_HD);
    LAS float* oacc = (LAS float*)(lds + HG_OACC);
    LAS bf16_t* Qs = (LAS bf16_t*)(lds + HG_QS); LAS bf16_t* Qd = (LAS bf16_t*)(lds + HG_QD); LAS bf16_t* Kd = (LAS bf16_t*)(lds + HG_KD); LAS bf16_t* Ke = (LAS bf16_t*)(lds + HG_KE);
    LAS bf16_t* Q2 = (LAS bf16_t*)(lds + HG_Q2); LAS bf16_t* K2 = (LAS bf16_t*)(lds + HG_K2); LAS bf16_t* VT = (LAS bf16_t*)(lds + HG_VT); LAS bf16_t* AT = (LAS bf16_t*)(lds + HG_AT);
    LAS bf16_t* ST = (LAS bf16_t*)(lds + HG_ST); LAS float* gt = (LAS float*)(lds + HG_GT);
    const int r16 = lane & 15, q4 = lane >> 4;
    const float lbv0 = hgrn_lb(a.in[I_BLB], 0, l, hh * 64 + k), lbv1 = hgrn_lb(a.in[I_BLB], 1, l, hh * 64 + k);
    unsigned short rq[8], rf[8], rv[8];
#define HG_LOADRAW(dir_, c_) do { const size_t rb_ = (size_t)b * SEQ + (c_) * 64; _Pragma("unroll") for (int i = 0; i < 8; ++i) { const int s_ = 8 * rg + i; const int tk_ = (dir_) ? (63 - s_) : s_; \
        const bf16_t* rp_ = proj + (rb_ + tk_) * INW; rq[i] = rp_[C_BQ + hh * 64 + k]; rf[i] = rp_[((dir_) ? C_BFB : C_BFF) + hh * 64 + k]; rv[i] = rp_[C_BI + hh * 64 + k]; } } while (0)
    HG_LOADRAW(0, c0);
    float st[8];
#pragma unroll
    for (int i = 0; i < 8; ++i) st[i] = 0.f;
    for (int stp = 0; stp < 8; ++stp) {
        {
            const int dir = stp >> 2, ci = stp & 3;
            const float lb = dir ? lbv1 : lbv0;
            const size_t sbase = (((size_t)b * 4 + hh) * 2 + dir) * 32;
            const int c = dir ? (c0 + 3 - ci) : (c0 + ci);
            if (ci == 0) { const bf16_t* HSp = (const bf16_t*)(ws + WS_HS) + (sbase + c) * 4096 + (8 * wave) * 64 + k;
#pragma unroll
                for (int i = 0; i < 8; ++i) st[i] = bf2f(HSp[i * 64]); }
            float qv[8], lf[8], kk[8];
            u32x4 vpk;
#pragma unroll
            for (int i = 0; i < 8; ++i) { qv[i] = bf2f(rq[i]); hgrn_fk(bf2f(rf[i]), lb, lf[i], kk[i]); }
            vpk.x = rv[0] | ((unsigned)rv[1] << 16); vpk.y = rv[2] | ((unsigned)rv[3] << 16); vpk.z = rv[4] | ((unsigned)rv[5] << 16); vpk.w = rv[6] | ((unsigned)rv[7] << 16);
            const float dk = HDp[(sbase + c) * 64 + k];
            float Ln[8];
            { const float* Lp = HL + (sbase + c) * 4096 + (8 * wave) * 64 + k;
#pragma unroll
              for (int i = 0; i < 8; ++i) Ln[i] = Lp[i * 64]; }
            if (stp < 7) { const int nd = (stp + 1) >> 2, nci = (stp + 1) & 3; const int nc = nd ? (c0 + 3 - nci) : (c0 + nci); HG_LOADRAW(nd, nc); }
#pragma unroll
            for (int i = 1; i < 8; ++i) lf[i] += lf[i - 1];
            gt[rg * 64 + k] = lf[7];
#pragma unroll
            for (int i = 0; i < 8; ++i) ST[(8 * wave + i) * 72 + k] = (bf16_t)f2bf(st[i]);
            __syncthreads();
            float gsum[9]; gsum[0] = 0.f;
#pragma unroll
            for (int g = 0; g < 8; ++g) gsum[g + 1] = gsum[g] + gt[g * 64 + k];
            float off = 0.f, bS = 0.f, bE = 0.f;
#pragma unroll
            for (int g = 0; g < 8; ++g) { if (g == rg) off = gsum[g]; if (g == (rg & ~1)) { bS = gsum[g]; bE = gsum[g + 2]; } }
            const float b31 = gsum[4];
#pragma unroll
            for (int i = 0; i < 8; ++i) {
                const int s = 8 * rg + i; const float bb = off + lf[i];
                Qs[s * 72 + k] = (bf16_t)f2bf(qv[i] * fast_exp2(bb));
                Qd[s * 72 + k] = (bf16_t)f2bf(qv[i] * fast_exp2(bb - bS));
                Kd[s * 72 + k] = (bf16_t)f2bf(kk[i] * fast_exp2(fminf(bS - bb, 115.f)));
                Ke[s * 72 + k] = (bf16_t)f2bf(kk[i] * fast_exp2(bE - bb));
                { const bool hi2 = rg >= 4; LAS bf16_t* T2 = hi2 ? Q2 + (s - 32) * 72 + k : K2 + s * 72 + k;
                  *T2 = (bf16_t)f2bf((hi2 ? qv[i] : kk[i]) * fast_exp2(hi2 ? bb - b31 : b31 - bb)); }
            }
            *(LAS u32x4*)(VT + k * 72 + 8 * rg) = vpk;
            __syncthreads();
            {
                const int I = wave >> 1;
#pragma unroll
                for (int jj = 0; jj < 2; ++jj) {
                    const int J = 2 * (wave & 1) + jj;
                    f32x4 acc = (f32x4){0.f, 0.f, 0.f, 0.f};
                    if (J <= I) {
                        const LAS bf16_t* Ap; const LAS bf16_t* Bp;
                        if (J == I) { Ap = Qd + (16 * I + r16) * 72; Bp = Kd + (16 * J + r16) * 72; }
                        else if ((I >> 1) == (J >> 1)) { Ap = Qd + (16 * I + r16) * 72; Bp = Ke + (16 * J + r16) * 72; }
                        else { Ap = Q2 + (16 * (I - 2) + r16) * 72; Bp = K2 + (16 * J + r16) * 72; }
#pragma unroll
                        for (int ks = 0; ks < 2; ++ks) { const bf16x8 af = *(const LAS bf16x8*)(Ap + 32 * ks + 8 * q4); const bf16x8 bfr = *(const LAS bf16x8*)(Bp + 32 * ks + 8 * q4);
                            acc = __builtin_amdgcn_mfma_f32_16x16x32_bf16(af, bfr, acc, 0, 0, 0); }
                        if (J == I) {
#pragma unroll
                            for (int j = 0; j < 4; ++j) if (r16 > 4 * q4 + j) acc[j] = 0.f;
                        }
                    }
#pragma unroll
                    for (int j = 0; j < 4; ++j) AT[(16 * I + 4 * q4 + j) * 72 + 16 * J + r16] = (bf16_t)f2bf(acc[j]);
                }
            }
            __syncthreads();
            {
                const int mi = wave >> 1;
#pragma unroll
                for (int jj = 0; jj < 2; ++jj) {
                    const int ni = 2 * (wave & 1) + jj;
                    f32x4 acc = (f32x4){0.f, 0.f, 0.f, 0.f};
#pragma unroll
                    for (int ks = 0; ks < 2; ++ks) { const bf16x8 af = *(const LAS bf16x8*)(Qs + (16 * mi + r16) * 72 + 32 * ks + 8 * q4); const bf16x8 bfr = *(const LAS bf16x8*)(ST + (16 * ni + r16) * 72 + 32 * ks + 8 * q4);
                        acc = __builtin_amdgcn_mfma_f32_16x16x32_bf16(af, bfr, acc, 0, 0, 0); }
#pragma unroll
                    for (int ks = 0; ks < 2; ++ks) { const bf16x8 af = *(const LAS bf16x8*)(AT + (16 * mi + r16) * 72 + 32 * ks + 8 * q4); const bf16x8 bfr = *(const LAS bf16x8*)(VT + (16 * ni + r16) * 72 + 32 * ks + 8 * q4);
                        acc = __builtin_amdgcn_mfma_f32_16x16x32_bf16(af, bfr, acc, 0, 0, 0); }
#pragma unroll
                    for (int j = 0; j < 4; ++j) { const int t = 16 * mi + 4 * q4 + j; const int tl = (c - c0) * 64 + (dir ? (63 - t) : t);
                        LAS float* op = oacc + tl * 64 + 16 * ni + r16;
                        if (dir == 0) *op = acc[j]; else *op += acc[j]; }
                }
            }
#pragma unroll
            for (int i = 0; i < 8; ++i) st[i] = dk * st[i] + Ln[i];
            __syncthreads();
        }
    }
#undef HG_LOADRAW

    {
        const float gn = a.in[I_BON][l * 64 + lane];
        bf16_t* mix = (bf16_t*)(ws + WS_MIX);
        for (int rb = 0; rb < 32; rb += 8) {
            unsigned short gv[8];
#pragma unroll
            for (int r = 0; r < 8; ++r) gv[r] = proj[((size_t)b * SEQ + c0 * 64 + 32 * wave + rb + r) * INW + C_BG + hh * 64 + lane];
#pragma unroll
            for (int r = 0; r < 8; ++r) {
                const int tl = 32 * wave + rb + r;
                const size_t row = (size_t)b * SEQ + c0 * 64 + tl;
                const float o = oacc[tl * 64 + lane];
                const float ss = wave_sum(o * o);
                mix[row * DM + 384 + hh * 64 + lane] = (bf16_t)f2bf(o * rsqrtf(ss * (1.f / 64) + EPS) * gn * silu_f(bf2f(gv[r])));
            }
        }
    }
    __syncthreads();
}

__device__ __forceinline__ void phase_mixers(const Args& a, lds_u8* lds, int l, int vcu, int G, const int tid) {
    unsigned char* ws = a.ws;
    const bf16_t* proj = (const bf16_t*)(ws + WS_PROJ); const bf16_t* vt = (const bf16_t*)(ws + WS_VT); bf16_t* mix = (bf16_t*)(ws + WS_MIX);
    const float* rope = (const float*)(ws + WS_ROPE);
    for (int rp = 0; rp < ((PROBE_DUP & 256) ? 2 : 1); ++rp)
    for (int it = vcu; it < NB * 4 * 8; it += G) hgrn_out_item(a, lds, l, it, tid);
    const bf16_t* po_far = (const bf16_t*)(ws + WS_PO); const float* pl_far = (const float*)(ws + WS_PL);
    for (int u = vcu; u < 768; u += G) {
        const int mixer = u / 384, r = u % 384, b = r / 48, rr = r % 48, kvh = rr / 24, r3 = rr % 24, hq = r3 / 8, qblk = r3 % 8;
        const int h = kvh * 3 + hq;
        if (mixer == 0) attn_unit<false>(lds, proj, vt, mix, nullptr, nullptr, a.in[I_AQN] + l * 64, a.in[I_AKN] + l * 64, rope, b, h, qblk, C_AQ, C_AK, 0, 0, tid);
        else attn_unit<true>(lds, proj, vt, mix, po_far, pl_far, a.in[I_CQN] + l * 64, a.in[I_CKN] + l * 64, rope, b, h, qblk, C_CQ, C_CK, 2, 640, tid);
    }
}

__device__ __forceinline__ void phase_mixc(const Args& a, lds_u8* lds, int l, int vcu, int G, const int tid) {
    unsigned char* ws = a.ws;
    const bf16_t* proj = (const bf16_t*)(ws + WS_PROJ);
    bf16_t* po = (bf16_t*)(ws + WS_PO); float* pl = (float*)(ws + WS_PL);
    for (int u = vcu; u < 256; u += G) {
        const int b = u >> 5, kvh = (u >> 4) & 1, rho = u & 15;
        attn_r16_unit(lds, proj, po, pl, a.in[I_CQN] + l * 64, a.in[I_CKN] + l * 64, b, kvh, rho, tid);
    }
}

#define XB_TMO      128
#define XB_XCNT(j)  (256  + 64 * (j))
#define XB_XSUB(j)  (1280 + 64 * (j))
#define XB_XGEN(j)  (2304 + 64 * (j))
#define XB_TOP      3328
#define XB_TOPGEN   3392
#define XCD_BAR_WORDS 3456
#define XB_SPIN_CAP (1u << 18)
__device__ __forceinline__ unsigned xb_ld(unsigned* p)              { return __hip_atomic_load(p, __ATOMIC_RELAXED, __HIP_MEMORY_SCOPE_AGENT); }
__device__ __forceinline__ unsigned xb_add(unsigned* p, unsigned v) { return __hip_atomic_fetch_add(p, v, __ATOMIC_RELAXED, __HIP_MEMORY_SCOPE_AGENT); }
__device__ __forceinline__ unsigned xb_xcc_id() { return (unsigned)__builtin_amdgcn_s_getreg((3 << 11) | 20) & 0xFu; }
#define XB_SPIN(cond, bar) do { unsigned _sp = 0; while (cond) { __builtin_amdgcn_s_sleep(1); \
    if ((++_sp & 255u) == 0u) { if (xb_ld(&(bar)[XB_TMO])) break; if (_sp > XB_SPIN_CAP) { atomicAdd(&(bar)[XB_TMO], 1u); break; } } } } while (0)
struct XcdBarrier { unsigned* bar; unsigned x; volatile LAS unsigned* st; int wave; };
__device__ __forceinline__ int lane_id() { return (int)__builtin_amdgcn_mbcnt_hi(~0u, __builtin_amdgcn_mbcnt_lo(~0u, 0u)); }
__device__ __forceinline__ XcdBarrier xcd_barrier_post(unsigned* bar, volatile LAS unsigned* st, int wave) {
    XcdBarrier b; b.bar = bar; b.x = xb_xcc_id(); b.st = st; b.wave = wave;
    if (wave == 0 && lane_id() == 0) (void)xb_add(&bar[XB_XCNT(b.x)], 1u);
    return b;
}
__device__ __forceinline__ void xcd_barrier_complete(unsigned* bar, unsigned x, unsigned& nloc, unsigned& nx) {
    const unsigned G = gridDim.x * gridDim.y * gridDim.z;
    unsigned sum, cnt, mine, sp = 0u;
    for (;;) {
        sum = 0u; cnt = 0u; mine = 0u;
#pragma unroll
        for (unsigned j = 0; j < 16; ++j) { const unsigned c = xb_ld(&bar[XB_XCNT(j)]); sum += c; cnt += (c > 0u) ? 1u : 0u; mine = (j == x) ? c : mine; }
        if (sum == G) break;
        __builtin_amdgcn_s_sleep(1);
        if ((++sp & 255u) == 0u) { if (xb_ld(&bar[XB_TMO])) break; if (sp > XB_SPIN_CAP) { atomicAdd(&bar[XB_TMO], 1u); break; } }
    }
    nloc = mine > 0u ? mine : 1u; nx = cnt > 0u ? cnt : 1u;
}
__device__ __forceinline__ void xcd_barrier(const XcdBarrier& b) {
    asm volatile("s_waitcnt vmcnt(0)" ::: "memory");
    __syncthreads();
    if (b.wave == 0 && lane_id() == 0) {
        unsigned* bar = b.bar;
        __builtin_amdgcn_s_waitcnt(0);
        unsigned nloc = b.st[0], nx = b.st[1];
        if (nloc == 0u) { xcd_barrier_complete(bar, b.x, nloc, nx); b.st[0] = nloc; b.st[1] = nx; }
        const unsigned old = xb_add(&bar[XB_XSUB(b.x)], 1u);
        const unsigned gen = old / nloc;
        if (old + 1u == (gen + 1u) * nloc) {
            __builtin_amdgcn_fence(__ATOMIC_RELEASE, "agent");
            asm volatile("s_waitcnt vmcnt(0)" ::: "memory");
            const unsigned og = xb_add(&bar[XB_TOP], 1u);
            const unsigned tg = og / nx;
            if (og + 1u == (tg + 1u) * nx) xb_add(&bar[XB_TOPGEN], 1u);
            else XB_SPIN(xb_ld(&bar[XB_TOPGEN]) == tg, bar);
            __builtin_amdgcn_fence(__ATOMIC_ACQUIRE, "agent");
            xb_add(&bar[XB_XGEN(b.x)], 1u);
            asm volatile("s_waitcnt vmcnt(0)" ::: "memory");
        } else {
            XB_SPIN(xb_ld(&bar[XB_XGEN(b.x)]) == gen, bar);
            __builtin_amdgcn_fence(__ATOMIC_ACQUIRE, "agent");
            asm volatile("s_waitcnt vmcnt(0)" ::: "memory");
        }
    }
    __syncthreads();
}
__device__ __forceinline__ void panel_norm(unsigned* cnt, const bf16_t* x, const float* g, const float* mod_l, int which_sh, bf16_t* h, int pm, int pn, const int tid) {
    asm volatile("s_waitcnt vmcnt(0)" ::: "memory");
    __syncthreads();
    if (tid == 0) {
        __builtin_amdgcn_fence(__ATOMIC_RELEASE, "agent");
        asm volatile("s_waitcnt vmcnt(0)" ::: "memory");
        (void)xb_add(cnt, 1u);
        unsigned sp = 0u;
        while (xb_ld(cnt) < 4u) { __builtin_amdgcn_s_sleep(1); if (++sp > (1u << 22)) break; }
        __builtin_amdgcn_fence(__ATOMIC_ACQUIRE, "agent");
        asm volatile("s_waitcnt vmcnt(0)" ::: "memory");
    }
    __syncthreads();
    const int lane = tid & 63, wave = tid >> 6;
    for (int r = 0; r < 8; r += 4) norm_rows4_bf(x, g, mod_l, which_sh, h, pm * 256 + pn * 64 + wave * 8 + r, lane);
}
constexpr int MISC_OFF = LDS_BYTES - 64;

constexpr int NPHASES = 2 + 9 * DEPTH - 1;

typedef const Args __attribute__((address_space(4))) KArgs;
template <int KMASK> __global__ void __launch_bounds__(NTHREADS, 2) fwd_kernel_t(Args a0) {
    extern __shared__ __attribute__((aligned(16))) unsigned char lds_raw[];
    lds_u8* lds = (lds_u8*)lds_raw;
    const int G = gridDim.x;
    unsigned char* ws = a0.ws;
    const int ph_lo = a0.ph_lo, ph_hi = a0.ph_hi;
    const float* mod = (const float*)(ws + WS_MOD);
    const int wave_s = __builtin_amdgcn_readfirstlane((int)(threadIdx.x >> 6));
    if (wave_s == 0 && lane_id() < 16) ((LAS unsigned*)(lds + MISC_OFF))[lane_id()] = 0u;
    __syncthreads();
    XcdBarrier bar = xcd_barrier_post((unsigned*)(ws + WS_CTL) + 4096, (volatile LAS unsigned*)(lds + MISC_OFF), wave_s);
    const bool fuse_norm = MK_ONE_LAUNCH && !PROBE_DUP && (G == 256);
    for (int ph = ph_lo; ph < ph_hi; ++ph) {
        KArgs* kap = (KArgs*)__builtin_amdgcn_kernarg_segment_ptr(); asm volatile("" : "+s"(kap));
        Args a;
#pragma unroll
        for (int i_ = 0; i_ < 17; ++i_) a.in[i_] = kap->in[i_];
        a.out = kap->out; a.ws = kap->ws; a.ph_lo = ph_lo; a.ph_hi = ph_hi;
        if (fuse_norm && ph >= 2 && ((ph - 2) % 9 == 5 || (ph - 2) % 9 == 8)) continue;
        int kbit = 0;
        if (PROBE_DUP) { if (ph == 0) kbit = 1; else if (ph == 1) kbit = 2; else { const int s_ = (ph - 2) % 9; kbit = s_ == 0 ? 4 : (s_ == 4 || s_ == 7) ? 8 : s_ == 1 ? 16 : s_ == 3 ? 32 : s_ == 6 ? 64 : s_ == 2 ? 128 : 2; } }
        const int nrep = (PROBE_DUP & kbit) ? 2 : 1;
        for (int rep = 0; rep < nrep; ++rep) {
        const bool dry = (rep + 1 < nrep); if (rep) __syncthreads();
        int tid = threadIdx.x; asm volatile("" : "+v"(tid));
        int bx = blockIdx.x; asm volatile("" : "+s"(bx));
        const int vcu = (G % 8 == 0) ? (bx % 8) * (G / 8) + bx / 8 : bx;
        if (ph == 0) { if (KMASK & 1) phase_prologue(a, lds, vcu, G, tid, bx); }
        else if (ph == 1) { if (KMASK & 2) phase_norm(a.in[I_X], a.in[I_NORMG], mod, 0, (bf16_t*)(ws + WS_H), vcu, G, tid); }
        else {
            const int l = (ph - 2) / 9, s = (ph - 2) % 9;
            const float* mod_l = mod + (size_t)l * 8 * 6144;
            if ((KMASK & 4) && s == 0) {
                const pg8::Gemm g{(const bf16_t*)(ws + WS_H), (const bf16_t*)(ws + WS_WIN) + (size_t)l * INW * DM, M, INW, DM}; const pg8::EpiStore E{(bf16_t*)(ws + WS_PROJ), INW};
                pg8::StaticOrder S; S.init(g.M, g.N, G, bx);
                pg8::gemm_phase<pg8::EpiStore, pg8::StaticOrder>(lds, g, S, E, tid);
            } else if ((KMASK & 64) && s == 6) {
                const pg8::Gemm g{(const bf16_t*)(ws + WS_H), (const bf16_t*)(ws + WS_WUP) + (size_t)l * UPW * DM, M, UPW, DM};
                const pg8::EpiConvGate E{(bf16_t*)(ws + WS_ACT), a.in[I_CONVW] + (size_t)l * 3 * UPW, a.in[I_CONVB] + (size_t)l * UPW};
                pg8::StaticOrder S; S.init(g.M, g.N, G, bx, 1);
                pg8::gemm_phase<pg8::EpiConvGate, pg8::StaticOrder>(lds, g, S, E, tid);
            } else if ((KMASK & 8) && (s == 4 || s == 7)) {
                pg8::Gemm g; pg8::EpiResid E;
                const bool nfuse = fuse_norm && !dry && !(s == 7 && l == DEPTH - 1);
                if (s == 4) { g = pg8::Gemm{(const bf16_t*)(ws + WS_MIX), (const bf16_t*)(ws + WS_WOUT) + (size_t)l * DM * DM, M, DM, DM};
                    E = pg8::EpiResid{ws, l == 0 ? a.in[I_X] : nullptr, nullptr, a.in[I_NORMG], l, 0, nfuse ? 1 : 0}; }
                else { g = pg8::Gemm{(const bf16_t*)(ws + WS_ACT), (const bf16_t*)(ws + WS_WDN) + (size_t)l * DM * FF, M, DM, FF};
                    E = pg8::EpiResid{ws, nullptr, (l == DEPTH - 1) ? a.out : nullptr, a.in[I_NORMG], l, 1, nfuse ? 1 : 0}; }
                pg8::StaticOrder S; S.init(g.M, g.N, G, bx);
                pg8::gemm_phase<pg8::EpiResid, pg8::StaticOrder>(lds, g, S, E, tid);
            } else if ((KMASK & 16) && s == 1) phase_prep(a, lds, l, vcu, G, tid, dry);
            else if ((KMASK & 16) && s == 2) { phase_scan(a, vcu, G, tid); phase_mixc(a, lds, l, vcu, G, tid); }
            else if ((KMASK & 32) && s == 3) phase_mixers(a, lds, l, vcu, G, tid);
            else if ((KMASK & 2) && s == 5) phase_norm_bf((const bf16_t*)(ws + WS_XB), a.in[I_NORMG] + (size_t)(l * 2 + 1) * DM, mod_l, 3, (bf16_t*)(ws + WS_H), vcu, G, tid);
            else if ((KMASK & 2) && s == 8) phase_norm_bf((const bf16_t*)(ws + WS_XB), a.in[I_NORMG] + (size_t)((l + 1) * 2) * DM, mod_l + 8 * 6144, 0, (bf16_t*)(ws + WS_H), vcu, G, tid);
        }
        }
        if (ph + 1 < ph_hi) { if (ph == 0) { __syncthreads(); cg::this_grid().sync(); } else xcd_barrier(bar); }
    }
}

typedef void (*kern_t)(Args);
static int phase_kind(int ph) { if (ph == 0) return 0; if (ph == 1) return 1; const int s = (ph - 2) % 9; return s == 0 ? 2 : s == 4 || s == 7 ? 3 : s == 1 || s == 2 ? 4 : s == 3 ? 5 : s == 6 ? 6 : 1; }
extern "C" void kernel_launch(void* const* d_in, const int* in_sizes, int n_in, void* d_out, int out_size, void* d_ws, size_t ws_size, hipStream_t stream) {
    static int grid = 0;
#if MK_ONE_LAUNCH
    static const kern_t kerns[1] = {fwd_kernel_t<127>}; constexpr int NK = 1;
#else
    static const kern_t kerns[7] = {fwd_kernel_t<1>, fwd_kernel_t<2>, fwd_kernel_t<4>, fwd_kernel_t<8>, fwd_kernel_t<16>, fwd_kernel_t<32>, fwd_kernel_t<64>}; constexpr int NK = 7;
#endif
    if (grid == 0) {
        if (n_in != 17 || out_size != M * DM || ws_size < WS_END) { fprintf(stderr, "kernel_launch: unexpected shapes (n_in %d, out %d, ws %zu)\n", n_in, out_size, ws_size); grid = -1; return; }
        int dev = 0, cus = 0;
        if (hipGetDevice(&dev) != hipSuccess || hipDeviceGetAttribute(&cus, hipDeviceAttributeMultiprocessorCount, dev) != hipSuccess) { grid = -1; return; }
        for (int i = 0; i < NK; ++i)
            if (hipFuncSetAttribute((const void*)kerns[i], hipFuncAttributeMaxDynamicSharedMemorySize, LDS_BYTES) != hipSuccess) { fprintf(stderr, "kernel_launch: hipFuncSetAttribute failed\n"); grid = -1; return; }
        int per_cu = 0;
        if (hipOccupancyMaxActiveBlocksPerMultiprocessor(&per_cu, (const void*)kerns[0], NTHREADS, LDS_BYTES) != hipSuccess || per_cu < 1) { fprintf(stderr, "kernel_launch: occupancy query says %d\n", per_cu); (void)hipGetLastError(); }
        grid = cus;
    }
    if (grid < 0) return;
    Args a{};
    for (int i = 0; i < 17; ++i) a.in[i] = (const float*)d_in[i];
    a.out = (float*)d_out; a.ws = (unsigned char*)d_ws;
#if MK_ONE_LAUNCH
    if (hipMemsetAsync((char*)d_ws + WS_CTL, 0, 65536, stream) != hipSuccess) { fprintf(stderr, "kernel_launch: memset failed\n"); return; }
    a.ph_lo = 0; a.ph_hi = NPHASES;
    void* args[] = {&a};
    hipError_t e = hipLaunchCooperativeKernel((const void*)kerns[0], dim3(grid), dim3(NTHREADS), args, LDS_BYTES, stream);
    if (e != hipSuccess) fprintf(stderr, "cooperative launch failed: %s (grid %d)\n", hipGetErrorString(e), grid);
#else
    for (int ph = 0; ph < NPHASES; ++ph) {
        a.ph_lo = ph; a.ph_hi = ph + 1;
        hipLaunchKernelGGL(kerns[phase_kind(ph)], dim3(grid), dim3(NTHREADS), LDS_BYTES, stream, a);
    }
#endif
}
```

```cpp
#include <hip/hip_runtime.h>
#include <hip/hip_cooperative_groups.h>
#include <cstdio>
#include <cstdint>
namespace cg = cooperative_groups;

#ifndef PROBE_DUP
#define PROBE_DUP 0
#endif
#ifndef MK_ONE_LAUNCH
#define MK_ONE_LAUNCH 1
#endif

#define LAS __attribute__((address_space(3)))
typedef unsigned short bf16_t;
typedef short bf16x8 __attribute__((ext_vector_type(8)));
typedef float f32x4 __attribute__((ext_vector_type(4)));
typedef float f32x16 __attribute__((ext_vector_type(16)));
typedef unsigned u32x4 __attribute__((ext_vector_type(4)));
typedef unsigned u32x2 __attribute__((ext_vector_type(2)));
typedef LAS unsigned char lds_u8;

constexpr int NB = 8, SEQ = 2048, DM = 1024, M = NB * SEQ, DEPTH = 4, INW = 2560, FF = 2816, UPW = 2 * FF;
constexpr float EPS = 1e-6f;
constexpr int C_AQ = 0, C_AK = 384, C_AV = 512, C_BQ = 640, C_BFF = 896, C_BFB = 1152, C_BI = 1408, C_BG = 1664, C_CQ = 1920, C_CK = 2304, C_CV = 2432;

constexpr size_t MiB = 1u << 20;
constexpr size_t WS_CTL = 0;
constexpr size_t WS_MOD = 1 * MiB;
constexpr size_t WS_ROPE = 2 * MiB;
constexpr size_t WS_WIN = 4 * MiB;
constexpr size_t WS_WOUT = 24 * MiB;
constexpr size_t WS_WUP = 32 * MiB;
constexpr size_t WS_WDN = 76 * MiB;
constexpr size_t WS_H = 98 * MiB;
constexpr size_t WS_PROJ = 130 * MiB;
constexpr size_t WS_MIX = 210 * MiB;
constexpr size_t WS_HL = 242 * MiB;
constexpr size_t WS_HD = 274 * MiB;
constexpr size_t WS_VT = 275 * MiB;
constexpr size_t WS_ACT = 190 * MiB;
constexpr size_t WS_HS = 283 * MiB;
constexpr size_t WS_PO = 300 * MiB;
constexpr size_t WS_PL = 326 * MiB;
constexpr size_t WS_XB = 332 * MiB;
constexpr size_t WS_U = 330 * MiB;
constexpr size_t WS_END = 366 * MiB;

constexpr int LDS_BYTES = 147456;
constexpr int NTHREADS = 512;

typedef float f32x2_t __attribute__((ext_vector_type(2))); typedef __bf16 bf16x2_t __attribute__((ext_vector_type(2)));
__device__ __forceinline__ unsigned pk2(float lo, float hi) { f32x2_t v = {lo, hi}; bf16x2_t b = __builtin_convertvector(v, bf16x2_t); return __builtin_bit_cast(unsigned, b); }
__device__ __forceinline__ unsigned f2bf(float f) { return pk2(f, 0.f) & 0xffffu; }
__device__ __forceinline__ float bf2f(unsigned short h) { return __builtin_bit_cast(float, (unsigned)h << 16); }
__device__ __forceinline__ float bflo(unsigned w) { return __builtin_bit_cast(float, w << 16); }
__device__ __forceinline__ float bfhi(unsigned w) { return __builtin_bit_cast(float, w & 0xffff0000u); }
__device__ __forceinline__ float wave_sum(float v) {
#pragma unroll
    for (int o = 1; o < 64; o <<= 1) v += __shfl_xor(v, o);
    return v;
}
__device__ __forceinline__ float fast_exp2(float x) { return __builtin_amdgcn_exp2f(x); }
__device__ __forceinline__ float fast_exp(float x) { return __builtin_amdgcn_exp2f(x * 1.4426950408889634f); }
__device__ __forceinline__ float silu_f(float x) { return x * __builtin_amdgcn_rcpf(1.0f + fast_exp2(-1.4426950408889634f * x)); }

__device__ __forceinline__ float dpp_ror1(float v) { return __builtin_bit_cast(float, __builtin_amdgcn_update_dpp(0, __builtin_bit_cast(int, v), 0x121, 0xf, 0xf, true)); }
__device__ __forceinline__ float dpp_ror15(float v) { return __builtin_bit_cast(float, __builtin_amdgcn_update_dpp(0, __builtin_bit_cast(int, v), 0x12f, 0xf, 0xf, true)); }
__device__ __forceinline__ float dpp_shr1(float old, float v) { return __builtin_bit_cast(float, __builtin_amdgcn_update_dpp(__builtin_bit_cast(int, old), __builtin_bit_cast(int, v), 0x111, 0xf, 0xf, false)); }
__device__ __forceinline__ float dpp_shl1(float old, float v) { return __builtin_bit_cast(float, __builtin_amdgcn_update_dpp(__builtin_bit_cast(int, old), __builtin_bit_cast(int, v), 0x101, 0xf, 0xf, false)); }

namespace pg8 {
constexpr int BM = 256, BK = 64, HALF = 128, HTB = HALF * BK * 2, STAGE_BYTES = 8 * HTB, NXCD = 8, WGM = 8;
__host__ __device__ __forceinline__ int lds_byte(int r, int c) { const int st = (r >> 4) * 2 + (c >> 5), rr = r & 15, cc = c & 31, ob = rr * 64 + cc * 2; return st * 1024 + (ob ^ (((ob >> 9) & 1) << 5)); }
__host__ __device__ __forceinline__ void stage_rc(int b, int& R, int& C) { const int st = b / 1024, sb = b % 1024, swz = sb ^ (((sb >> 9) & 1) << 5); R = (st >> 1) * 16 + swz / 64; C = (st & 1) * 32 + (swz % 64) / 2; }
__host__ __device__ __forceinline__ int perm32(int rho) { const int n = rho >> 4, i = rho & 15; return 8 * (i >> 2) + 4 * n + (i & 3); }

struct Unit { int pm, pn, ar; };
struct Gemm { const bf16_t* A; const bf16_t* Bt; int M, N, K; };

struct StaticOrder {
    int nM, nN, nwg, G, c, conv, Mrows;
    __host__ __device__ void init(int M_, int N_, int G_, int c_, int conv_ = 0) { conv = conv_; Mrows = M_; nM = conv_ ? (M_ + 253) / 254 : M_ / BM; nN = N_ / BM; nwg = nM * nN; G = G_; c = c_; }
    __host__ __device__ bool next(int i, Unit& u) const {
        const long L = (long)i * G + c; if (L >= nwg) return false;
        int wgid = (int)L; { const int q = nwg / NXCD, r = nwg % NXCD, xcd = wgid % NXCD, off = wgid / NXCD; wgid = (xcd < r ? xcd * (q + 1) : r * (q + 1) + (xcd - r) * q) + off; }
        const int nig = WGM * nN, gid = wgid / nig, fm = gid * WGM, gsz = (nM - fm) < WGM ? (nM - fm) : WGM;
        u.pm = fm + ((wgid % nig) % gsz); u.pn = (wgid % nig) / gsz;
        if (conv) { int s = 254 * u.pm - 1; s = s < 0 ? 0 : s; u.ar = s > Mrows - BM ? Mrows - BM : s; } else u.ar = u.pm * BM;
        return true;
    }
};

struct EpiStore {
    static constexpr bool PERM = true;
    bf16_t* O; int ldc;
    __device__ __forceinline__ void operator()(const f32x4 (&acc)[2][2][4][2], const Unit& u, int wr, int wc, int fr, int fq, lds_u8*) const {
        const int row0 = u.pm * BM + wr * 64 + fr, col0 = u.pn * BM + wc * 32 + 8 * fq;
#pragma unroll
        for (int ai = 0; ai < 2; ++ai)
#pragma unroll
            for (int m = 0; m < 4; ++m) { bf16_t* rowp = O + (size_t)(row0 + ai * HALF + m * 16) * ldc + col0;
#pragma unroll
                for (int bj = 0; bj < 2; ++bj) { const f32x4 v0 = acc[ai][bj][m][0], v1 = acc[ai][bj][m][1];
                    u32x4 w; w.x = pk2(v0[0], v0[1]); w.y = pk2(v0[2], v0[3]); w.z = pk2(v1[0], v1[1]); w.w = pk2(v1[2], v1[3]);
                    *(u32x4*)(rowp + bj * HALF) = w; } }
    }
};
struct EpiResid {
    static constexpr bool PERM = true;
    unsigned char* ws; const float* xin32; float* out32; const float* normg;
    int l, second, nfuse;
    __device__ __forceinline__ void operator()(f32x4 (&acc)[2][2][4][2], const Unit& u, int wr, int wc, int fr, int fq, lds_u8* lds) const {
        const int col0 = u.pn * BM + wc * 32 + 8 * fq;
        const int bidx = (u.pm * BM) / SEQ;
        bf16_t* const xb16 = (bf16_t*)(ws + WS_XB);
        const float* const modl = (const float*)(ws + WS_MOD) + (size_t)l * 8 * 6144;
        const float* const gate = modl + (second ? 5 : 2) * DM;
        const float* const ng = normg + (size_t)(second ? (l + 1) * 2 : l * 2 + 1) * DM;
        const float* const nmod = second ? modl + 8 * 6144 : modl + 3 * DM;
        const int nidx = nfuse ? l * 2 + second : -1;
        const float* gb = gate + (size_t)bidx * 6144 + col0;
        f32x4 gv[2][2];
#pragma unroll
        for (int bj = 0; bj < 2; ++bj)
#pragma unroll
            for (int n = 0; n < 2; ++n) gv[bj][n] = *(const f32x4*)(gb + bj * HALF + 4 * n);
#pragma unroll
        for (int ai = 0; ai < 2; ++ai)
#pragma unroll
            for (int m = 0; m < 4; ++m) { const size_t off = (size_t)(u.pm * BM + ai * HALF + wr * 64 + m * 16 + fr) * DM + col0;
#pragma unroll
                for (int bj = 0; bj < 2; ++bj) {
                    f32x4 x0, x1;
                    if (xin32) { x0 = *(const f32x4*)(xin32 + off + bj * HALF); x1 = *(const f32x4*)(xin32 + off + bj * HALF + 4); }
                    else { const u32x4 w = *(const u32x4*)(xb16 + off + bj * HALF); x0 = (f32x4){bflo(w.x), bfhi(w.x), bflo(w.y), bfhi(w.y)}; x1 = (f32x4){bflo(w.z), bfhi(w.z), bflo(w.w), bfhi(w.w)}; }
                    const f32x4 y0 = x0 + gv[bj][0] * acc[ai][bj][m][0], y1 = x1 + gv[bj][1] * acc[ai][bj][m][1];
                    acc[ai][bj][m][0] = y0; acc[ai][bj][m][1] = y1;
                    if (out32) { __builtin_nontemporal_store(y0, (f32x4*)(out32 + off + bj * HALF)); __builtin_nontemporal_store(y1, (f32x4*)(out32 + off + bj * HALF + 4)); }
                    else { u32x4 w; w.x = pk2(y0[0], y0[1]); w.y = pk2(y0[2], y0[3]); w.z = pk2(y1[0], y1[1]); w.w = pk2(y1[2], y1[3]); *(u32x4*)(xb16 + off + bj * HALF) = w; }
                } }
        if (nidx < 0) return;
        asm volatile("" : "+v"(fr), "+v"(fq));
        bf16_t* const hn = (bf16_t*)(ws + WS_H); float* const slots = (float*)(ws + WS_CTL + 512 * 1024); unsigned* const cnt = (unsigned*)(ws + WS_CTL) + 8192 + nidx * 1024;
        LAS float* P = (LAS float*)(lds + STAGE_BYTES);
        LAS float* S = P + 1024;
#pragma unroll
        for (int ai = 0; ai < 2; ++ai)
#pragma unroll
            for (int m = 0; m < 4; ++m) { float s = 0.f;
#pragma unroll
                for (int bj = 0; bj < 2; ++bj)
#pragma unroll
                    for (int n = 0; n < 2; ++n) { const f32x4 v = acc[ai][bj][m][n]; s += (v[0] * v[0] + v[1] * v[1]) + (v[2] * v[2] + v[3] * v[3]); }
                s += __shfl_xor(s, 16); s += __shfl_xor(s, 32);
                if (fq == 0) P[(ai * HALF + wr * 64 + m * 16 + fr) * 4 + wc] = s; }
        asm volatile("s_waitcnt lgkmcnt(0)" ::: "memory"); __builtin_amdgcn_s_barrier(); asm volatile("" ::: "memory");
        const int tid = (wr * 4 + wc) * 64 + fr + 16 * fq;
        unsigned* slot_u = (unsigned*)slots + ((size_t)u.pm * BM) * 4;
        if (tid < 256) { const float t = (P[tid * 4] + P[tid * 4 + 1]) + (P[tid * 4 + 2] + P[tid * 4 + 3]);
            __hip_atomic_store(slot_u + tid * 4 + u.pn, __builtin_bit_cast(unsigned, t), __ATOMIC_RELAXED, __HIP_MEMORY_SCOPE_AGENT); }
        asm volatile("s_waitcnt vmcnt(0)" ::: "memory"); __builtin_amdgcn_s_barrier(); asm volatile("" ::: "memory");
        if (tid == 0) {
            unsigned* c = cnt + u.pm * 16;
            __builtin_amdgcn_fence(__ATOMIC_RELEASE, "agent");
            asm volatile("s_waitcnt vmcnt(0)" ::: "memory");
            (void)__hip_atomic_fetch_add(c, 1u, __ATOMIC_RELAXED, __HIP_MEMORY_SCOPE_AGENT);
            unsigned sp = 0u;
            while (__hip_atomic_load(c, __ATOMIC_RELAXED, __HIP_MEMORY_SCOPE_AGENT) < 4u) { __builtin_amdgcn_s_sleep(1); if (++sp > (1u << 22)) break; }
            __builtin_amdgcn_fence(__ATOMIC_ACQUIRE, "agent");
            asm volatile("s_waitcnt vmcnt(0)" ::: "memory");
        }
        __builtin_amdgcn_s_barrier(); asm volatile("" ::: "memory");
        if (tid < 256) { float t = 0.f;
#pragma unroll
            for (int p = 0; p < 4; ++p) t += __builtin_bit_cast(float, __hip_atomic_load(slot_u + tid * 4 + p, __ATOMIC_RELAXED, __HIP_MEMORY_SCOPE_AGENT));
            S[tid] = rsqrtf(t * (1.f / DM) + EPS); }
        asm volatile("s_waitcnt lgkmcnt(0)" ::: "memory"); __builtin_amdgcn_s_barrier(); asm volatile("" ::: "memory");
        const float* shp = nmod + (size_t)bidx * 6144 + col0; const float* scp = shp + DM; const float* gp = ng + col0;
#pragma unroll
        for (int bj = 0; bj < 2; ++bj)
#pragma unroll
            for (int n = 0; n < 2; ++n) {
                const f32x4 gn = *(const f32x4*)(gp + bj * HALF + 4 * n) * (*(const f32x4*)(scp + bj * HALF + 4 * n) + 1.0f), sn = *(const f32x4*)(shp + bj * HALF + 4 * n);
#pragma unroll
                for (int ai = 0; ai < 2; ++ai)
#pragma unroll
                    for (int m = 0; m < 4; ++m) { const int rl = ai * HALF + wr * 64 + m * 16 + fr; const float rstd = S[rl];
                        const f32x4 h0 = acc[ai][bj][m][n] * rstd * gn + sn;
                        u32x2 w; w.x = pk2(h0[0], h0[1]); w.y = pk2(h0[2], h0[3]);
                        *(u32x2*)(hn + (size_t)(u.pm * BM + rl) * DM + col0 + bj * HALF + 4 * n) = w; }
            }
    }
};

struct EpiConvGate {
    static constexpr bool PERM = true;
    bf16_t* act; const float* cw; const float* cb;
    __device__ __forceinline__ void operator()(const f32x4 (&acc)[2][2][4][2], const Unit& u, int wr, int wc, int fr, int fq, lds_u8* lds) const {
        LAS float* xch = (LAS float*)(lds + STAGE_BYTES);
        int colw = wc * 32 + 8 * fq; asm volatile("" : "+v"(colw));
#pragma unroll
        for (int ai = 0; ai < 2; ++ai) { const int rho = 2 * ai + wr;
#pragma unroll
            for (int bj = 0; bj < 2; ++bj)
#pragma unroll
                for (int n = 0; n < 2; ++n) {
                    if (fr == 0) *(LAS f32x4*)(xch + (rho * 2) * 256 + bj * 128 + colw + 4 * n) = acc[ai][bj][0][n];
                    if (fr == 15) *(LAS f32x4*)(xch + (rho * 2 + 1) * 256 + bj * 128 + colw + 4 * n) = acc[ai][bj][3][n]; } }
        asm volatile("s_waitcnt lgkmcnt(0)" ::: "memory"); __builtin_amdgcn_s_barrier(); asm volatile("" ::: "memory");
        const int jcol = u.pn * 128 + colw;
        const int olo = 254 * u.pm, ohi = (olo + 254 < M) ? olo + 254 : M;
#pragma unroll
        for (int n = 0; n < 2; ++n) {
            const int ja = jcol + 4 * n, jb = FF + ja;
            const f32x4 wa0 = *(const f32x4*)(cw + ja), wa1 = *(const f32x4*)(cw + UPW + ja), wa2 = *(const f32x4*)(cw + 2 * UPW + ja), ba = *(const f32x4*)(cb + ja);
            const f32x4 wb0 = *(const f32x4*)(cw + jb), wb1 = *(const f32x4*)(cw + UPW + jb), wb2 = *(const f32x4*)(cw + 2 * UPW + jb), bb = *(const f32x4*)(cb + jb);
#pragma unroll
            for (int ai = 0; ai < 2; ++ai) {
                const int rho = 2 * ai + wr;
                const f32x4 z4 = (f32x4){0.f, 0.f, 0.f, 0.f};
#pragma unroll
                for (int m = 0; m < 4; ++m) {
                    f32x4 Xa = z4, Xb = z4, Ya = z4, Yb = z4;
                    if (m == 0 && rho > 0) { Xa = *(const LAS f32x4*)(xch + ((rho - 1) * 2 + 1) * 256 + colw + 4 * n); Xb = *(const LAS f32x4*)(xch + ((rho - 1) * 2 + 1) * 256 + 128 + colw + 4 * n); }
                    if (m == 3 && rho < 3) { Ya = *(const LAS f32x4*)(xch + ((rho + 1) * 2) * 256 + colw + 4 * n); Yb = *(const LAS f32x4*)(xch + ((rho + 1) * 2) * 256 + 128 + colw + 4 * n); }
                    const int gr = u.ar + ai * HALF + wr * 64 + m * 16 + fr;
                    const int t = gr & (SEQ - 1);
                    const bool hasp = t != 0, hasn = t != SEQ - 1;
                    const f32x4 va = acc[ai][0][m][n], vb = acc[ai][1][m][n];
                    f32x4 pa, pb, na, nb;
#pragma unroll
                    for (int j = 0; j < 4; ++j) {
                        pa[j] = dpp_shr1(m > 0 ? dpp_ror1(acc[ai][0][m > 0 ? m - 1 : 0][n][j]) : Xa[j], va[j]);
                        pb[j] = dpp_shr1(m > 0 ? dpp_ror1(acc[ai][1][m > 0 ? m - 1 : 0][n][j]) : Xb[j], vb[j]);
                        na[j] = dpp_shl1(m < 3 ? dpp_ror15(acc[ai][0][m < 3 ? m + 1 : 3][n][j]) : Ya[j], va[j]);
                        nb[j] = dpp_shl1(m < 3 ? dpp_ror15(acc[ai][1][m < 3 ? m + 1 : 3][n][j]) : Yb[j], vb[j]);
                    }
                    const float fp = hasp ? 1.0f : 0.0f, fn = hasn ? 1.0f : 0.0f;
                    const f32x4 ca = ba + (wa0 * fp) * pa + wa1 * va + (wa2 * fn) * na;
                    const f32x4 cbv = bb + (wb0 * fp) * pb + wb1 * vb + (wb2 * fn) * nb;
                    const f32x4 ex = ca * -1.4426950408889634f;
                    f32x4 sg;
#pragma unroll
                    for (int j = 0; j < 4; ++j) sg[j] = __builtin_amdgcn_rcpf(1.0f + fast_exp2(ex[j]));
                    const f32x4 r = ca * sg * cbv;
                    if (gr >= olo && gr < ohi) { u32x2 w; w.x = pk2(r[0], r[1]); w.y = pk2(r[2], r[3]); *(u32x2*)(act + (size_t)gr * FF + ja) = w; }
                }
            }
        }
    }
};

template <class Epi, class Sched>
__device__ __forceinline__ void gemm_phase(lds_u8* lds, const Gemm g, const Sched& S, const Epi& E, const int tid) {
    const int wid = __builtin_amdgcn_readfirstlane(tid >> 6), lane = tid & 63, wr = wid >> 2, wc = wid & 3, fr = lane & 15, fq = lane >> 4;
    const int K = g.K, nt = K / BK;
    unsigned voffA[2], voffB[2];
#pragma unroll
    for (int i = 0; i < 2; ++i) { int R, C; stage_rc(tid * 16 + i * 8192, R, C); const int Rb = Epi::PERM ? ((R & ~31) + perm32(R & 31)) : R;
        voffA[i] = (unsigned)(R * K + C) * 2u; voffB[i] = (unsigned)(Rb * K + C) * 2u; }
    const size_t kstep = (size_t)(BK * 2);
    const size_t hstep = (size_t)HALF * K * 2;
    const size_t tstep = 2 * hstep;
    const unsigned ldsw = (unsigned)wid * 1024u;
    const int aoff = lds_byte(wr * 64 + fr, fq * 8), boff = lds_byte(wc * 32 + fr, fq * 8);
#define PG8_SA(b, h) (((b) * 2 + (h)) * HTB)
#define PG8_SB(b, h) ((4 + (b) * 2 + (h)) * HTB)
#define PG8_STAGE(bufoff, gbase, voff) do { _Pragma("unroll") for (int _i = 0; _i < 2; ++_i) \
        __builtin_amdgcn_global_load_lds((const unsigned*)((const char*)(gbase) + (voff)[_i]), (LAS unsigned*)(lds + (bufoff) + ldsw + _i * 8192), 16, 0, 0); } while (0)
#define PG8_LDA(dst, b, h) do { _Pragma("unroll") for (int m = 0; m < 4; ++m) _Pragma("unroll") for (int k = 0; k < 2; ++k) dst[m][k] = *(const LAS bf16x8*)(lds + PG8_SA(b, h) + aoff + m * 2048 + k * 1024); } while (0)
#define PG8_LDB(dst, b, h) do { _Pragma("unroll") for (int n = 0; n < 2; ++n) _Pragma("unroll") for (int k = 0; k < 2; ++k) dst[n][k] = *(const LAS bf16x8*)(lds + PG8_SB(b, h) + boff + n * 2048 + k * 1024); } while (0)
#define PG8_MMA(ai, bj, At, Bt) do { __builtin_amdgcn_s_setprio(1); _Pragma("unroll") for (int m = 0; m < 4; ++m) _Pragma("unroll") for (int n = 0; n < 2; ++n) _Pragma("unroll") for (int k = 0; k < 2; ++k) \
        acc[ai][bj][m][n] = __builtin_amdgcn_mfma_f32_16x16x32_bf16(Bt[n][k], At[m][k], acc[ai][bj][m][n], 0, 0, 0); __builtin_amdgcn_s_setprio(0); } while (0)
#define PG8_WAIT_V(n) asm volatile("s_waitcnt vmcnt(" #n ")" ::: "memory")
#define PG8_WAIT_L(n) asm volatile("s_waitcnt lgkmcnt(" #n ")" ::: "memory")
#define PG8_BAR __builtin_amdgcn_s_barrier()
#define PG8_SCHED __builtin_amdgcn_sched_barrier(0)
    Unit cur, nxt; int ui = 0;
    if (!S.next(0, cur)) return;
    f32x4 acc[2][2][4][2];
#pragma unroll
    for (int a = 0; a < 2; ++a)
#pragma unroll
        for (int b = 0; b < 2; ++b)
#pragma unroll
            for (int m = 0; m < 4; ++m)
#pragma unroll
                for (int n = 0; n < 2; ++n) acc[a][b][m][n] = (f32x4){0.f, 0.f, 0.f, 0.f};
    bf16x8 At[4][2], B0[2][2], B1[2][2];
    const char* cA = (const char*)g.A + (size_t)cur.ar * (size_t)(K * 2); const char* cB = (const char*)g.Bt + (size_t)cur.pn * tstep;
    PG8_STAGE(PG8_SB(0, 0), cB, voffB); PG8_STAGE(PG8_SB(0, 1), cB + hstep, voffB); PG8_STAGE(PG8_SA(0, 0), cA, voffA); PG8_STAGE(PG8_SA(0, 1), cA + hstep, voffA);
    if (wr == 1) PG8_BAR;
    PG8_WAIT_V(2); PG8_BAR;
    PG8_STAGE(PG8_SB(1, 0), cB + kstep, voffB); PG8_STAGE(PG8_SA(1, 0), cA + kstep, voffA); PG8_STAGE(PG8_SB(1, 1), cB + hstep + kstep, voffB);
    PG8_WAIT_V(6); PG8_BAR;
    for (;;) {
        const bool has_next = S.next(ui + 1, nxt);
        const char* nA = has_next ? (const char*)g.A + (size_t)nxt.ar * (size_t)(K * 2) : cA; const char* nB = has_next ? (const char*)g.Bt + (size_t)nxt.pn * tstep : cB;
        for (int t = 0; t < nt; t += 2) {
            const bool last = (t == nt - 2);
            const char* a1 = cA + (size_t)(t + 1) * kstep;
            const char* a2 = last ? nA : cA + (size_t)(t + 2) * kstep; const char* b2 = last ? nB : cB + (size_t)(t + 2) * kstep;
            const char* a3 = a2 + kstep; const char* b3 = b2 + kstep;
            PG8_LDB(B0, 0, 0); PG8_LDB(B1, 0, 1); PG8_SCHED; PG8_LDA(At, 0, 0); PG8_STAGE(PG8_SA(1, 1), a1 + hstep, voffA);
            PG8_WAIT_V(8); PG8_WAIT_L(0); PG8_BAR; PG8_MMA(0, 0, At, B0); PG8_MMA(0, 1, At, B1); PG8_BAR; PG8_SCHED;
            PG8_LDA(At, 0, 1); PG8_STAGE(PG8_SB(0, 0), b2, voffB); PG8_STAGE(PG8_SB(0, 1), b2 + hstep, voffB); PG8_STAGE(PG8_SA(0, 0), a2, voffA);
            PG8_WAIT_V(8); PG8_WAIT_L(0); PG8_BAR; PG8_MMA(1, 0, At, B0); PG8_MMA(1, 1, At, B1); PG8_BAR; PG8_SCHED;
            PG8_LDB(B0, 1, 0); PG8_LDB(B1, 1, 1); PG8_SCHED; PG8_LDA(At, 1, 0); PG8_STAGE(PG8_SA(0, 1), a2 + hstep, voffA);
            PG8_WAIT_V(8); PG8_WAIT_L(0); PG8_BAR; PG8_MMA(0, 0, At, B0); PG8_MMA(0, 1, At, B1); PG8_BAR; PG8_SCHED;
            PG8_LDA(At, 1, 1); PG8_STAGE(PG8_SB(1, 0), b3, voffB); PG8_STAGE(PG8_SB(1, 1), b3 + hstep, voffB); PG8_STAGE(PG8_SA(1, 0), a3, voffA);
            PG8_WAIT_V(8); PG8_WAIT_L(0); PG8_BAR; PG8_MMA(1, 0, At, B0); PG8_MMA(1, 1, At, B1); PG8_BAR; PG8_SCHED;
        }
        if (wr == 0) PG8_BAR;
        E(acc, cur, wr, wc, fr, fq, lds);
        if (!has_next) break;
#pragma unroll
        for (int a = 0; a < 2; ++a)
#pragma unroll
            for (int b = 0; b < 2; ++b)
#pragma unroll
                for (int m = 0; m < 4; ++m)
#pragma unroll
                    for (int n = 0; n < 2; ++n) acc[a][b][m][n] = (f32x4){0.f, 0.f, 0.f, 0.f};
        cur = nxt; cA = nA; cB = nB; ++ui;
        if (wr == 1) PG8_BAR;
    }
    PG8_WAIT_V(0);
    PG8_BAR;
#undef PG8_SA
#undef PG8_SB
#undef PG8_STAGE
#undef PG8_LDA
#undef PG8_LDB
#undef PG8_MMA
#undef PG8_WAIT_V
#undef PG8_WAIT_L
#undef PG8_BAR
#undef PG8_SCHED
}
}

struct Args {
    const float* in[17];
    float* out; unsigned char* ws;
    int ph_lo, ph_hi;
};
enum { I_X = 0, I_C, I_WADA, I_BADA, I_NORMG, I_WIN, I_AQN, I_AKN, I_BLB, I_BON, I_CQN, I_CKN, I_WOUT, I_WUP, I_CONVW, I_CONVB, I_WDOWN };

__device__ __forceinline__ void p0_transpose_item(const float* W, int K, int N, bf16_t* WT, int mode, LAS float* scr, int item, int lane) {
    const int nblk = N / 32, kb = item / nblk, nb = item % nblk, k0 = 64 * kb, n0 = 32 * nb;
    int rbase = n0;
    if (mode == 1) { const int isb = n0 / FF, j0 = n0 % FF; rbase = 256 * (j0 / 128) + (j0 % 128) + 128 * isb; }
    { float tmp[32];
#pragma unroll
      for (int i = 0; i < 32; ++i) { const int kk = 2 * i + (lane >> 5); tmp[i] = __builtin_nontemporal_load(&W[(size_t)(k0 + kk) * N + n0 + (lane & 31)]); }
#pragma unroll
      for (int i = 0; i < 32; ++i) { const int kk = 2 * i + (lane >> 5); scr[kk * 33 + (lane & 31)] = tmp[i]; } }
    asm volatile("s_waitcnt lgkmcnt(0)" ::: "memory");
    const int c = lane & 7;
#pragma unroll
    for (int j = 0; j < 4; ++j) { const int n = (lane >> 3) + 8 * j; const LAS float* s = scr + (8 * c) * 33 + n;
        u32x4 o; o.x = pk2(s[0 * 33], s[1 * 33]); o.y = pk2(s[2 * 33], s[3 * 33]); o.z = pk2(s[4 * 33], s[5 * 33]); o.w = pk2(s[6 * 33], s[7 * 33]);
        *(u32x4*)(WT + (size_t)(rbase + n) * K + k0 + 8 * c) = o; }
    asm volatile("s_waitcnt lgkmcnt(0)" ::: "memory");
}

__device__ __forceinline__ void phase_prologue(const Args& a, lds_u8* lds, int vcu, int G, const int tid, const int bx) {
    const int lane = tid & 63, wave = tid >> 6;
    unsigned char* ws = a.ws;
    if (bx == 0) {
        float* tb = (float*)(ws + WS_ROPE);
        for (int e = tid; e < 1024; e += NTHREADS) { const int pos = e >> 4, i = e & 15; const float inv = exp2f(-(float)i * (13.287712379549449f / 16.0f)); const float ang = (float)pos * inv;
            tb[2 * e] = cosf(ang); tb[2 * e + 1] = sinf(ang); }
    }
    {
        LAS float* sc = (LAS float*)(lds + 0);
        LAS float* red = (LAS float*)(lds + 32768);
        bool have = false;
        for (int it = vcu; it < DEPTH * 96; it += G) {
            if (!have) { const float* c = a.in[I_C];
                for (int e = tid; e < NB * DM; e += NTHREADS) { const int b = e >> 10, k = e & 1023; sc[k * 8 + b] = silu_f(c[e]); }
                have = true; __syncthreads(); }
            const int l = it / 96, n0 = 64 * (it % 96);
            const float* wp = a.in[I_WADA] + ((size_t)l * DM + 128 * wave) * 6144 + n0 + lane;
            float acc[8];
#pragma unroll
            for (int b = 0; b < 8; ++b) acc[b] = 0.f;
#pragma unroll 32
            for (int kk = 0; kk < 128; ++kk) { const float wv = __builtin_nontemporal_load(&wp[(size_t)kk * 6144]); const LAS f32x4* s4 = (const LAS f32x4*)(sc + (128 * wave + kk) * 8); const f32x4 s0 = s4[0], s1 = s4[1];
                acc[0] += s0[0] * wv; acc[1] += s0[1] * wv; acc[2] += s0[2] * wv; acc[3] += s0[3] * wv; acc[4] += s1[0] * wv; acc[5] += s1[1] * wv; acc[6] += s1[2] * wv; acc[7] += s1[3] * wv; }
#pragma unroll
            for (int b = 0; b < 8; ++b) red[(wave * 8 + b) * 64 + lane] = acc[b];
            __syncthreads();
            { const int b = tid >> 6, col = tid & 63; float s = 0.f;
#pragma unroll
              for (int w = 0; w < 8; ++w) s += red[(w * 8 + b) * 64 + col];
              ((float*)(ws + WS_MOD))[((size_t)l * 8 + b) * 6144 + n0 + col] = s + a.in[I_BADA][(size_t)l * 6144 + n0 + col]; }
            __syncthreads();
        }
        __syncthreads();
    }
    {
        LAS float* scr = (LAS float*)(lds + wave * 8448);
        const int gw = vcu * 8 + wave, NGW = G * 8;
        constexpr int I_IN = 16 * (INW / 32), I_OUT = 16 * (DM / 32), I_UP = 16 * (UPW / 32), I_DN = (FF / 64) * (DM / 32), I_LAYER = I_IN + I_OUT + I_UP + I_DN;
        for (int it = gw; it < DEPTH * I_LAYER; it += NGW) {
            const int l = it / I_LAYER; int r = it % I_LAYER;
            if (r < I_IN) { p0_transpose_item(a.in[I_WIN] + (size_t)l * DM * INW, DM, INW, (bf16_t*)(ws + WS_WIN) + (size_t)l * INW * DM, 0, scr, r, lane); continue; } r -= I_IN;
            if (r < I_OUT) { p0_transpose_item(a.in[I_WOUT] + (size_t)l * DM * DM, DM, DM, (bf16_t*)(ws + WS_WOUT) + (size_t)l * DM * DM, 0, scr, r, lane); continue; } r -= I_OUT;
            if (r < I_UP) { p0_transpose_item(a.in[I_WUP] + (size_t)l * DM * UPW, DM, UPW, (bf16_t*)(ws + WS_WUP) + (size_t)l * UPW * DM, 1, scr, r, lane); continue; } r -= I_UP;
            p0_transpose_item(a.in[I_WDOWN] + (size_t)l * FF * DM, FF, DM, (bf16_t*)(ws + WS_WDN) + (size_t)l * DM * FF, 0, scr, r, lane);
        }
    }
}

__device__ __forceinline__ void norm_rows4(const float* x, const float* g, const float* mod_l  , int which_sh, bf16_t* h, int m0, int lane) {
    const int b = m0 / SEQ;
    const f32x4* gr = (const f32x4*)g + lane;
    const f32x4* shr = (const f32x4*)(mod_l + (size_t)b * 6144 + which_sh * DM) + lane;
    const f32x4* scr = (const f32x4*)(mod_l + (size_t)b * 6144 + (which_sh + 1) * DM) + lane;
    f32x4 v[4][4];
#pragma unroll
    for (int r = 0; r < 4; ++r) { const f32x4* xr = (const f32x4*)(x + (size_t)(m0 + r) * DM) + lane;
#pragma unroll
        for (int j = 0; j < 4; ++j) v[r][j] = xr[64 * j]; }
    f32x4 gs[4], sh[4];
#pragma unroll
    for (int j = 0; j < 4; ++j) { gs[j] = gr[64 * j] * (scr[64 * j] + 1.0f); sh[j] = shr[64 * j]; }
#pragma unroll
    for (int r = 0; r < 4; ++r) {
        float s = 0.f;
#pragma unroll
        for (int j = 0; j < 4; ++j) s += (v[r][j].x * v[r][j].x + v[r][j].y * v[r][j].y) + (v[r][j].z * v[r][j].z + v[r][j].w * v[r][j].w);
        const float rstd = rsqrtf(wave_sum(s) * (1.f / DM) + EPS);
        u32x2* o8 = (u32x2*)(h + (size_t)(m0 + r) * DM) + lane;
#pragma unroll
        for (int j = 0; j < 4; ++j) { const f32x4 y = v[r][j] * rstd * gs[j] + sh[j];
            u32x2 w; w.x = pk2(y.x, y.y); w.y = pk2(y.z, y.w); o8[64 * j] = w; }
    }
}
__device__ __forceinline__ void norm_rows4_bf(const bf16_t* x, const float* g, const float* mod_l  , int which_sh, bf16_t* h, int m0, int lane) {
    const int b = m0 / SEQ;
    const float* shp = mod_l + (size_t)b * 6144 + which_sh * DM; const float* scp = shp + DM;
    u32x4 raw[4][2];
#pragma unroll
    for (int r = 0; r < 4; ++r) { const u32x4* xr = (const u32x4*)(x + (size_t)(m0 + r) * DM) + lane; raw[r][0] = xr[0]; raw[r][1] = xr[64]; }
    f32x4 gs[2][2], sh[2][2];
#pragma unroll
    for (int c = 0; c < 2; ++c)
#pragma unroll
        for (int q = 0; q < 2; ++q) { const int col = 512 * c + 8 * lane + 4 * q; gs[c][q] = *(const f32x4*)(g + col) * (*(const f32x4*)(scp + col) + 1.0f); sh[c][q] = *(const f32x4*)(shp + col); }
#pragma unroll
    for (int r = 0; r < 4; ++r) {
        f32x4 v[2][2]; float s = 0.f;
#pragma unroll
        for (int c = 0; c < 2; ++c) { const u32x4 w = raw[r][c]; v[c][0] = (f32x4){bflo(w.x), bfhi(w.x), bflo(w.y), bfhi(w.y)}; v[c][1] = (f32x4){bflo(w.z), bfhi(w.z), bflo(w.w), bfhi(w.w)};
#pragma unroll
            for (int q = 0; q < 2; ++q) s += (v[c][q].x * v[c][q].x + v[c][q].y * v[c][q].y) + (v[c][q].z * v[c][q].z + v[c][q].w * v[c][q].w); }
        const float rstd = rsqrtf(wave_sum(s) * (1.f / DM) + EPS);
        u32x4* o16 = (u32x4*)(h + (size_t)(m0 + r) * DM) + lane;
#pragma unroll
        for (int c = 0; c < 2; ++c) { const f32x4 y0 = v[c][0] * rstd * gs[c][0] + sh[c][0], y1 = v[c][1] * rstd * gs[c][1] + sh[c][1];
            u32x4 w; w.x = pk2(y0.x, y0.y); w.y = pk2(y0.z, y0.w); w.z = pk2(y1.x, y1.y); w.w = pk2(y1.z, y1.w); o16[64 * c] = w; }
    }
}
__device__ __forceinline__ void phase_norm_bf(const bf16_t* x, const float* g, const float* mod_l, int which_sh, bf16_t* h, int vcu, int G, const int tid) {
    const int lane = tid & 63, wave = tid >> 6;
    const int gw = vcu * 8 + wave, NGW = G * 8;
    for (int m0 = gw * 4; m0 < M; m0 += NGW * 4) norm_rows4_bf(x, g, mod_l, which_sh, h, m0, lane);
}
__device__ __forceinline__ void phase_norm(const float* x, const float* g, const float* mod_l, int which_sh, bf16_t* h, int vcu, int G, const int tid) {
    const int lane = tid & 63, wave = tid >> 6;
    const int gw = vcu * 8 + wave, NGW = G * 8;
    for (int m0 = gw * 4; m0 < M; m0 += NGW * 4) norm_rows4(x, g, mod_l, which_sh, h, m0, lane);
}

__device__ __forceinline__ float hgrn_lb(const float* b_lb, int dir, int l, int col) {
    const float* p = b_lb + (size_t)dir * DEPTH * 256 + col;
    const float v0 = p[0], v1 = p[256], v2 = p[512], v3 = p[768];
    const float mx = fmaxf(fmaxf(v0, v1), fmaxf(v2, v3));
    const float e0 = __expf(v0 - mx), e1 = __expf(v1 - mx), e2 = __expf(v2 - mx), e3 = __expf(v3 - mx);
    const float s = e0 + e1 + e2 + e3;
    float acc = 0.f; if (l >= 1) acc += e1; if (l >= 2) acc += e2; if (l >= 3) acc += e3;
    return acc / s;
}
__device__ __forceinline__ void hgrn_fk(float xpre, float lb, float& lf, float& kk) {
    float f = lb + (1.0f - lb) * __builtin_amdgcn_rcpf(1.0f + fast_exp2(-1.4426950408889634f * xpre));
    f = fmaxf(f, 1e-6f);
    lf = __builtin_amdgcn_logf(f); kk = 1.0f - f;
}

__device__ __forceinline__ void phase_prep(const Args& a, lds_u8* lds, int l, int vcu, int G, const int tid, const bool dry) {
    const int lane = tid & 63, wave = tid >> 6;
    const int gw = vcu * 8 + wave, NGW = G * 8;
    unsigned char* ws = a.ws;
    bf16_t* proj = (bf16_t*)(ws + WS_PROJ);
    const float* rope = (const float*)(ws + WS_ROPE);
    {
        const float gak = a.in[I_AKN][l * 64 + lane], gck = a.in[I_CKN][l * 64 + lane];
        const int half = lane >> 5, side = (lane >> 4) & 1, i = lane & 15;
        for (int m0 = gw * 4; m0 < M; m0 += NGW * 4) {
            unsigned short raw[4][4];
#pragma unroll
            for (int r = 0; r < 4; ++r) { const bf16_t* row = proj + (size_t)(m0 + r) * INW;
                raw[r][0] = row[C_AK + lane]; raw[r][1] = row[C_AK + 64 + lane]; raw[r][2] = row[C_CK + lane]; raw[r][3] = row[C_CK + 64 + lane]; }
#pragma unroll
            for (int r = 0; r < 4; ++r) {
                const int m = m0 + r, t = m & (SEQ - 1);
                bf16_t* wrow = (dry ? (bf16_t*)(ws + WS_U) : proj) + (size_t)m * INW;
                const int pos = half ? (t & 63) : (t >> 6);
                const float cs = rope[(pos * 16 + i) * 2], sn = rope[(pos * 16 + i) * 2 + 1];
#pragma unroll
                for (int hh = 0; hh < 2; ++hh) {
                    float v = bf2f(raw[r][hh]);
                    const float ss = wave_sum(v * v);
                    v = v * rsqrtf(ss * (1.f / 64) + EPS) * gak;
                    const float pr = __shfl_xor(v, 16);
                    const float o = side ? (v * cs + pr * sn) : (v * cs - pr * sn);
                    wrow[C_AK + hh * 64 + lane] = (bf16_t)f2bf(o);
                }
#pragma unroll
                for (int hh = 0; hh < 2; ++hh) {
                    float v = bf2f(raw[r][2 + hh]);
                    const float ss = wave_sum(v * v);
                    v = v * rsqrtf(ss * (1.f / 64) + EPS) * gck;
                    wrow[C_CK + hh * 64 + lane] = (bf16_t)f2bf(v);
                }
            }
        }
    }
    {
        LAS bf16_t* scr = (LAS bf16_t*)(lds + wave * 9216);
        bf16_t* vt = (bf16_t*)(ws + WS_VT);
        for (int it = gw; it < NB * 4 * 32; it += NGW) {
            const int b = it >> 7, kv4 = (it >> 5) & 3, tb = it & 31;
            const int col0 = (kv4 < 2 ? C_AV : C_CV) + (kv4 & 1) * 64;
            const bf16_t* src = proj + ((size_t)b * SEQ + tb * 64) * INW + col0 + lane;
#pragma unroll
            for (int rb = 0; rb < 64; rb += 32) { unsigned short tmp[32];
#pragma unroll
              for (int r = 0; r < 32; ++r) tmp[r] = src[(size_t)(rb + r) * INW];
#pragma unroll
              for (int r = 0; r < 32; ++r) scr[(rb + r) * 66 + lane] = tmp[r]; }
            asm volatile("s_waitcnt lgkmcnt(0)" ::: "memory");
            bf16_t* dst = vt + (((size_t)b * 4 + kv4) * 64) * SEQ + tb * 64 + lane;
#pragma unroll 16
            for (int d = 0; d < 64; ++d) dst[(size_t)d * SEQ] = scr[lane * 66 + d];
            asm volatile("s_waitcnt lgkmcnt(0)" ::: "memory");
        }
    }
    {
        LAS bf16_t* klt = (LAS bf16_t*)(lds + wave * 9216);
        float* HL = (float*)(ws + WS_HL); float* HDp = (float*)(ws + WS_HD);
        const int r16 = lane & 15, q4 = lane >> 4;
        for (int it = gw; it < NB * 4 * 2 * 32; it += NGW) {
            const int c = it & 31, dir = (it >> 5) & 1, hh = (it >> 6) & 3, b = it >> 8;
            const float lb = hgrn_lb(a.in[I_BLB], dir, l, hh * 64 + lane);
            const size_t rbase = (size_t)b * SEQ + c * 64;
            const int fcol = (dir ? C_BFB : C_BFF) + hh * 64 + lane;
            unsigned fpk[32];
#pragma unroll
            for (int s = 0; s < 64; s += 2) { const int t0 = dir ? (63 - s) : s, t1 = dir ? (62 - s) : s + 1; fpk[s >> 1] = (unsigned)proj[(rbase + t0) * INW + fcol] | ((unsigned)proj[(rbase + t1) * INW + fcol] << 16); }
            float total = 0.f;
#pragma unroll
            for (int s = 63; s >= 0; --s) { float lf, kk; hgrn_fk((s & 1) ? bfhi(fpk[s >> 1]) : bflo(fpk[s >> 1]), lb, lf, kk);
                klt[lane * 72 + s] = (bf16_t)f2bf(kk * fast_exp2(total)); total += lf; }
            asm volatile("s_waitcnt lgkmcnt(0)" ::: "memory");
            HDp[(size_t)it * 64 + lane] = fast_exp2(total);
            const int vcol = C_BI + hh * 64;
            float* Lo = HL + (size_t)it * 4096;
#pragma unroll
            for (int mi = 0; mi < 4; ++mi) {
                bf16x8 af[2];
#pragma unroll
                for (int ks = 0; ks < 2; ++ks)
#pragma unroll
                    for (int j = 0; j < 8; ++j) { const int s = 32 * ks + 8 * q4 + j; const int tk = dir ? (63 - s) : s; af[ks][j] = (short)proj[(rbase + tk) * INW + vcol + 16 * mi + r16]; }
#pragma unroll
                for (int ni = 0; ni < 4; ++ni) {
                    f32x4 acc = (f32x4){0.f, 0.f, 0.f, 0.f};
#pragma unroll
                    for (int ks = 0; ks < 2; ++ks) { const bf16x8 bfr = *(const LAS bf16x8*)(klt + (16 * ni + r16) * 72 + 32 * ks + 8 * q4);
                        acc = __builtin_amdgcn_mfma_f32_16x16x32_bf16(af[ks], bfr, acc, 0, 0, 0); }
#pragma unroll
                    for (int j = 0; j < 4; ++j) Lo[(16 * mi + 4 * q4 + j) * 64 + 16 * ni + r16] = acc[j];
                }
            }
            asm volatile("s_waitcnt lgkmcnt(0)" ::: "memory");
        }
    }
}

constexpr int AT_KV = 18432;
constexpr int AT_TBL = 4 * AT_KV;
__device__ __forceinline__ int pi32(int m) { return (m & ~12) | ((m & 4) << 1) | ((m & 8) >> 1); }

template <bool BIAS>
__device__ __forceinline__ void attn_unit(lds_u8* lds, const bf16_t* proj, const bf16_t* vt, bf16_t* mix, const bf16_t* po_far, const float* pl, const float* gq, const float* gk, const float* rope,
                                          int b, int h, int qblk, int qcol0, int kcol0, int vsel0, int mixcol0, const int tid) {
    const int lane = tid & 63, wave = __builtin_amdgcn_readfirstlane(tid >> 6);
    const int r32 = lane & 31, hi = lane >> 5;
    const int kvh = h / 3;
    const int q0 = qblk * 256;
    const int qp = q0 + 32 * wave + r32;
    int tlo = 0, ntile = SEQ / 64;
    if (BIAS) { const int klo = q0 - 256 < 0 ? 0 : q0 - 256, khi_ = q0 + 255 + 256 > SEQ - 1 ? SEQ - 1 : q0 + 255 + 256; tlo = klo >> 6; ntile = (khi_ >> 6) - tlo + 1; }
    const bf16_t* kbase = proj + (size_t)b * SEQ * INW + kcol0 + kvh * 64;
    const bf16_t* vbase = vt + ((size_t)b * 4 + vsel0 + kvh) * 64 * SEQ;
    const int lrow_ = tid >> 3, lc16 = tid & 7;
    u32x4 kreg, vreg;
#define AT_LOAD(tile) do { const int key0_ = (tile) * 64; kreg = *(const u32x4*)(kbase + (size_t)(key0_ + lrow_) * INW + lc16 * 8); vreg = *(const u32x4*)(vbase + (size_t)lrow_ * SEQ + key0_ + lc16 * 8); } while (0)
#define AT_STORE(bufi) do { lds_u8* bb_ = lds + (bufi) * AT_KV; *(LAS u32x4*)(bb_ + lrow_ * 144 + lc16 * 16) = kreg; *(LAS u32x4*)(bb_ + 9216 + lrow_ * 144 + lc16 * 16) = vreg; } while (0)
    u32x4 qraw[4];
    { const bf16_t* qrow = proj + ((size_t)b * SEQ + qp) * INW + qcol0 + h * 64 + 8 * hi;
#pragma unroll
      for (int d0 = 0; d0 < 4; ++d0) qraw[d0] = *(const u32x4*)(qrow + 16 * d0); }
    AT_LOAD(tlo);
    const float gql = gq[lane], gkl = gk[lane];
    f32x4 gqv[4][2];
#pragma unroll
    for (int d0 = 0; d0 < 4; ++d0) { gqv[d0][0] = *(const f32x4*)(gq + 16 * d0 + 8 * hi); gqv[d0][1] = *(const f32x4*)(gq + 16 * d0 + 8 * hi + 4); }
    f32x4 rpr[4], rpc[4];
    if (!BIAS) { const int pr = qp >> 6, pc = qp & 63;
#pragma unroll
        for (int j4 = 0; j4 < 4; ++j4) { rpr[j4] = *(const f32x4*)(rope + (pr * 16 + 8 * hi) * 2 + 4 * j4); rpc[j4] = *(const f32x4*)(rope + (pc * 16 + 8 * hi) * 2 + 4 * j4); } }
    float ref;
    { float a = fabsf(gql), c = fabsf(gkl);
#pragma unroll
      for (int o = 1; o < 64; o <<= 1) { a = fmaxf(a, __shfl_xor(a, o)); c = fmaxf(c, __shfl_xor(c, o)); }
      ref = 64.0f * 0.125f * 1.4426950408889634f * 1.02f * a * c + (BIAS ? 1.6f : 0.0f); }
    if (BIAS) {
        LAS float* tbl = (LAS float*)(lds + AT_TBL);
        const float slope = fast_exp2(-(float)(h + 1) * (4.0f / 3.0f));
        for (int e = tid; e < 4096; e += NTHREADS) { const int d = e - 2048, ad = d < 0 ? -d : d;
            const int mult = ad > 256 ? 0 : (ad <= 64 ? 1 : 0) + ((ad & 3) == 0 ? 1 : 0) + ((ad & 15) == 0 ? 1 : 0);
            const float lg = mult == 3 ? 1.5849625007211562f : (mult == 2 ? 1.0f : 0.0f);
            tbl[e] = mult ? (lg - slope * (float)ad * 1.4426950408889634f - ref) : -1e30f; }
    }
    bf16x8 qr[4];
    {
        float v[4][8]; float ss = 0.f;
#pragma unroll
        for (int d0 = 0; d0 < 4; ++d0) { const u32x4 w = qraw[d0];
            v[d0][0] = bflo(w.x); v[d0][1] = bfhi(w.x); v[d0][2] = bflo(w.y); v[d0][3] = bfhi(w.y); v[d0][4] = bflo(w.z); v[d0][5] = bfhi(w.z); v[d0][6] = bflo(w.w); v[d0][7] = bfhi(w.w);
#pragma unroll
            for (int j = 0; j < 8; ++j) ss += v[d0][j] * v[d0][j]; }
        ss += __shfl_xor(ss, 32);
        const float rstd = rsqrtf(ss * (1.f / 64) + EPS);
#pragma unroll
        for (int d0 = 0; d0 < 4; ++d0)
#pragma unroll
            for (int j = 0; j < 8; ++j) v[d0][j] *= rstd * gqv[d0][j >> 2][j & 3];
        if (!BIAS) {
#pragma unroll
            for (int j = 0; j < 8; ++j) {
                { const float c = rpr[j >> 1][2 * (j & 1)], s = rpr[j >> 1][2 * (j & 1) + 1]; const float x1 = v[0][j], x2 = v[1][j]; v[0][j] = x1 * c - x2 * s; v[1][j] = x2 * c + x1 * s; }
                { const float c = rpc[j >> 1][2 * (j & 1)], s = rpc[j >> 1][2 * (j & 1) + 1]; const float x1 = v[2][j], x2 = v[3][j]; v[2][j] = x1 * c - x2 * s; v[3][j] = x2 * c + x1 * s; } }
        }
        const float qsc = 0.125f * 1.4426950408889634f;
#pragma unroll
        for (int d0 = 0; d0 < 4; ++d0) { u32x4 w; w.x = pk2(v[d0][0] * qsc, v[d0][1] * qsc); w.y = pk2(v[d0][2] * qsc, v[d0][3] * qsc); w.z = pk2(v[d0][4] * qsc, v[d0][5] * qsc); w.w = pk2(v[d0][6] * qsc, v[d0][7] * qsc);
            qr[d0] = __builtin_bit_cast(bf16x8, w); }
    }
    AT_STORE(0);
    __syncthreads();
    float lrow = 0.f;
    f32x16 o0, o1, negref;
#pragma unroll
    for (int i = 0; i < 16; ++i) { o0[i] = 0.f; o1[i] = 0.f; negref[i] = -ref; }
    const int krow = pi32(r32);
    for (int step = 0; step < ntile; ++step) {
        const bool ldn = (step + 1 < ntile);
        if (ldn) AT_LOAD(tlo + step + 1);
        {
            const lds_u8* kb = lds + (step & 1) * AT_KV;
            const lds_u8* vb = kb + 9216;
            f32x16 p0, p1;
            if (BIAS) {
                const LAS float* tbl = (const LAS float*)(lds + AT_TBL) + ((tlo + step) * 64 + 8 * hi - qp + 2048);
#pragma unroll
                for (int i = 0; i < 16; ++i) { p0[i] = tbl[(i & 7) + 16 * (i >> 3)]; p1[i] = tbl[(i & 7) + 16 * (i >> 3) + 32]; }
            } else { p0 = negref; p1 = negref; }
#pragma unroll
            for (int d0 = 0; d0 < 4; ++d0) {
                const bf16x8 k0 = *(const LAS bf16x8*)(kb + krow * 144 + 32 * d0 + 16 * hi);
                const bf16x8 k1 = *(const LAS bf16x8*)(kb + (32 + krow) * 144 + 32 * d0 + 16 * hi);
                p0 = __builtin_amdgcn_mfma_f32_32x32x16_bf16(k0, qr[d0], p0, 0, 0, 0);
                p1 = __builtin_amdgcn_mfma_f32_32x32x16_bf16(k1, qr[d0], p1, 0, 0, 0);
            }
            float rs0 = 0.f, rs1 = 0.f;
#pragma unroll
            for (int i = 0; i < 16; ++i) { p0[i] = fast_exp2(p0[i]); p1[i] = fast_exp2(p1[i]); rs0 += p0[i]; rs1 += p1[i]; }
            lrow += rs0 + rs1;
            bf16x8 pb[2][2];
#pragma unroll
            for (int ks = 0; ks < 2; ++ks) {
                u32x4 w; w.x = pk2(p0[8 * ks + 0], p0[8 * ks + 1]); w.y = pk2(p0[8 * ks + 2], p0[8 * ks + 3]); w.z = pk2(p0[8 * ks + 4], p0[8 * ks + 5]); w.w = pk2(p0[8 * ks + 6], p0[8 * ks + 7]);
                pb[0][ks] = __builtin_bit_cast(bf16x8, w);
                u32x4 w1; w1.x = pk2(p1[8 * ks + 0], p1[8 * ks + 1]); w1.y = pk2(p1[8 * ks + 2], p1[8 * ks + 3]); w1.z = pk2(p1[8 * ks + 4], p1[8 * ks + 5]); w1.w = pk2(p1[8 * ks + 6], p1[8 * ks + 7]);
                pb[1][ks] = __builtin_bit_cast(bf16x8, w1);
            }
#pragma unroll
            for (int sub = 0; sub < 2; ++sub)
#pragma unroll
                for (int ks = 0; ks < 2; ++ks) {
                    const bf16x8 v0 = *(const LAS bf16x8*)(vb + r32 * 144 + (32 * sub + 16 * ks + 8 * hi) * 2);
                    const bf16x8 v1 = *(const LAS bf16x8*)(vb + (32 + r32) * 144 + (32 * sub + 16 * ks + 8 * hi) * 2);
                    o0 = __builtin_amdgcn_mfma_f32_32x32x16_bf16(v0, pb[sub][ks], o0, 0, 0, 0);
                    o1 = __builtin_amdgcn_mfma_f32_32x32x16_bf16(v1, pb[sub][ks], o1, 0, 0, 0);
                }
        }
        if (ldn) AT_STORE((step + 1) & 1);
        __syncthreads();
    }
#undef AT_LOAD
#undef AT_STORE
    lrow += __shfl_xor(lrow, 32);
    {
        const size_t grow = (size_t)b * SEQ + qp;
        const bf16_t* fpo = BIAS ? po_far + grow * 384 + h * 64 + 4 * hi : nullptr;
        const float inv = 1.0f / (lrow + (BIAS ? pl[grow * 6 + h] : 0.0f));
        bf16_t* orow = mix + grow * DM + mixcol0 + h * 64 + 4 * hi;
#pragma unroll
        for (int g4 = 0; g4 < 4; ++g4) {
            u32x2 f0 = (u32x2){0u, 0u}, f1 = (u32x2){0u, 0u};
            if (BIAS) { f0 = *(const u32x2*)(fpo + 8 * g4); f1 = *(const u32x2*)(fpo + 32 + 8 * g4); }
            { const float x0 = (o0[4 * g4] + bflo(f0.x)) * inv, x1 = (o0[4 * g4 + 1] + bfhi(f0.x)) * inv, x2 = (o0[4 * g4 + 2] + bflo(f0.y)) * inv, x3 = (o0[4 * g4 + 3] + bfhi(f0.y)) * inv;
              u32x2 w; w.x = pk2(x0, x1); w.y = pk2(x2, x3); *(u32x2*)(orow + 8 * g4) = w; }
            { const float x0 = (o1[4 * g4] + bflo(f1.x)) * inv, x1 = (o1[4 * g4 + 1] + bfhi(f1.x)) * inv, x2 = (o1[4 * g4 + 2] + bflo(f1.y)) * inv, x3 = (o1[4 * g4 + 3] + bfhi(f1.y)) * inv;
              u32x2 w; w.x = pk2(x0, x1); w.y = pk2(x2, x3); *(u32x2*)(orow + 32 + 8 * g4) = w; }
        }
    }
}

__device__ __forceinline__ void attn_r16_unit(lds_u8* lds, const bf16_t* proj, bf16_t* po, float* pl, const float* gq, const float* gk, int b, int kvh, int rho, const int tid) {
    const int lane = tid & 63, wave = __builtin_amdgcn_readfirstlane(tid >> 6);
    const int qs = wave & 3, kh = wave >> 2, r32 = lane & 31, hi = lane >> 5;
    const int iq = 32 * qs + r32;
    const size_t qrow_g = (size_t)b * SEQ + rho + 16 * iq;
    const bf16_t* qrow0 = proj + qrow_g * INW + C_CQ + (kvh * 3) * 64 + 8 * hi;
    u32x4 qcur[4], qnxt[4];
#pragma unroll
    for (int d0 = 0; d0 < 4; ++d0) { qcur[d0] = *(const u32x4*)(qrow0 + 16 * d0); qnxt[d0] = qcur[d0]; }
    u32x4 kst[2], vst[2];
    const int th = tid & 255;
#pragma unroll
    for (int i_ = 0; i_ < 2; ++i_) { const int c_ = th + 256 * i_, row_ = c_ >> 3, c16_ = c_ & 7;
        const bf16_t* src = proj + ((size_t)b * SEQ + rho + 16 * (64 * kh + row_)) * INW + kvh * 64 + c16_ * 8;
        kst[i_] = *(const u32x4*)(src + C_CK); vst[i_] = *(const u32x4*)(src + C_CV); }
    const float gql = gq[lane], gkl = gk[lane];
    float ref;
    { float a = fabsf(gql), c = fabsf(gkl);
#pragma unroll
      for (int o = 1; o < 64; o <<= 1) { a = fmaxf(a, __shfl_xor(a, o)); c = fmaxf(c, __shfl_xor(c, o)); }
      ref = 64.0f * 0.125f * 1.4426950408889634f * 1.02f * a * c + 1.6f; }
    LAS float* tb = (LAS float*)(lds + 40960);
    for (int e = tid; e < 768; e += NTHREADS) { const int hq = e >> 8, d = (e & 255) - 128, ad = d < 0 ? -d : d; const float slope = fast_exp2(-(float)(kvh * 3 + hq + 1) * (4.0f / 3.0f));
        tb[e] = (ad > 16 && ad <= 64) ? (-slope * 16.0f * (float)ad * 1.4426950408889634f - ref) : -1e30f; }
    lds_u8* hb = lds + kh * AT_KV;
#pragma unroll
    for (int i_ = 0; i_ < 2; ++i_) { const int c_ = th + 256 * i_, row_ = c_ >> 3, c16_ = c_ & 7;
        *(LAS u32x4*)(hb + row_ * 144 + c16_ * 16) = kst[i_]; *(LAS u32x4*)(hb + 9216 + row_ * 144 + c16_ * 16) = vst[i_]; }
    __syncthreads();
    const int krow = pi32(r32);
    bf16x8 kf[8], vf[8];
#pragma unroll
    for (int d0 = 0; d0 < 4; ++d0) { kf[2 * d0] = *(const LAS bf16x8*)(hb + krow * 144 + 32 * d0 + 16 * hi); kf[2 * d0 + 1] = *(const LAS bf16x8*)(hb + (32 + krow) * 144 + 32 * d0 + 16 * hi); }
    { const LAS bf16_t* vbase = (const LAS bf16_t*)(hb + 9216);
#pragma unroll
      for (int sub = 0; sub < 2; ++sub)
#pragma unroll
        for (int ks = 0; ks < 2; ++ks)
#pragma unroll
            for (int j = 0; j < 8; ++j) { const int key = 32 * sub + 16 * ks + 8 * hi + j;
                vf[(sub * 2 + ks) * 2][j] = (short)vbase[key * 72 + r32]; vf[(sub * 2 + ks) * 2 + 1][j] = (short)vbase[key * 72 + 32 + r32]; } }
    __syncthreads();
    LAS float* cs = (LAS float*)(lds) + (qs * 64 + lane) * 35;
#pragma unroll 1
    for (int hq = 0; hq < 3; ++hq) {
        const int h = kvh * 3 + hq;
        if (hq < 2) {
#pragma unroll
            for (int d0 = 0; d0 < 4; ++d0) qnxt[d0] = *(const u32x4*)(qrow0 + (hq + 1) * 64 + 16 * d0); }
        bf16x8 qr[4];
        {
            f32x4 gqv[4][2];
#pragma unroll
            for (int d0 = 0; d0 < 4; ++d0) { gqv[d0][0] = *(const f32x4*)(gq + 16 * d0 + 8 * hi); gqv[d0][1] = *(const f32x4*)(gq + 16 * d0 + 8 * hi + 4); }
            float v[4][8]; float ss = 0.f;
#pragma unroll
            for (int d0 = 0; d0 < 4; ++d0) { const u32x4 w = qcur[d0];
                v[d0][0] = bflo(w.x); v[d0][1] = bfhi(w.x); v[d0][2] = bflo(w.y); v[d0][3] = bfhi(w.y); v[d0][4] = bflo(w.z); v[d0][5] = bfhi(w.z); v[d0][6] = bflo(w.w); v[d0][7] = bfhi(w.w);
#pragma unroll
                for (int j = 0; j < 8; ++j) ss += v[d0][j] * v[d0][j]; }
            ss += __shfl_xor(ss, 32);
            const float rstd = rsqrtf(ss * (1.f / 64) + EPS) * (0.125f * 1.4426950408889634f);
#pragma unroll
            for (int d0 = 0; d0 < 4; ++d0) { float y[8];
#pragma unroll
                for (int j = 0; j < 8; ++j) y[j] = v[d0][j] * rstd * gqv[d0][j >> 2][j & 3];
                u32x4 w; w.x = pk2(y[0], y[1]); w.y = pk2(y[2], y[3]); w.z = pk2(y[4], y[5]); w.w = pk2(y[6], y[7]); qr[d0] = __builtin_bit_cast(bf16x8, w); }
        }
        f32x16 p0, p1;
        { const LAS float* tbl = tb + hq * 256 + (64 * kh + 8 * hi - iq + 128);
#pragma unroll
          for (int i = 0; i < 16; ++i) { p0[i] = tbl[(i & 7) + 16 * (i >> 3)]; p1[i] = tbl[(i & 7) + 16 * (i >> 3) + 32]; } }
#pragma unroll
        for (int d0 = 0; d0 < 4; ++d0) {
            p0 = __builtin_amdgcn_mfma_f32_32x32x16_bf16(kf[2 * d0], qr[d0], p0, 0, 0, 0);
            p1 = __builtin_amdgcn_mfma_f32_32x32x16_bf16(kf[2 * d0 + 1], qr[d0], p1, 0, 0, 0);
        }
        float lrow = 0.f;
#pragma unroll
        for (int i = 0; i < 16; ++i) { p0[i] = fast_exp2(p0[i]); p1[i] = fast_exp2(p1[i]); lrow += p0[i] + p1[i]; }
        bf16x8 pb[2][2];
#pragma unroll
        for (int ks = 0; ks < 2; ++ks) {
            u32x4 w; w.x = pk2(p0[8 * ks + 0], p0[8 * ks + 1]); w.y = pk2(p0[8 * ks + 2], p0[8 * ks + 3]); w.z = pk2(p0[8 * ks + 4], p0[8 * ks + 5]); w.w = pk2(p0[8 * ks + 6], p0[8 * ks + 7]);
            pb[0][ks] = __builtin_bit_cast(bf16x8, w);
            u32x4 w1; w1.x = pk2(p1[8 * ks + 0], p1[8 * ks + 1]); w1.y = pk2(p1[8 * ks + 2], p1[8 * ks + 3]); w1.z = pk2(p1[8 * ks + 4], p1[8 * ks + 5]); w1.w = pk2(p1[8 * ks + 6], p1[8 * ks + 7]);
            pb[1][ks] = __builtin_bit_cast(bf16x8, w1);
        }
        f32x16 o0, o1;
#pragma unroll
        for (int i = 0; i < 16; ++i) { o0[i] = 0.f; o1[i] = 0.f; }
#pragma unroll
        for (int sub = 0; sub < 2; ++sub)
#pragma unroll
            for (int ks = 0; ks < 2; ++ks) {
                o0 = __builtin_amdgcn_mfma_f32_32x32x16_bf16(vf[(sub * 2 + ks) * 2], pb[sub][ks], o0, 0, 0, 0);
                o1 = __builtin_amdgcn_mfma_f32_32x32x16_bf16(vf[(sub * 2 + ks) * 2 + 1], pb[sub][ks], o1, 0, 0, 0);
            }
        lrow += __shfl_xor(lrow, 32);
        if (kh == 1) { cs[1] = lrow;
#pragma unroll
            for (int i = 0; i < 16; ++i) { cs[2 + i] = o0[i]; cs[18 + i] = o1[i]; } }
        __syncthreads();
        if (kh == 0) {
            bf16_t* orow = po + qrow_g * 384 + h * 64 + 4 * hi;
            if (hi == 0) pl[qrow_g * 6 + h] = lrow + cs[1];
#pragma unroll
            for (int g4 = 0; g4 < 4; ++g4) {
                { u32x2 w; w.x = pk2(o0[4 * g4] + cs[2 + 4 * g4], o0[4 * g4 + 1] + cs[3 + 4 * g4]); w.y = pk2(o0[4 * g4 + 2] + cs[4 + 4 * g4], o0[4 * g4 + 3] + cs[5 + 4 * g4]); *(u32x2*)(orow + 8 * g4) = w; }
                { u32x2 w; w.x = pk2(o1[4 * g4] + cs[18 + 4 * g4], o1[4 * g4 + 1] + cs[19 + 4 * g4]); w.y = pk2(o1[4 * g4 + 2] + cs[20 + 4 * g4], o1[4 * g4 + 3] + cs[21 + 4 * g4]); *(u32x2*)(orow + 32 + 8 * g4) = w; }
            }
        }
        __syncthreads();
#pragma unroll
        for (int d0 = 0; d0 < 4; ++d0) qcur[d0] = qnxt[d0];
    }
}

__device__ __forceinline__ void phase_scan(const Args& a, int vcu, int G, const int tid) {
    const float* HL = (const float*)(a.ws + WS_HL); const float* HDp = (const float*)(a.ws + WS_HD); bf16_t* HS = (bf16_t*)(a.ws + WS_HS);
    for (int e = vcu * NTHREADS + tid; e < 64 * 4096; e += G * NTHREADS) {
        const int seq = e >> 12, idx = e & 4095, k = idx & 63, dir = seq & 1;
        float st = 0.f;
        float hd[32], hl[32];
#pragma unroll
        for (int j = 0; j < 32; ++j) { const int c = dir ? 31 - j : j; const size_t o = (size_t)seq * 32 + c; hd[j] = HDp[o * 64 + k]; hl[j] = HL[o * 4096 + idx]; }
#pragma unroll
        for (int j = 0; j < 32; ++j) { const int c = dir ? 31 - j : j; const size_t o = (size_t)seq * 32 + c; HS[o * 4096 + idx] = (bf16_t)f2bf(st); st = hd[j] * st + hl[j]; }
    }
}

constexpr int HG_OACC = 0, HG_QS = 65536, HG_QD = HG_QS + 9216, HG_KD = HG_QD + 9216, HG_KE = HG_KD + 9216, HG_Q2 = HG_KE + 9216, HG_K2 = HG_Q2 + 4608,
              HG_VT = HG_K2 + 4608, HG_AT = HG_VT + 9216, HG_ST = HG_AT + 9216, HG_GT = HG_ST + 9216, HG_END = HG_GT + 2048;
static_assert(HG_END <= LDS_BYTES, "HGRN LDS map");

__device__ __forceinline__ void hgrn_out_item(const Args& a, lds_u8* lds, int l, int item, const int tid) {
    const int lane = tid & 63, wave = __builtin_amdgcn_readfirstlane(tid >> 6);
    const int k = lane, rg = wave;
    const int b = item >> 5, hh = (item >> 3) & 3, grp = item & 7;
    const int c0 = grp * 4;
    unsigned char* ws = a.ws;
    const bf16_t* proj = (const bf16_t*)(ws + WS_PROJ);
    const float* HL = (const float*)(ws + WS_HL); const float* HDp = (const float*)(ws + WS_HD);
    LAS float* oacc = (LAS float*)(lds + HG_OACC);
    LAS bf16_t* Qs = (LAS bf16_t*)(lds + HG_QS); LAS bf16_t* Qd = (LAS bf16_t*)(lds + HG_QD); LAS bf16_t* Kd = (LAS bf16_t*)(lds + HG_KD); LAS bf16_t* Ke = (LAS bf16_t*)(lds + HG_KE);
    LAS bf16_t* Q2 = (LAS bf16_t*)(lds + HG_Q2); LAS bf16_t* K2 = (LAS bf16_t*)(lds + HG_K2); LAS bf16_t* VT = (LAS bf16_t*)(lds + HG_VT); LAS bf16_t* AT = (LAS bf16_t*)(lds + HG_AT);
    LAS bf16_t* ST = (LAS bf16_t*)(lds + HG_ST); LAS float* gt = (LAS float*)(lds + HG_GT);
    const int r16 = lane & 15, q4 = lane >> 4;
    const float lbv0 = hgrn_lb(a.in[I_BLB], 0, l, hh * 64 + k), lbv1 = hgrn_lb(a.in[I_BLB], 1, l, hh * 64 + k);
    unsigned short rq[8], rf[8], rv[8];
#define HG_LOADRAW(dir_, c_) do { const size_t rb_ = (size_t)b * SEQ + (c_) * 64; _Pragma("unroll") for (int i = 0; i < 8; ++i) { const int s_ = 8 * rg + i; const int tk_ = (dir_) ? (63 - s_) : s_; \
        const bf16_t* rp_ = proj + (rb_ + tk_) * INW; rq[i] = rp_[C_BQ + hh * 64 + k]; rf[i] = rp_[((dir_) ? C_BFB : C_BFF) + hh * 64 + k]; rv[i] = rp_[C_BI + hh * 64 + k]; } } while (0)
    HG_LOADRAW(0, c0);
    float st[8];
#pragma unroll
    for (int i = 0; i < 8; ++i) st[i] = 0.f;
    for (int stp = 0; stp < 8; ++stp) {
        {
            const int dir = stp >> 2, ci = stp & 3;
            const float lb = dir ? lbv1 : lbv0;
            const size_t sbase = (((size_t)b * 4 + hh) * 2 + dir) * 32;
            const int c = dir ? (c0 + 3 - ci) : (c0 + ci);
            if (ci == 0) { const bf16_t* HSp = (const bf16_t*)(ws + WS_HS) + (sbase + c) * 4096 + (8 * wave) * 64 + k;
#pragma unroll
                for (int i = 0; i < 8; ++i) st[i] = bf2f(HSp[i * 64]); }
            float qv[8], lf[8], kk[8];
            u32x4 vpk;
#pragma unroll
            for (int i = 0; i < 8; ++i) { qv[i] = bf2f(rq[i]); hgrn_fk(bf2f(rf[i]), lb, lf[i], kk[i]); }
            vpk.x = rv[0] | ((unsigned)rv[1] << 16); vpk.y = rv[2] | ((unsigned)rv[3] << 16); vpk.z = rv[4] | ((unsigned)rv[5] << 16); vpk.w = rv[6] | ((unsigned)rv[7] << 16);
            const float dk = HDp[(sbase + c) * 64 + k];
            float Ln[8];
            { const float* Lp = HL + (sbase + c) * 4096 + (8 * wave) * 64 + k;
#pragma unroll
              for (int i = 0; i < 8; ++i) Ln[i] = Lp[i * 64]; }
            if (stp < 7) { const int nd = (stp + 1) >> 2, nci = (stp + 1) & 3; const int nc = nd ? (c0 + 3 - nci) : (c0 + nci); HG_LOADRAW(nd, nc); }
#pragma unroll
            for (int i = 1; i < 8; ++i) lf[i] += lf[i - 1];
            gt[rg * 64 + k] = lf[7];
#pragma unroll
            for (int i = 0; i < 8; ++i) ST[(8 * wave + i) * 72 + k] = (bf16_t)f2bf(st[i]);
            __syncthreads();
            float gsum[9]; gsum[0] = 0.f;
#pragma unroll
            for (int g = 0; g < 8; ++g) gsum[g + 1] = gsum[g] + gt[g * 64 + k];
            float off = 0.f, bS = 0.f, bE = 0.f;
#pragma unroll
            for (int g = 0; g < 8; ++g) { if (g == rg) off = gsum[g]; if (g == (rg & ~1)) { bS = gsum[g]; bE = gsum[g + 2]; } }
            const float b31 = gsum[4];
            const float eS = fast_exp2(bS), e2 = fast_exp2(rg >= 4 ? bS - b31 : b31 - bE);
#pragma unroll
            for (int i = 0; i < 8; ++i) {
                const int s = 8 * rg + i; const float bb = off + lf[i];
                const float qd = qv[i] * fast_exp2(bb - bS), ke = kk[i] * fast_exp2(bE - bb);
                Qd[s * 72 + k] = (bf16_t)f2bf(qd);
                Qs[s * 72 + k] = (bf16_t)f2bf(qd * eS);
                Kd[s * 72 + k] = (bf16_t)f2bf(kk[i] * fast_exp2(fminf(bS - bb, 115.f)));
                Ke[s * 72 + k] = (bf16_t)f2bf(ke);
                { const bool hi2 = rg >= 4; LAS bf16_t* T2 = hi2 ? Q2 + (s - 32) * 72 + k : K2 + s * 72 + k;
                  *T2 = (bf16_t)f2bf((hi2 ? qd : ke) * e2); }
            }
            *(LAS u32x4*)(VT + k * 72 + 8 * rg) = vpk;
            __syncthreads();
            {
                const int I = wave >> 1;
#pragma unroll
                for (int jj = 0; jj < 2; ++jj) {
                    const int J = 2 * (wave & 1) + jj;
                    f32x4 acc = (f32x4){0.f, 0.f, 0.f, 0.f};
                    if (J <= I) {
                        const LAS bf16_t* Ap; const LAS bf16_t* Bp;
                        if (J == I) { Ap = Qd + (16 * I + r16) * 72; Bp = Kd + (16 * J + r16) * 72; }
                        else if ((I >> 1) == (J >> 1)) { Ap = Qd + (16 * I + r16) * 72; Bp = Ke + (16 * J + r16) * 72; }
                        else { Ap = Q2 + (16 * (I - 2) + r16) * 72; Bp = K2 + (16 * J + r16) * 72; }
#pragma unroll
                        for (int ks = 0; ks < 2; ++ks) { const bf16x8 af = *(const LAS bf16x8*)(Ap + 32 * ks + 8 * q4); const bf16x8 bfr = *(const LAS bf16x8*)(Bp + 32 * ks + 8 * q4);
                            acc = __builtin_amdgcn_mfma_f32_16x16x32_bf16(af, bfr, acc, 0, 0, 0); }
                        if (J == I) {
#pragma unroll
                            for (int j = 0; j < 4; ++j) if (r16 > 4 * q4 + j) acc[j] = 0.f;
                        }
                    }
#pragma unroll
                    for (int j = 0; j < 4; ++j) AT[(16 * I + 4 * q4 + j) * 72 + 16 * J + r16] = (bf16_t)f2bf(acc[j]);
                }
            }
            __syncthreads();
            {
                const int mi = wave >> 1;
#pragma unroll
                for (int jj = 0; jj < 2; ++jj) {
                    const int ni = 2 * (wave & 1) + jj;
                    f32x4 acc = (f32x4){0.f, 0.f, 0.f, 0.f};
#pragma unroll
                    for (int ks = 0; ks < 2; ++ks) { const bf16x8 af = *(const LAS bf16x8*)(Qs + (16 * mi + r16) * 72 + 32 * ks + 8 * q4); const bf16x8 bfr = *(const LAS bf16x8*)(ST + (16 * ni + r16) * 72 + 32 * ks + 8 * q4);
                        acc = __builtin_amdgcn_mfma_f32_16x16x32_bf16(af, bfr, acc, 0, 0, 0); }
#pragma unroll
                    for (int ks = 0; ks < 2; ++ks) { const bf16x8 af = *(const LAS bf16x8*)(AT + (16 * mi + r16) * 72 + 32 * ks + 8 * q4); const bf16x8 bfr = *(const LAS bf16x8*)(VT + (16 * ni + r16) * 72 + 32 * ks + 8 * q4);
                        acc = __builtin_amdgcn_mfma_f32_16x16x32_bf16(af, bfr, acc, 0, 0, 0); }
#pragma unroll
                    for (int j = 0; j < 4; ++j) { const int t = 16 * mi + 4 * q4 + j; const int tl = (c - c0) * 64 + (dir ? (63 - t) : t);
                        LAS float* op = oacc + tl * 64 + 16 * ni + r16;
                        if (dir == 0) *op = acc[j]; else *op += acc[j]; }
                }
            }
#pragma unroll
            for (int i = 0; i < 8; ++i) st[i] = dk * st[i] + Ln[i];
            __syncthreads();
        }
    }
#undef HG_LOADRAW

    {
        const float gn = a.in[I_BON][l * 64 + lane];
        bf16_t* mix = (bf16_t*)(ws + WS_MIX);
        for (int rb = 0; rb < 32; rb += 8) {
            unsigned short gv[8];
#pragma unroll
            for (int r = 0; r < 8; ++r) gv[r] = proj[((size_t)b * SEQ + c0 * 64 + 32 * wave + rb + r) * INW + C_BG + hh * 64 + lane];
#pragma unroll
            for (int r = 0; r < 8; ++r) {
                const int tl = 32 * wave + rb + r;
                const size_t row = (size_t)b * SEQ + c0 * 64 + tl;
                const float o = oacc[tl * 64 + lane];
                const float ss = wave_sum(o * o);
                mix[row * DM + 384 + hh * 64 + lane] = (bf16_t)f2bf(o * rsqrtf(ss * (1.f / 64) + EPS) * gn * silu_f(bf2f(gv[r])));
            }
        }
    }
    __syncthreads();
}

__device__ __forceinline__ void phase_mixers(const Args& a, lds_u8* lds, int l, int vcu, int G, const int tid) {
    unsigned char* ws = a.ws;
    const bf16_t* proj = (const bf16_t*)(ws + WS_PROJ); const bf16_t* vt = (const bf16_t*)(ws + WS_VT); bf16_t* mix = (bf16_t*)(ws + WS_MIX);
    const float* rope = (const float*)(ws + WS_ROPE);
    for (int rp = 0; rp < ((PROBE_DUP & 256) ? 2 : 1); ++rp)
    for (int it = vcu; it < NB * 4 * 8; it += G) hgrn_out_item(a, lds, l, it, tid);
    const bf16_t* po_far = (const bf16_t*)(ws + WS_PO); const float* pl_far = (const float*)(ws + WS_PL);
    for (int u = vcu; u < 768; u += G) {
        const int mixer = u / 384, r = u % 384, b = r / 48, rr = r % 48, kvh = rr / 24, r3 = rr % 24, hq = r3 / 8, qblk = r3 % 8;
        const int h = kvh * 3 + hq;
        if (mixer == 0) attn_unit<false>(lds, proj, vt, mix, nullptr, nullptr, a.in[I_AQN] + l * 64, a.in[I_AKN] + l * 64, rope, b, h, qblk, C_AQ, C_AK, 0, 0, tid);
        else attn_unit<true>(lds, proj, vt, mix, po_far, pl_far, a.in[I_CQN] + l * 64, a.in[I_CKN] + l * 64, rope, b, h, qblk, C_CQ, C_CK, 2, 640, tid);
    }
}

__device__ __forceinline__ void phase_mixc(const Args& a, lds_u8* lds, int l, int vcu, int G, const int tid) {
    unsigned char* ws = a.ws;
    const bf16_t* proj = (const bf16_t*)(ws + WS_PROJ);
    bf16_t* po = (bf16_t*)(ws + WS_PO); float* pl = (float*)(ws + WS_PL);
    for (int u = vcu; u < 256; u += G) {
        const int b = u >> 5, kvh = (u >> 4) & 1, rho = u & 15;
        attn_r16_unit(lds, proj, po, pl, a.in[I_CQN] + l * 64, a.in[I_CKN] + l * 64, b, kvh, rho, tid);
    }
}

#define XB_TMO      128
#define XB_XCNT(j)  (256  + 64 * (j))
#define XB_XSUB(j)  (1280 + 64 * (j))
#define XB_XGEN(j)  (2304 + 64 * (j))
#define XB_TOP      3328
#define XB_TOPGEN   3392
#define XCD_BAR_WORDS 3456
#define XB_SPIN_CAP (1u << 18)
__device__ __forceinline__ unsigned xb_ld(unsigned* p)              { return __hip_atomic_load(p, __ATOMIC_RELAXED, __HIP_MEMORY_SCOPE_AGENT); }
__device__ __forceinline__ unsigned xb_add(unsigned* p, unsigned v) { return __hip_atomic_fetch_add(p, v, __ATOMIC_RELAXED, __HIP_MEMORY_SCOPE_AGENT); }
__device__ __forceinline__ unsigned xb_xcc_id() { return (unsigned)__builtin_amdgcn_s_getreg((3 << 11) | 20) & 0xFu; }
#define XB_SPIN(cond, bar) do { unsigned _sp = 0; while (cond) { __builtin_amdgcn_s_sleep(1); \
    if ((++_sp & 255u) == 0u) { if (xb_ld(&(bar)[XB_TMO])) break; if (_sp > XB_SPIN_CAP) { atomicAdd(&(bar)[XB_TMO], 1u); break; } } } } while (0)
struct XcdBarrier { unsigned* bar; unsigned x; volatile LAS unsigned* st; int wave; };
__device__ __forceinline__ int lane_id() { return (int)__builtin_amdgcn_mbcnt_hi(~0u, __builtin_amdgcn_mbcnt_lo(~0u, 0u)); }
__device__ __forceinline__ XcdBarrier xcd_barrier_post(unsigned* bar, volatile LAS unsigned* st, int wave) {
    XcdBarrier b; b.bar = bar; b.x = xb_xcc_id(); b.st = st; b.wave = wave;
    if (wave == 0 && lane_id() == 0) (void)xb_add(&bar[XB_XCNT(b.x)], 1u);
    return b;
}
__device__ __forceinline__ void xcd_barrier_complete(unsigned* bar, unsigned x, unsigned& nloc, unsigned& nx) {
    const unsigned G = gridDim.x * gridDim.y * gridDim.z;
    unsigned sum, cnt, mine, sp = 0u;
    for (;;) {
        sum = 0u; cnt = 0u; mine = 0u;
#pragma unroll
        for (unsigned j = 0; j < 16; ++j) { const unsigned c = xb_ld(&bar[XB_XCNT(j)]); sum += c; cnt += (c > 0u) ? 1u : 0u; mine = (j == x) ? c : mine; }
        if (sum == G) break;
        __builtin_amdgcn_s_sleep(1);
        if ((++sp & 255u) == 0u) { if (xb_ld(&bar[XB_TMO])) break; if (sp > XB_SPIN_CAP) { atomicAdd(&bar[XB_TMO], 1u); break; } }
    }
    nloc = mine > 0u ? mine : 1u; nx = cnt > 0u ? cnt : 1u;
}
__device__ __forceinline__ void xcd_barrier(const XcdBarrier& b) {
    asm volatile("s_waitcnt vmcnt(0)" ::: "memory");
    __syncthreads();
    if (b.wave == 0 && lane_id() == 0) {
        unsigned* bar = b.bar;
        __builtin_amdgcn_s_waitcnt(0);
        unsigned nloc = b.st[0], nx = b.st[1];
        if (nloc == 0u) { xcd_barrier_complete(bar, b.x, nloc, nx); b.st[0] = nloc; b.st[1] = nx; }
        const unsigned old = xb_add(&bar[XB_XSUB(b.x)], 1u);
        const unsigned gen = old / nloc;
        if (old + 1u == (gen + 1u) * nloc) {
            __builtin_amdgcn_fence(__ATOMIC_RELEASE, "agent");
            asm volatile("s_waitcnt vmcnt(0)" ::: "memory");
            const unsigned og = xb_add(&bar[XB_TOP], 1u);
            const unsigned tg = og / nx;
            if (og + 1u == (tg + 1u) * nx) xb_add(&bar[XB_TOPGEN], 1u);
            else XB_SPIN(xb_ld(&bar[XB_TOPGEN]) == tg, bar);
            __builtin_amdgcn_fence(__ATOMIC_ACQUIRE, "agent");
            xb_add(&bar[XB_XGEN(b.x)], 1u);
            asm volatile("s_waitcnt vmcnt(0)" ::: "memory");
        } else {
            XB_SPIN(xb_ld(&bar[XB_XGEN(b.x)]) == gen, bar);
            __builtin_amdgcn_fence(__ATOMIC_ACQUIRE, "agent");
            asm volatile("s_waitcnt vmcnt(0)" ::: "memory");
        }
    }
    __syncthreads();
}
__device__ __forceinline__ void panel_norm(unsigned* cnt, const bf16_t* x, const float* g, const float* mod_l, int which_sh, bf16_t* h, int pm, int pn, const int tid) {
    asm volatile("s_waitcnt vmcnt(0)" ::: "memory");
    __syncthreads();
    if (tid == 0) {
        __builtin_amdgcn_fence(__ATOMIC_RELEASE, "agent");
        asm volatile("s_waitcnt vmcnt(0)" ::: "memory");
        (void)xb_add(cnt, 1u);
        unsigned sp = 0u;
        while (xb_ld(cnt) < 4u) { __builtin_amdgcn_s_sleep(1); if (++sp > (1u << 22)) break; }
        __builtin_amdgcn_fence(__ATOMIC_ACQUIRE, "agent");
        asm volatile("s_waitcnt vmcnt(0)" ::: "memory");
    }
    __syncthreads();
    const int lane = tid & 63, wave = tid >> 6;
    for (int r = 0; r < 8; r += 4) norm_rows4_bf(x, g, mod_l, which_sh, h, pm * 256 + pn * 64 + wave * 8 + r, lane);
}
constexpr int MISC_OFF = LDS_BYTES - 64;

constexpr int NPHASES = 2 + 9 * DEPTH - 1;

typedef const Args __attribute__((address_space(4))) KArgs;
template <int KMASK> __global__ void __launch_bounds__(NTHREADS, 2) fwd_kernel_t(Args a0) {
    extern __shared__ __attribute__((aligned(16))) unsigned char lds_raw[];
    lds_u8* lds = (lds_u8*)lds_raw;
    const int G = gridDim.x;
    unsigned char* ws = a0.ws;
    const int ph_lo = a0.ph_lo, ph_hi = a0.ph_hi;
    const float* mod = (const float*)(ws + WS_MOD);
    const int wave_s = __builtin_amdgcn_readfirstlane((int)(threadIdx.x >> 6));
    if (wave_s == 0 && lane_id() < 16) ((LAS unsigned*)(lds + MISC_OFF))[lane_id()] = 0u;
    __syncthreads();
    XcdBarrier bar = xcd_barrier_post((unsigned*)(ws + WS_CTL) + 4096, (volatile LAS unsigned*)(lds + MISC_OFF), wave_s);
    const bool fuse_norm = MK_ONE_LAUNCH && !PROBE_DUP && (G == 256);
    for (int ph = ph_lo; ph < ph_hi; ++ph) {
        KArgs* kap = (KArgs*)__builtin_amdgcn_kernarg_segment_ptr(); asm volatile("" : "+s"(kap));
        Args a;
#pragma unroll
        for (int i_ = 0; i_ < 17; ++i_) a.in[i_] = kap->in[i_];
        a.out = kap->out; a.ws = kap->ws; a.ph_lo = ph_lo; a.ph_hi = ph_hi;
        if (fuse_norm && ph >= 2 && ((ph - 2) % 9 == 5 || (ph - 2) % 9 == 8)) continue;
        int kbit = 0;
        if (PROBE_DUP) { if (ph == 0) kbit = 1; else if (ph == 1) kbit = 2; else { const int s_ = (ph - 2) % 9; kbit = s_ == 0 ? 4 : (s_ == 4 || s_ == 7) ? 8 : s_ == 1 ? 16 : s_ == 3 ? 32 : s_ == 6 ? 64 : s_ == 2 ? 128 : 2; } }
        const int nrep = (PROBE_DUP & kbit) ? 2 : 1;
        for (int rep = 0; rep < nrep; ++rep) {
        const bool dry = (rep + 1 < nrep); if (rep) __syncthreads();
        int tid = threadIdx.x; asm volatile("" : "+v"(tid));
        int bx = blockIdx.x; asm volatile("" : "+s"(bx));
        const int vcu = (G % 8 == 0) ? (bx % 8) * (G / 8) + bx / 8 : bx;
        if (ph == 0) { if (KMASK & 1) phase_prologue(a, lds, vcu, G, tid, bx); }
        else if (ph == 1) { if (KMASK & 2) phase_norm(a.in[I_X], a.in[I_NORMG], mod, 0, (bf16_t*)(ws + WS_H), vcu, G, tid); }
        else {
            const int l = (ph - 2) / 9, s = (ph - 2) % 9;
            const float* mod_l = mod + (size_t)l * 8 * 6144;
            if ((KMASK & 4) && s == 0) {
                const pg8::Gemm g{(const bf16_t*)(ws + WS_H), (const bf16_t*)(ws + WS_WIN) + (size_t)l * INW * DM, M, INW, DM}; const pg8::EpiStore E{(bf16_t*)(ws + WS_PROJ), INW};
                pg8::StaticOrder S; S.init(g.M, g.N, G, bx);
                pg8::gemm_phase<pg8::EpiStore, pg8::StaticOrder>(lds, g, S, E, tid);
            } else if ((KMASK & 64) && s == 6) {
                const pg8::Gemm g{(const bf16_t*)(ws + WS_H), (const bf16_t*)(ws + WS_WUP) + (size_t)l * UPW * DM, M, UPW, DM};
                const pg8::EpiConvGate E{(bf16_t*)(ws + WS_ACT), a.in[I_CONVW] + (size_t)l * 3 * UPW, a.in[I_CONVB] + (size_t)l * UPW};
                pg8::StaticOrder S; S.init(g.M, g.N, G, bx, 1);
                pg8::gemm_phase<pg8::EpiConvGate, pg8::StaticOrder>(lds, g, S, E, tid);
            } else if ((KMASK & 8) && (s == 4 || s == 7)) {
                pg8::Gemm g; pg8::EpiResid E;
                const bool nfuse = fuse_norm && !dry && !(s == 7 && l == DEPTH - 1);
                if (s == 4) { g = pg8::Gemm{(const bf16_t*)(ws + WS_MIX), (const bf16_t*)(ws + WS_WOUT) + (size_t)l * DM * DM, M, DM, DM};
                    E = pg8::EpiResid{ws, l == 0 ? a.in[I_X] : nullptr, nullptr, a.in[I_NORMG], l, 0, nfuse ? 1 : 0}; }
                else { g = pg8::Gemm{(const bf16_t*)(ws + WS_ACT), (const bf16_t*)(ws + WS_WDN) + (size_t)l * DM * FF, M, DM, FF};
                    E = pg8::EpiResid{ws, nullptr, (l == DEPTH - 1) ? a.out : nullptr, a.in[I_NORMG], l, 1, nfuse ? 1 : 0}; }
                pg8::StaticOrder S; S.init(g.M, g.N, G, bx);
                pg8::gemm_phase<pg8::EpiResid, pg8::StaticOrder>(lds, g, S, E, tid);
            } else if ((KMASK & 16) && s == 1) phase_prep(a, lds, l, vcu, G, tid, dry);
            else if ((KMASK & 16) && s == 2) { phase_scan(a, vcu, G, tid); phase_mixc(a, lds, l, vcu, G, tid); }
            else if ((KMASK & 32) && s == 3) phase_mixers(a, lds, l, vcu, G, tid);
            else if ((KMASK & 2) && s == 5) phase_norm_bf((const bf16_t*)(ws + WS_XB), a.in[I_NORMG] + (size_t)(l * 2 + 1) * DM, mod_l, 3, (bf16_t*)(ws + WS_H), vcu, G, tid);
            else if ((KMASK & 2) && s == 8) phase_norm_bf((const bf16_t*)(ws + WS_XB), a.in[I_NORMG] + (size_t)((l + 1) * 2) * DM, mod_l + 8 * 6144, 0, (bf16_t*)(ws + WS_H), vcu, G, tid);
        }
        }
        if (ph + 1 < ph_hi) { if (ph == 0) { __syncthreads(); cg::this_grid().sync(); } else xcd_barrier(bar); }
    }
}

typedef void (*kern_t)(Args);
static int phase_kind(int ph) { if (ph == 0) return 0; if (ph == 1) return 1; const int s = (ph - 2) % 9; return s == 0 ? 2 : s == 4 || s == 7 ? 3 : s == 1 || s == 2 ? 4 : s == 3 ? 5 : s == 6 ? 6 : 1; }
extern "C" void kernel_launch(void* const* d_in, const int* in_sizes, int n_in, void* d_out, int out_size, void* d_ws, size_t ws_size, hipStream_t stream) {
    static int grid = 0;
#if MK_ONE_LAUNCH
    static const kern_t kerns[1] = {fwd_kernel_t<127>}; constexpr int NK = 1;
#else
    static const kern_t kerns[7] = {fwd_kernel_t<1>, fwd_kernel_t<2>, fwd_kernel_t<4>, fwd_kernel_t<8>, fwd_kernel_t<16>, fwd_kernel_t<32>, fwd_kernel_t<64>}; constexpr int NK = 7;
#endif
    if (grid == 0) {
        if (n_in != 17 || out_size != M * DM || ws_size < WS_END) { fprintf(stderr, "kernel_launch: unexpected shapes (n_in %d, out %d, ws %zu)\n", n_in, out_size, ws_size); grid = -1; return; }
        int dev = 0, cus = 0;
        if (hipGetDevice(&dev) != hipSuccess || hipDeviceGetAttribute(&cus, hipDeviceAttributeMultiprocessorCount, dev) != hipSuccess) { grid = -1; return; }
        for (int i = 0; i < NK; ++i)
            if (hipFuncSetAttribute((const void*)kerns[i], hipFuncAttributeMaxDynamicSharedMemorySize, LDS_BYTES) != hipSuccess) { fprintf(stderr, "kernel_launch: hipFuncSetAttribute failed\n"); grid = -1; return; }
        int per_cu = 0;
        if (hipOccupancyMaxActiveBlocksPerMultiprocessor(&per_cu, (const void*)kerns[0], NTHREADS, LDS_BYTES) != hipSuccess || per_cu < 1) { fprintf(stderr, "kernel_launch: occupancy query says %d\n", per_cu); (void)hipGetLastError(); }
        grid = cus;
    }
    if (grid < 0) return;
    Args a{};
    for (int i = 0; i < 17; ++i) a.in[i] = (const float*)d_in[i];
    a.out = (float*)d_out; a.ws = (unsigned char*)d_ws;
#if MK_ONE_LAUNCH
    if (hipMemsetAsync((char*)d_ws + WS_CTL, 0, 65536, stream) != hipSuccess) { fprintf(stderr, "kernel_launch: memset failed\n"); return; }
    a.ph_lo = 0; a.ph_hi = NPHASES;
    void* args[] = {&a};
    hipError_t e = hipLaunchCooperativeKernel((const void*)kerns[0], dim3(grid), dim3(NTHREADS), args, LDS_BYTES, stream);
    if (e != hipSuccess) fprintf(stderr, "cooperative launch failed: %s (grid %d)\n", hipGetErrorString(e), grid);
#else
    for (int ph = 0; ph < NPHASES; ++ph) {
        a.ph_lo = ph; a.ph_hi = ph + 1;
        hipLaunchKernelGGL(kerns[phase_kind(ph)], dim3(grid), dim3(NTHREADS), LDS_BYTES, stream, a);
    }
#endif
}
```

```cpp
#include <hip/hip_runtime.h>
#include <hip/hip_cooperative_groups.h>
#include <cstdio>
#include <cstdint>
namespace cg = cooperative_groups;

#ifndef PROBE_DUP
#define PROBE_DUP 0
#endif
#ifndef MK_ONE_LAUNCH
#define MK_ONE_LAUNCH 1
#endif

#define LAS __attribute__((address_space(3)))
typedef unsigned short bf16_t;
typedef short bf16x8 __attribute__((ext_vector_type(8)));
typedef float f32x4 __attribute__((ext_vector_type(4)));
typedef float f32x16 __attribute__((ext_vector_type(16)));
typedef unsigned u32x4 __attribute__((ext_vector_type(4)));
typedef unsigned u32x2 __attribute__((ext_vector_type(2)));
typedef LAS unsigned char lds_u8;

constexpr int NB = 8, SEQ = 2048, DM = 1024, M = NB * SEQ, DEPTH = 4, INW = 2560, FF = 2816, UPW = 2 * FF;
constexpr float EPS = 1e-6f;
constexpr int C_AQ = 0, C_AK = 384, C_AV = 512, C_BQ = 640, C_BFF = 896, C_BFB = 1152, C_BI = 1408, C_BG = 1664, C_CQ = 1920, C_CK = 2304, C_CV = 2432;

constexpr size_t MiB = 1u << 20;
constexpr size_t WS_CTL = 0;
constexpr size_t WS_MOD = 1 * MiB;
constexpr size_t WS_ROPE = 2 * MiB;
constexpr size_t WS_WIN = 4 * MiB;
constexpr size_t WS_WOUT = 24 * MiB;
constexpr size_t WS_WUP = 32 * MiB;
constexpr size_t WS_WDN = 76 * MiB;
constexpr size_t WS_H = 98 * MiB;
constexpr size_t WS_PROJ = 130 * MiB;
constexpr size_t WS_MIX = 210 * MiB;
constexpr size_t WS_HL = 242 * MiB;
constexpr size_t WS_HD = 274 * MiB;
constexpr size_t WS_VT = 275 * MiB;
constexpr size_t WS_ACT = 190 * MiB;
constexpr size_t WS_HS = 283 * MiB;
constexpr size_t WS_PO = 300 * MiB;
constexpr size_t WS_PL = 326 * MiB;
constexpr size_t WS_XB = 332 * MiB;
constexpr size_t WS_U = 330 * MiB;
constexpr size_t WS_END = 366 * MiB;

constexpr int LDS_BYTES = 147456;
constexpr int NTHREADS = 512;

typedef float f32x2_t __attribute__((ext_vector_type(2))); typedef __bf16 bf16x2_t __attribute__((ext_vector_type(2)));
__device__ __forceinline__ unsigned pk2(float lo, float hi) { f32x2_t v = {lo, hi}; bf16x2_t b = __builtin_convertvector(v, bf16x2_t); return __builtin_bit_cast(unsigned, b); }
__device__ __forceinline__ unsigned f2bf(float f) { return pk2(f, 0.f) & 0xffffu; }
__device__ __forceinline__ float bf2f(unsigned short h) { return __builtin_bit_cast(float, (unsigned)h << 16); }
__device__ __forceinline__ float bflo(unsigned w) { return __builtin_bit_cast(float, w << 16); }
__device__ __forceinline__ float bfhi(unsigned w) { return __builtin_bit_cast(float, w & 0xffff0000u); }
__device__ __forceinline__ float wave_sum(float v) {
#pragma unroll
    for (int o = 1; o < 64; o <<= 1) v += __shfl_xor(v, o);
    return v;
}
__device__ __forceinline__ float fast_exp2(float x) { return __builtin_amdgcn_exp2f(x); }
__device__ __forceinline__ float fast_exp(float x) { return __builtin_amdgcn_exp2f(x * 1.4426950408889634f); }
__device__ __forceinline__ float silu_f(float x) { return x * __builtin_amdgcn_rcpf(1.0f + fast_exp2(-1.4426950408889634f * x)); }

__device__ __forceinline__ float dpp_ror1(float v) { return __builtin_bit_cast(float, __builtin_amdgcn_update_dpp(0, __builtin_bit_cast(int, v), 0x121, 0xf, 0xf, true)); }
__device__ __forceinline__ float dpp_ror15(float v) { return __builtin_bit_cast(float, __builtin_amdgcn_update_dpp(0, __builtin_bit_cast(int, v), 0x12f, 0xf, 0xf, true)); }
__device__ __forceinline__ float dpp_shr1(float old, float v) { return __builtin_bit_cast(float, __builtin_amdgcn_update_dpp(__builtin_bit_cast(int, old), __builtin_bit_cast(int, v), 0x111, 0xf, 0xf, false)); }
__device__ __forceinline__ float dpp_shl1(float old, float v) { return __builtin_bit_cast(float, __builtin_amdgcn_update_dpp(__builtin_bit_cast(int, old), __builtin_bit_cast(int, v), 0x101, 0xf, 0xf, false)); }

namespace pg8 {
constexpr int BM = 256, BK = 64, HALF = 128, HTB = HALF * BK * 2, STAGE_BYTES = 8 * HTB, NXCD = 8, WGM = 8;
__host__ __device__ __forceinline__ int lds_byte(int r, int c) { const int st = (r >> 4) * 2 + (c >> 5), rr = r & 15, cc = c & 31, ob = rr * 64 + cc * 2; return st * 1024 + (ob ^ (((ob >> 9) & 1) << 5)); }
__host__ __device__ __forceinline__ void stage_rc(int b, int& R, int& C) { const int st = b / 1024, sb = b % 1024, swz = sb ^ (((sb >> 9) & 1) << 5); R = (st >> 1) * 16 + swz / 64; C = (st & 1) * 32 + (swz % 64) / 2; }
__host__ __device__ __forceinline__ int perm32(int rho) { const int n = rho >> 4, i = rho & 15; return 8 * (i >> 2) + 4 * n + (i & 3); }

struct Unit { int pm, pn, ar; };
struct Gemm { const bf16_t* A; const bf16_t* Bt; int M, N, K; };

struct StaticOrder {
    int nM, nN, nwg, G, c, conv, Mrows;
    __host__ __device__ void init(int M_, int N_, int G_, int c_, int conv_ = 0) { conv = conv_; Mrows = M_; nM = conv_ ? (M_ + 253) / 254 : M_ / BM; nN = N_ / BM; nwg = nM * nN; G = G_; c = c_; }
    __host__ __device__ bool next(int i, Unit& u) const {
        const long L = (long)i * G + c; if (L >= nwg) return false;
        int wgid = (int)L; { const int q = nwg / NXCD, r = nwg % NXCD, xcd = wgid % NXCD, off = wgid / NXCD; wgid = (xcd < r ? xcd * (q + 1) : r * (q + 1) + (xcd - r) * q) + off; }
        const int nig = WGM * nN, gid = wgid / nig, fm = gid * WGM, gsz = (nM - fm) < WGM ? (nM - fm) : WGM;
        u.pm = fm + ((wgid % nig) % gsz); u.pn = (wgid % nig) / gsz;
        if (conv) { int s = 254 * u.pm - 1; s = s < 0 ? 0 : s; u.ar = s > Mrows - BM ? Mrows - BM : s; } else u.ar = u.pm * BM;
        return true;
    }
};

struct EpiStore {
    static constexpr bool PERM = true;
    bf16_t* O; int ldc;
    __device__ __forceinline__ void operator()(const f32x4 (&acc)[2][2][4][2], const Unit& u, int wr, int wc, int fr, int fq, lds_u8*) const {
        const int row0 = u.pm * BM + wr * 64 + fr, col0 = u.pn * BM + wc * 32 + 8 * fq;
#pragma unroll
        for (int ai = 0; ai < 2; ++ai)
#pragma unroll
            for (int m = 0; m < 4; ++m) { bf16_t* rowp = O + (size_t)(row0 + ai * HALF + m * 16) * ldc + col0;
#pragma unroll
                for (int bj = 0; bj < 2; ++bj) { const f32x4 v0 = acc[ai][bj][m][0], v1 = acc[ai][bj][m][1];
                    u32x4 w; w.x = pk2(v0[0], v0[1]); w.y = pk2(v0[2], v0[3]); w.z = pk2(v1[0], v1[1]); w.w = pk2(v1[2], v1[3]);
                    *(u32x4*)(rowp + bj * HALF) = w; } }
    }
};
struct EpiResid {
    static constexpr bool PERM = true;
    unsigned char* ws; const float* xin32; float* out32; const float* normg;
    int l, second, nfuse;
    __device__ __forceinline__ void operator()(f32x4 (&acc)[2][2][4][2], const Unit& u, int wr, int wc, int fr, int fq, lds_u8* lds) const {
        const int col0 = u.pn * BM + wc * 32 + 8 * fq;
        const int bidx = (u.pm * BM) / SEQ;
        bf16_t* const xb16 = (bf16_t*)(ws + WS_XB);
        const float* const modl = (const float*)(ws + WS_MOD) + (size_t)l * 8 * 6144;
        const float* const gate = modl + (second ? 5 : 2) * DM;
        const float* const ng = normg + (size_t)(second ? (l + 1) * 2 : l * 2 + 1) * DM;
        const float* const nmod = second ? modl + 8 * 6144 : modl + 3 * DM;
        const int nidx = nfuse ? l * 2 + second : -1;
        const float* gb = gate + (size_t)bidx * 6144 + col0;
        f32x4 gv[2][2];
#pragma unroll
        for (int bj = 0; bj < 2; ++bj)
#pragma unroll
            for (int n = 0; n < 2; ++n) gv[bj][n] = *(const f32x4*)(gb + bj * HALF + 4 * n);
#pragma unroll
        for (int ai = 0; ai < 2; ++ai)
#pragma unroll
            for (int m = 0; m < 4; ++m) { const size_t off = (size_t)(u.pm * BM + ai * HALF + wr * 64 + m * 16 + fr) * DM + col0;
#pragma unroll
                for (int bj = 0; bj < 2; ++bj) {
                    f32x4 x0, x1;
                    if (xin32) { x0 = *(const f32x4*)(xin32 + off + bj * HALF); x1 = *(const f32x4*)(xin32 + off + bj * HALF + 4); }
                    else { const u32x4 w = *(const u32x4*)(xb16 + off + bj * HALF); x0 = (f32x4){bflo(w.x), bfhi(w.x), bflo(w.y), bfhi(w.y)}; x1 = (f32x4){bflo(w.z), bfhi(w.z), bflo(w.w), bfhi(w.w)}; }
                    const f32x4 y0 = x0 + gv[bj][0] * acc[ai][bj][m][0], y1 = x1 + gv[bj][1] * acc[ai][bj][m][1];
                    acc[ai][bj][m][0] = y0; acc[ai][bj][m][1] = y1;
                    if (out32) { __builtin_nontemporal_store(y0, (f32x4*)(out32 + off + bj * HALF)); __builtin_nontemporal_store(y1, (f32x4*)(out32 + off + bj * HALF + 4)); }
                    else { u32x4 w; w.x = pk2(y0[0], y0[1]); w.y = pk2(y0[2], y0[3]); w.z = pk2(y1[0], y1[1]); w.w = pk2(y1[2], y1[3]); *(u32x4*)(xb16 + off + bj * HALF) = w; }
                } }
        if (nidx < 0) return;
        asm volatile("" : "+v"(fr), "+v"(fq));
        bf16_t* const hn = (bf16_t*)(ws + WS_H); float* const slots = (float*)(ws + WS_CTL + 512 * 1024); unsigned* const cnt = (unsigned*)(ws + WS_CTL) + 8192 + nidx * 1024;
        LAS float* P = (LAS float*)(lds + STAGE_BYTES);
        LAS float* S = P + 1024;
#pragma unroll
        for (int ai = 0; ai < 2; ++ai)
#pragma unroll
            for (int m = 0; m < 4; ++m) { float s = 0.f;
#pragma unroll
                for (int bj = 0; bj < 2; ++bj)
#pragma unroll
                    for (int n = 0; n < 2; ++n) { const f32x4 v = acc[ai][bj][m][n]; s += (v[0] * v[0] + v[1] * v[1]) + (v[2] * v[2] + v[3] * v[3]); }
                s += __shfl_xor(s, 16); s += __shfl_xor(s, 32);
                if (fq == 0) P[(ai * HALF + wr * 64 + m * 16 + fr) * 4 + wc] = s; }
        asm volatile("s_waitcnt lgkmcnt(0)" ::: "memory"); __builtin_amdgcn_s_barrier(); asm volatile("" ::: "memory");
        const int tid = (wr * 4 + wc) * 64 + fr + 16 * fq;
        unsigned* slot_u = (unsigned*)slots + ((size_t)u.pm * BM) * 4;
        if (tid < 256) { const float t = (P[tid * 4] + P[tid * 4 + 1]) + (P[tid * 4 + 2] + P[tid * 4 + 3]);
            __hip_atomic_store(slot_u + tid * 4 + u.pn, __builtin_bit_cast(unsigned, t), __ATOMIC_RELAXED, __HIP_MEMORY_SCOPE_AGENT); }
        asm volatile("s_waitcnt vmcnt(0)" ::: "memory"); __builtin_amdgcn_s_barrier(); asm volatile("" ::: "memory");
        if (tid == 0) {
            unsigned* c = cnt + u.pm * 16;
            __builtin_amdgcn_fence(__ATOMIC_RELEASE, "agent");
            asm volatile("s_waitcnt vmcnt(0)" ::: "memory");
            (void)__hip_atomic_fetch_add(c, 1u, __ATOMIC_RELAXED, __HIP_MEMORY_SCOPE_AGENT);
            unsigned sp = 0u;
            while (__hip_atomic_load(c, __ATOMIC_RELAXED, __HIP_MEMORY_SCOPE_AGENT) < 4u) { __builtin_amdgcn_s_sleep(1); if (++sp > (1u << 22)) break; }
            __builtin_amdgcn_fence(__ATOMIC_ACQUIRE, "agent");
            asm volatile("s_waitcnt vmcnt(0)" ::: "memory");
        }
        __builtin_amdgcn_s_barrier(); asm volatile("" ::: "memory");
        if (tid < 256) { float t = 0.f;
#pragma unroll
            for (int p = 0; p < 4; ++p) t += __builtin_bit_cast(float, __hip_atomic_load(slot_u + tid * 4 + p, __ATOMIC_RELAXED, __HIP_MEMORY_SCOPE_AGENT));
            S[tid] = rsqrtf(t * (1.f / DM) + EPS); }
        asm volatile("s_waitcnt lgkmcnt(0)" ::: "memory"); __builtin_amdgcn_s_barrier(); asm volatile("" ::: "memory");
        const float* shp = nmod + (size_t)bidx * 6144 + col0; const float* scp = shp + DM; const float* gp = ng + col0;
#pragma unroll
        for (int bj = 0; bj < 2; ++bj)
#pragma unroll
            for (int n = 0; n < 2; ++n) {
                const f32x4 gn = *(const f32x4*)(gp + bj * HALF + 4 * n) * (*(const f32x4*)(scp + bj * HALF + 4 * n) + 1.0f), sn = *(const f32x4*)(shp + bj * HALF + 4 * n);
#pragma unroll
                for (int ai = 0; ai < 2; ++ai)
#pragma unroll
                    for (int m = 0; m < 4; ++m) { const int rl = ai * HALF + wr * 64 + m * 16 + fr; const float rstd = S[rl];
                        const f32x4 h0 = acc[ai][bj][m][n] * rstd * gn + sn;
                        u32x2 w; w.x = pk2(h0[0], h0[1]); w.y = pk2(h0[2], h0[3]);
                        *(u32x2*)(hn + (size_t)(u.pm * BM + rl) * DM + col0 + bj * HALF + 4 * n) = w; }
            }
    }
};

struct EpiConvGate {
    static constexpr bool PERM = true;
    bf16_t* act; const float* cw; const float* cb;
    __device__ __forceinline__ void operator()(const f32x4 (&acc)[2][2][4][2], const Unit& u, int wr, int wc, int fr, int fq, lds_u8* lds) const {
        LAS float* xch = (LAS float*)(lds + STAGE_BYTES);
        int colw = wc * 32 + 8 * fq; asm volatile("" : "+v"(colw));
#pragma unroll
        for (int ai = 0; ai < 2; ++ai) { const int rho = 2 * ai + wr;
#pragma unroll
            for (int bj = 0; bj < 2; ++bj)
#pragma unroll
                for (int n = 0; n < 2; ++n) {
                    if (fr == 0) *(LAS f32x4*)(xch + (rho * 2) * 256 + bj * 128 + colw + 4 * n) = acc[ai][bj][0][n];
                    if (fr == 15) *(LAS f32x4*)(xch + (rho * 2 + 1) * 256 + bj * 128 + colw + 4 * n) = acc[ai][bj][3][n]; } }
        asm volatile("s_waitcnt lgkmcnt(0)" ::: "memory"); __builtin_amdgcn_s_barrier(); asm volatile("" ::: "memory");
        const int jcol = u.pn * 128 + colw;
        const int olo = 254 * u.pm, ohi = (olo + 254 < M) ? olo + 254 : M;
#pragma unroll
        for (int n = 0; n < 2; ++n) {
            const int ja = jcol + 4 * n, jb = FF + ja;
            const f32x4 wa0 = *(const f32x4*)(cw + ja), wa1 = *(const f32x4*)(cw + UPW + ja), wa2 = *(const f32x4*)(cw + 2 * UPW + ja), ba = *(const f32x4*)(cb + ja);
            const f32x4 wb0 = *(const f32x4*)(cw + jb), wb1 = *(const f32x4*)(cw + UPW + jb), wb2 = *(const f32x4*)(cw + 2 * UPW + jb), bb = *(const f32x4*)(cb + jb);
#pragma unroll
            for (int ai = 0; ai < 2; ++ai) {
                const int rho = 2 * ai + wr;
                const f32x4 z4 = (f32x4){0.f, 0.f, 0.f, 0.f};
#pragma unroll
                for (int m = 0; m < 4; ++m) {
                    f32x4 Xa = z4, Xb = z4, Ya = z4, Yb = z4;
                    if (m == 0 && rho > 0) { Xa = *(const LAS f32x4*)(xch + ((rho - 1) * 2 + 1) * 256 + colw + 4 * n); Xb = *(const LAS f32x4*)(xch + ((rho - 1) * 2 + 1) * 256 + 128 + colw + 4 * n); }
                    if (m == 3 && rho < 3) { Ya = *(const LAS f32x4*)(xch + ((rho + 1) * 2) * 256 + colw + 4 * n); Yb = *(const LAS f32x4*)(xch + ((rho + 1) * 2) * 256 + 128 + colw + 4 * n); }
                    const int gr = u.ar + ai * HALF + wr * 64 + m * 16 + fr;
                    const int t = gr & (SEQ - 1);
                    const bool hasp = t != 0, hasn = t != SEQ - 1;
                    const f32x4 va = acc[ai][0][m][n], vb = acc[ai][1][m][n];
                    f32x4 pa, pb, na, nb;
#pragma unroll
                    for (int j = 0; j < 4; ++j) {
                        pa[j] = dpp_shr1(m > 0 ? dpp_ror1(acc[ai][0][m > 0 ? m - 1 : 0][n][j]) : Xa[j], va[j]);
                        pb[j] = dpp_shr1(m > 0 ? dpp_ror1(acc[ai][1][m > 0 ? m - 1 : 0][n][j]) : Xb[j], vb[j]);
                        na[j] = dpp_shl1(m < 3 ? dpp_ror15(acc[ai][0][m < 3 ? m + 1 : 3][n][j]) : Ya[j], va[j]);
                        nb[j] = dpp_shl1(m < 3 ? dpp_ror15(acc[ai][1][m < 3 ? m + 1 : 3][n][j]) : Yb[j], vb[j]);
                    }
                    const float fp = hasp ? 1.0f : 0.0f, fn = hasn ? 1.0f : 0.0f;
                    const f32x4 ca = ba + (wa0 * fp) * pa + wa1 * va + (wa2 * fn) * na;
                    const f32x4 cbv = bb + (wb0 * fp) * pb + wb1 * vb + (wb2 * fn) * nb;
                    const f32x4 ex = ca * -1.4426950408889634f;
                    f32x4 sg;
#pragma unroll
                    for (int j = 0; j < 4; ++j) sg[j] = __builtin_amdgcn_rcpf(1.0f + fast_exp2(ex[j]));
                    const f32x4 r = ca * sg * cbv;
                    if (gr >= olo && gr < ohi) { u32x2 w; w.x = pk2(r[0], r[1]); w.y = pk2(r[2], r[3]); *(u32x2*)(act + (size_t)gr * FF + ja) = w; }
                }
            }
        }
    }
};

template <class Epi, class Sched>
__device__ __forceinline__ void gemm_phase(lds_u8* lds, const Gemm g, const Sched& S, const Epi& E, const int tid) {
    const int wid = __builtin_amdgcn_readfirstlane(tid >> 6), lane = tid & 63, wr = wid >> 2, wc = wid & 3, fr = lane & 15, fq = lane >> 4;
    const int K = g.K, nt = K / BK;
    unsigned voffA[2], voffB[2];
#pragma unroll
    for (int i = 0; i < 2; ++i) { int R, C; stage_rc(tid * 16 + i * 8192, R, C); const int Rb = Epi::PERM ? ((R & ~31) + perm32(R & 31)) : R;
        voffA[i] = (unsigned)(R * K + C) * 2u; voffB[i] = (unsigned)(Rb * K + C) * 2u; }
    const size_t kstep = (size_t)(BK * 2);
    const size_t hstep = (size_t)HALF * K * 2;
    const size_t tstep = 2 * hstep;
    const unsigned ldsw = (unsigned)wid * 1024u;
    const int aoff = lds_byte(wr * 64 + fr, fq * 8), boff = lds_byte(wc * 32 + fr, fq * 8);
#define PG8_SA(b, h) (((b) * 2 + (h)) * HTB)
#define PG8_SB(b, h) ((4 + (b) * 2 + (h)) * HTB)
#define PG8_STAGE(bufoff, gbase, voff) do { _Pragma("unroll") for (int _i = 0; _i < 2; ++_i) \
        __builtin_amdgcn_global_load_lds((const unsigned*)((const char*)(gbase) + (voff)[_i]), (LAS unsigned*)(lds + (bufoff) + ldsw + _i * 8192), 16, 0, 0); } while (0)
#define PG8_LDA(dst, b, h) do { _Pragma("unroll") for (int m = 0; m < 4; ++m) _Pragma("unroll") for (int k = 0; k < 2; ++k) dst[m][k] = *(const LAS bf16x8*)(lds + PG8_SA(b, h) + aoff + m * 2048 + k * 1024); } while (0)
#define PG8_LDB(dst, b, h) do { _Pragma("unroll") for (int n = 0; n < 2; ++n) _Pragma("unroll") for (int k = 0; k < 2; ++k) dst[n][k] = *(const LAS bf16x8*)(lds + PG8_SB(b, h) + boff + n * 2048 + k * 1024); } while (0)
#define PG8_MMA(ai, bj, At, Bt) do { __builtin_amdgcn_s_setprio(1); _Pragma("unroll") for (int m = 0; m < 4; ++m) _Pragma("unroll") for (int n = 0; n < 2; ++n) _Pragma("unroll") for (int k = 0; k < 2; ++k) \
        acc[ai][bj][m][n] = __builtin_amdgcn_mfma_f32_16x16x32_bf16(Bt[n][k], At[m][k], acc[ai][bj][m][n], 0, 0, 0); __builtin_amdgcn_s_setprio(0); } while (0)
#define PG8_WAIT_V(n) asm volatile("s_waitcnt vmcnt(" #n ")" ::: "memory")
#define PG8_WAIT_L(n) asm volatile("s_waitcnt lgkmcnt(" #n ")" ::: "memory")
#define PG8_BAR __builtin_amdgcn_s_barrier()
#define PG8_SCHED __builtin_amdgcn_sched_barrier(0)
    Unit cur, nxt; int ui = 0;
    if (!S.next(0, cur)) return;
    f32x4 acc[2][2][4][2];
#pragma unroll
    for (int a = 0; a < 2; ++a)
#pragma unroll
        for (int b = 0; b < 2; ++b)
#pragma unroll
            for (int m = 0; m < 4; ++m)
#pragma unroll
                for (int n = 0; n < 2; ++n) acc[a][b][m][n] = (f32x4){0.f, 0.f, 0.f, 0.f};
    bf16x8 At[4][2], B0[2][2], B1[2][2];
    const char* cA = (const char*)g.A + (size_t)cur.ar * (size_t)(K * 2); const char* cB = (const char*)g.Bt + (size_t)cur.pn * tstep;
    PG8_STAGE(PG8_SB(0, 0), cB, voffB); PG8_STAGE(PG8_SB(0, 1), cB + hstep, voffB); PG8_STAGE(PG8_SA(0, 0), cA, voffA); PG8_STAGE(PG8_SA(0, 1), cA + hstep, voffA);
    if (wr == 1) PG8_BAR;
    PG8_WAIT_V(2); PG8_BAR;
    PG8_STAGE(PG8_SB(1, 0), cB + kstep, voffB); PG8_STAGE(PG8_SA(1, 0), cA + kstep, voffA); PG8_STAGE(PG8_SB(1, 1), cB + hstep + kstep, voffB);
    PG8_WAIT_V(6); PG8_BAR;
    for (;;) {
        const bool has_next = S.next(ui + 1, nxt);
        const char* nA = has_next ? (const char*)g.A + (size_t)nxt.ar * (size_t)(K * 2) : cA; const char* nB = has_next ? (const char*)g.Bt + (size_t)nxt.pn * tstep : cB;
        for (int t = 0; t < nt; t += 2) {
            const bool last = (t == nt - 2);
            const char* a1 = cA + (size_t)(t + 1) * kstep;
            const char* a2 = last ? nA : cA + (size_t)(t + 2) * kstep; const char* b2 = last ? nB : cB + (size_t)(t + 2) * kstep;
            const char* a3 = a2 + kstep; const char* b3 = b2 + kstep;
            PG8_LDB(B0, 0, 0); PG8_LDB(B1, 0, 1); PG8_SCHED; PG8_LDA(At, 0, 0); PG8_STAGE(PG8_SA(1, 1), a1 + hstep, voffA);
            PG8_WAIT_V(8); PG8_WAIT_L(0); PG8_BAR; PG8_MMA(0, 0, At, B0); PG8_MMA(0, 1, At, B1); PG8_BAR; PG8_SCHED;
            PG8_LDA(At, 0, 1); PG8_STAGE(PG8_SB(0, 0), b2, voffB); PG8_STAGE(PG8_SB(0, 1), b2 + hstep, voffB); PG8_STAGE(PG8_SA(0, 0), a2, voffA);
            PG8_WAIT_V(8); PG8_WAIT_L(0); PG8_BAR; PG8_MMA(1, 0, At, B0); PG8_MMA(1, 1, At, B1); PG8_BAR; PG8_SCHED;
            PG8_LDB(B0, 1, 0); PG8_LDB(B1, 1, 1); PG8_SCHED; PG8_LDA(At, 1, 0); PG8_STAGE(PG8_SA(0, 1), a2 + hstep, voffA);
            PG8_WAIT_V(8); PG8_WAIT_L(0); PG8_BAR; PG8_MMA(0, 0, At, B0); PG8_MMA(0, 1, At, B1); PG8_BAR; PG8_SCHED;
            PG8_LDA(At, 1, 1); PG8_STAGE(PG8_SB(1, 0), b3, voffB); PG8_STAGE(PG8_SB(1, 1), b3 + hstep, voffB); PG8_STAGE(PG8_SA(1, 0), a3, voffA);
            PG8_WAIT_V(8); PG8_WAIT_L(0); PG8_BAR; PG8_MMA(1, 0, At, B0); PG8_MMA(1, 1, At, B1); PG8_BAR; PG8_SCHED;
        }
        if (wr == 0) PG8_BAR;
        E(acc, cur, wr, wc, fr, fq, lds);
        if (!has_next) break;
#pragma unroll
        for (int a = 0; a < 2; ++a)
#pragma unroll
            for (int b = 0; b < 2; ++b)
#pragma unroll
                for (int m = 0; m < 4; ++m)
#pragma unroll
                    for (int n = 0; n < 2; ++n) acc[a][b][m][n] = (f32x4){0.f, 0.f, 0.f, 0.f};
        cur = nxt; cA = nA; cB = nB; ++ui;
        if (wr == 1) PG8_BAR;
    }
    PG8_WAIT_V(0);
    PG8_BAR;
#undef PG8_SA
#undef PG8_SB
#undef PG8_STAGE
#undef PG8_LDA
#undef PG8_LDB
#undef PG8_MMA
#undef PG8_WAIT_V
#undef PG8_WAIT_L
#undef PG8_BAR
#undef PG8_SCHED
}
}

struct Args {
    const float* in[17];
    float* out; unsigned char* ws;
    int ph_lo, ph_hi;
};
enum { I_X = 0, I_C, I_WADA, I_BADA, I_NORMG, I_WIN, I_AQN, I_AKN, I_BLB, I_BON, I_CQN, I_CKN, I_WOUT, I_WUP, I_CONVW, I_CONVB, I_WDOWN };

__device__ __forceinline__ void p0_transpose_item(const float* W, int K, int N, bf16_t* WT, int mode, LAS float* scr, int item, int lane) {
    const int nblk = N / 32, kb = item / nblk, nb = item % nblk, k0 = 64 * kb, n0 = 32 * nb;
    int rbase = n0;
    if (mode == 1) { const int isb = n0 / FF, j0 = n0 % FF; rbase = 256 * (j0 / 128) + (j0 % 128) + 128 * isb; }
    { float tmp[32];
#pragma unroll
      for (int i = 0; i < 32; ++i) { const int kk = 2 * i + (lane >> 5); tmp[i] = __builtin_nontemporal_load(&W[(size_t)(k0 + kk) * N + n0 + (lane & 31)]); }
#pragma unroll
      for (int i = 0; i < 32; ++i) { const int kk = 2 * i + (lane >> 5); scr[kk * 33 + (lane & 31)] = tmp[i]; } }
    asm volatile("s_waitcnt lgkmcnt(0)" ::: "memory");
    const int c = lane & 7;
#pragma unroll
    for (int j = 0; j < 4; ++j) { const int n = (lane >> 3) + 8 * j; const LAS float* s = scr + (8 * c) * 33 + n;
        u32x4 o; o.x = pk2(s[0 * 33], s[1 * 33]); o.y = pk2(s[2 * 33], s[3 * 33]); o.z = pk2(s[4 * 33], s[5 * 33]); o.w = pk2(s[6 * 33], s[7 * 33]);
        *(u32x4*)(WT + (size_t)(rbase + n) * K + k0 + 8 * c) = o; }
    asm volatile("s_waitcnt lgkmcnt(0)" ::: "memory");
}

__device__ __forceinline__ void phase_prologue(const Args& a, lds_u8* lds, int vcu, int G, const int tid, const int bx) {
    const int lane = tid & 63, wave = tid >> 6;
    unsigned char* ws = a.ws;
    if (bx == 0) {
        float* tb = (float*)(ws + WS_ROPE);
        for (int e = tid; e < 1024; e += NTHREADS) { const int pos = e >> 4, i = e & 15; const float inv = exp2f(-(float)i * (13.287712379549449f / 16.0f)); const float ang = (float)pos * inv;
            tb[2 * e] = cosf(ang); tb[2 * e + 1] = sinf(ang); }
    }
    {
        LAS float* sc = (LAS float*)(lds + 0);
        LAS float* red = (LAS float*)(lds + 32768);
        bool have = false;
        for (int it = vcu; it < DEPTH * 96; it += G) {
            if (!have) { const float* c = a.in[I_C];
                for (int e = tid; e < NB * DM; e += NTHREADS) { const int b = e >> 10, k = e & 1023; sc[k * 8 + b] = silu_f(c[e]); }
                have = true; __syncthreads(); }
            const int l = it / 96, n0 = 64 * (it % 96);
            const float* wp = a.in[I_WADA] + ((size_t)l * DM + 128 * wave) * 6144 + n0 + lane;
            float acc[8];
#pragma unroll
            for (int b = 0; b < 8; ++b) acc[b] = 0.f;
#pragma unroll 32
            for (int kk = 0; kk < 128; ++kk) { const float wv = __builtin_nontemporal_load(&wp[(size_t)kk * 6144]); const LAS f32x4* s4 = (const LAS f32x4*)(sc + (128 * wave + kk) * 8); const f32x4 s0 = s4[0], s1 = s4[1];
                acc[0] += s0[0] * wv; acc[1] += s0[1] * wv; acc[2] += s0[2] * wv; acc[3] += s0[3] * wv; acc[4] += s1[0] * wv; acc[5] += s1[1] * wv; acc[6] += s1[2] * wv; acc[7] += s1[3] * wv; }
#pragma unroll
            for (int b = 0; b < 8; ++b) red[(wave * 8 + b) * 64 + lane] = acc[b];
            __syncthreads();
            { const int b = tid >> 6, col = tid & 63; float s = 0.f;
#pragma unroll
              for (int w = 0; w < 8; ++w) s += red[(w * 8 + b) * 64 + col];
              ((float*)(ws + WS_MOD))[((size_t)l * 8 + b) * 6144 + n0 + col] = s + a.in[I_BADA][(size_t)l * 6144 + n0 + col]; }
            __syncthreads();
        }
        __syncthreads();
    }
    {
        LAS float* scr = (LAS float*)(lds + wave * 8448);
        const int gw = vcu * 8 + wave, NGW = G * 8;
        constexpr int I_IN = 16 * (INW / 32), I_OUT = 16 * (DM / 32), I_UP = 16 * (UPW / 32), I_DN = (FF / 64) * (DM / 32), I_LAYER = I_IN + I_OUT + I_UP + I_DN;
        const int nheavy = (DEPTH * 96 > G && DEPTH * 96 < 2 * G) ? DEPTH * 96 - G : 0, nlight = G - nheavy;
        const int npre = nheavy ? 3 * nlight * 8 : 0;
        for (int pass = 0; pass < 2; ++pass) {
            int it0, ie, st;
            if (pass == 0) { if (!nheavy || vcu < nheavy) continue; it0 = (vcu - nheavy) * 8 + wave; ie = npre; st = nlight * 8; }
            else { it0 = npre + gw; ie = DEPTH * I_LAYER; st = NGW; }
            for (int it = it0; it < ie; it += st) {
                const int l = it / I_LAYER; int r = it % I_LAYER;
                if (r < I_IN) { p0_transpose_item(a.in[I_WIN] + (size_t)l * DM * INW, DM, INW, (bf16_t*)(ws + WS_WIN) + (size_t)l * INW * DM, 0, scr, r, lane); continue; } r -= I_IN;
                if (r < I_OUT) { p0_transpose_item(a.in[I_WOUT] + (size_t)l * DM * DM, DM, DM, (bf16_t*)(ws + WS_WOUT) + (size_t)l * DM * DM, 0, scr, r, lane); continue; } r -= I_OUT;
                if (r < I_UP) { p0_transpose_item(a.in[I_WUP] + (size_t)l * DM * UPW, DM, UPW, (bf16_t*)(ws + WS_WUP) + (size_t)l * UPW * DM, 1, scr, r, lane); continue; } r -= I_UP;
                p0_transpose_item(a.in[I_WDOWN] + (size_t)l * FF * DM, FF, DM, (bf16_t*)(ws + WS_WDN) + (size_t)l * DM * FF, 0, scr, r, lane);
            }
        }
    }
}

__device__ __forceinline__ void norm_rows4(const float* x, const float* g, const float* mod_l  , int which_sh, bf16_t* h, int m0, int lane) {
    const int b = m0 / SEQ;
    const f32x4* gr = (const f32x4*)g + lane;
    const f32x4* shr = (const f32x4*)(mod_l + (size_t)b * 6144 + which_sh * DM) + lane;
    const f32x4* scr = (const f32x4*)(mod_l + (size_t)b * 6144 + (which_sh + 1) * DM) + lane;
    f32x4 v[4][4];
#pragma unroll
    for (int r = 0; r < 4; ++r) { const f32x4* xr = (const f32x4*)(x + (size_t)(m0 + r) * DM) + lane;
#pragma unroll
        for (int j = 0; j < 4; ++j) v[r][j] = xr[64 * j]; }
    f32x4 gs[4], sh[4];
#pragma unroll
    for (int j = 0; j < 4; ++j) { gs[j] = gr[64 * j] * (scr[64 * j] + 1.0f); sh[j] = shr[64 * j]; }
#pragma unroll
    for (int r = 0; r < 4; ++r) {
        float s = 0.f;
#pragma unroll
        for (int j = 0; j < 4; ++j) s += (v[r][j].x * v[r][j].x + v[r][j].y * v[r][j].y) + (v[r][j].z * v[r][j].z + v[r][j].w * v[r][j].w);
        const float rstd = rsqrtf(wave_sum(s) * (1.f / DM) + EPS);
        u32x2* o8 = (u32x2*)(h + (size_t)(m0 + r) * DM) + lane;
#pragma unroll
        for (int j = 0; j < 4; ++j) { const f32x4 y = v[r][j] * rstd * gs[j] + sh[j];
            u32x2 w; w.x = pk2(y.x, y.y); w.y = pk2(y.z, y.w); o8[64 * j] = w; }
    }
}
__device__ __forceinline__ void norm_rows4_bf(const bf16_t* x, const float* g, const float* mod_l  , int which_sh, bf16_t* h, int m0, int lane) {
    const int b = m0 / SEQ;
    const float* shp = mod_l + (size_t)b * 6144 + which_sh * DM; const float* scp = shp + DM;
    u32x4 raw[4][2];
#pragma unroll
    for (int r = 0; r < 4; ++r) { const u32x4* xr = (const u32x4*)(x + (size_t)(m0 + r) * DM) + lane; raw[r][0] = xr[0]; raw[r][1] = xr[64]; }
    f32x4 gs[2][2], sh[2][2];
#pragma unroll
    for (int c = 0; c < 2; ++c)
#pragma unroll
        for (int q = 0; q < 2; ++q) { const int col = 512 * c + 8 * lane + 4 * q; gs[c][q] = *(const f32x4*)(g + col) * (*(const f32x4*)(scp + col) + 1.0f); sh[c][q] = *(const f32x4*)(shp + col); }
#pragma unroll
    for (int r = 0; r < 4; ++r) {
        f32x4 v[2][2]; float s = 0.f;
#pragma unroll
        for (int c = 0; c < 2; ++c) { const u32x4 w = raw[r][c]; v[c][0] = (f32x4){bflo(w.x), bfhi(w.x), bflo(w.y), bfhi(w.y)}; v[c][1] = (f32x4){bflo(w.z), bfhi(w.z), bflo(w.w), bfhi(w.w)};
#pragma unroll
            for (int q = 0; q < 2; ++q) s += (v[c][q].x * v[c][q].x + v[c][q].y * v[c][q].y) + (v[c][q].z * v[c][q].z + v[c][q].w * v[c][q].w); }
        const float rstd = rsqrtf(wave_sum(s) * (1.f / DM) + EPS);
        u32x4* o16 = (u32x4*)(h + (size_t)(m0 + r) * DM) + lane;
#pragma unroll
        for (int c = 0; c < 2; ++c) { const f32x4 y0 = v[c][0] * rstd * gs[c][0] + sh[c][0], y1 = v[c][1] * rstd * gs[c][1] + sh[c][1];
            u32x4 w; w.x = pk2(y0.x, y0.y); w.y = pk2(y0.z, y0.w); w.z = pk2(y1.x, y1.y); w.w = pk2(y1.z, y1.w); o16[64 * c] = w; }
    }
}
__device__ __forceinline__ void phase_norm_bf(const bf16_t* x, const float* g, const float* mod_l, int which_sh, bf16_t* h, int vcu, int G, const int tid) {
    const int lane = tid & 63, wave = tid >> 6;
    const int gw = vcu * 8 + wave, NGW = G * 8;
    for (int m0 = gw * 4; m0 < M; m0 += NGW * 4) norm_rows4_bf(x, g, mod_l, which_sh, h, m0, lane);
}
__device__ __forceinline__ void phase_norm(const float* x, const float* g, const float* mod_l, int which_sh, bf16_t* h, int vcu, int G, const int tid) {
    const int lane = tid & 63, wave = tid >> 6;
    const int gw = vcu * 8 + wave, NGW = G * 8;
    for (int m0 = gw * 4; m0 < M; m0 += NGW * 4) norm_rows4(x, g, mod_l, which_sh, h, m0, lane);
}

__device__ __forceinline__ float hgrn_lb(const float* b_lb, int dir, int l, int col) {
    const float* p = b_lb + (size_t)dir * DEPTH * 256 + col;
    const float v0 = p[0], v1 = p[256], v2 = p[512], v3 = p[768];
    const float mx = fmaxf(fmaxf(v0, v1), fmaxf(v2, v3));
    const float e0 = __expf(v0 - mx), e1 = __expf(v1 - mx), e2 = __expf(v2 - mx), e3 = __expf(v3 - mx);
    const float s = e0 + e1 + e2 + e3;
    float acc = 0.f; if (l >= 1) acc += e1; if (l >= 2) acc += e2; if (l >= 3) acc += e3;
    return acc / s;
}
__device__ __forceinline__ void hgrn_fk(float xpre, float lb, float& lf, float& kk) {
    float f = lb + (1.0f - lb) * __builtin_amdgcn_rcpf(1.0f + fast_exp2(-1.4426950408889634f * xpre));
    f = fmaxf(f, 1e-6f);
    lf = __builtin_amdgcn_logf(f); kk = 1.0f - f;
}

__device__ __forceinline__ void phase_prep(const Args& a, lds_u8* lds, int l, int vcu, int G, const int tid, const bool dry) {
    const int lane = tid & 63, wave = tid >> 6;
    const int gw = vcu * 8 + wave, NGW = G * 8;
    unsigned char* ws = a.ws;
    bf16_t* proj = (bf16_t*)(ws + WS_PROJ);
    const float* rope = (const float*)(ws + WS_ROPE);
    {
        const float gak = a.in[I_AKN][l * 64 + lane], gck = a.in[I_CKN][l * 64 + lane];
        const int half = lane >> 5, side = (lane >> 4) & 1, i = lane & 15;
        for (int m0 = gw * 4; m0 < M; m0 += NGW * 4) {
            unsigned short raw[4][4];
#pragma unroll
            for (int r = 0; r < 4; ++r) { const bf16_t* row = proj + (size_t)(m0 + r) * INW;
                raw[r][0] = row[C_AK + lane]; raw[r][1] = row[C_AK + 64 + lane]; raw[r][2] = row[C_CK + lane]; raw[r][3] = row[C_CK + 64 + lane]; }
#pragma unroll
            for (int r = 0; r < 4; ++r) {
                const int m = m0 + r, t = m & (SEQ - 1);
                bf16_t* wrow = (dry ? (bf16_t*)(ws + WS_U) : proj) + (size_t)m * INW;
                const int pos = half ? (t & 63) : (t >> 6);
                const float cs = rope[(pos * 16 + i) * 2], sn = rope[(pos * 16 + i) * 2 + 1];
#pragma unroll
                for (int hh = 0; hh < 2; ++hh) {
                    float v = bf2f(raw[r][hh]);
                    const float ss = wave_sum(v * v);
                    v = v * rsqrtf(ss * (1.f / 64) + EPS) * gak;
                    const float pr = __shfl_xor(v, 16);
                    const float o = side ? (v * cs + pr * sn) : (v * cs - pr * sn);
                    wrow[C_AK + hh * 64 + lane] = (bf16_t)f2bf(o);
                }
#pragma unroll
                for (int hh = 0; hh < 2; ++hh) {
                    float v = bf2f(raw[r][2 + hh]);
                    const float ss = wave_sum(v * v);
                    v = v * rsqrtf(ss * (1.f / 64) + EPS) * gck;
                    wrow[C_CK + hh * 64 + lane] = (bf16_t)f2bf(v);
                }
            }
        }
    }
    {
        LAS bf16_t* scr = (LAS bf16_t*)(lds + wave * 9216);
        bf16_t* vt = (bf16_t*)(ws + WS_VT);
        for (int it = gw; it < NB * 4 * 32; it += NGW) {
            const int b = it >> 7, kv4 = (it >> 5) & 3, tb = it & 31;
            const int col0 = (kv4 < 2 ? C_AV : C_CV) + (kv4 & 1) * 64;
            const bf16_t* src = proj + ((size_t)b * SEQ + tb * 64) * INW + col0 + lane;
#pragma unroll
            for (int rb = 0; rb < 64; rb += 32) { unsigned short tmp[32];
#pragma unroll
              for (int r = 0; r < 32; ++r) tmp[r] = src[(size_t)(rb + r) * INW];
#pragma unroll
              for (int r = 0; r < 32; ++r) scr[(rb + r) * 66 + lane] = tmp[r]; }
            asm volatile("s_waitcnt lgkmcnt(0)" ::: "memory");
            bf16_t* dst = vt + (((size_t)b * 4 + kv4) * 64) * SEQ + tb * 64 + lane;
#pragma unroll 16
            for (int d = 0; d < 64; ++d) dst[(size_t)d * SEQ] = scr[lane * 66 + d];
            asm volatile("s_waitcnt lgkmcnt(0)" ::: "memory");
        }
    }
    {
        LAS bf16_t* klt = (LAS bf16_t*)(lds + wave * 9216);
        float* HL = (float*)(ws + WS_HL); float* HDp = (float*)(ws + WS_HD);
        const int r16 = lane & 15, q4 = lane >> 4;
        for (int it = gw; it < NB * 4 * 2 * 32; it += NGW) {
            const int c = it & 31, dir = (it >> 5) & 1, hh = (it >> 6) & 3, b = it >> 8;
            const float lb = hgrn_lb(a.in[I_BLB], dir, l, hh * 64 + lane);
            const size_t rbase = (size_t)b * SEQ + c * 64;
            const int fcol = (dir ? C_BFB : C_BFF) + hh * 64 + lane;
            unsigned fpk[32];
#pragma unroll
            for (int s = 0; s < 64; s += 2) { const int t0 = dir ? (63 - s) : s, t1 = dir ? (62 - s) : s + 1; fpk[s >> 1] = (unsigned)proj[(rbase + t0) * INW + fcol] | ((unsigned)proj[(rbase + t1) * INW + fcol] << 16); }
            float total = 0.f;
#pragma unroll
            for (int s = 63; s >= 0; --s) { float lf, kk; hgrn_fk((s & 1) ? bfhi(fpk[s >> 1]) : bflo(fpk[s >> 1]), lb, lf, kk);
                klt[lane * 72 + s] = (bf16_t)f2bf(kk * fast_exp2(total)); total += lf; }
            asm volatile("s_waitcnt lgkmcnt(0)" ::: "memory");
            HDp[(size_t)it * 64 + lane] = fast_exp2(total);
            const int vcol = C_BI + hh * 64;
            float* Lo = HL + (size_t)it * 4096;
#pragma unroll
            for (int mi = 0; mi < 4; ++mi) {
                bf16x8 af[2];
#pragma unroll
                for (int ks = 0; ks < 2; ++ks)
#pragma unroll
                    for (int j = 0; j < 8; ++j) { const int s = 32 * ks + 8 * q4 + j; const int tk = dir ? (63 - s) : s; af[ks][j] = (short)proj[(rbase + tk) * INW + vcol + 16 * mi + r16]; }
#pragma unroll
                for (int ni = 0; ni < 4; ++ni) {
                    f32x4 acc = (f32x4){0.f, 0.f, 0.f, 0.f};
#pragma unroll
                    for (int ks = 0; ks < 2; ++ks) { const bf16x8 bfr = *(const LAS bf16x8*)(klt + (16 * ni + r16) * 72 + 32 * ks + 8 * q4);
                        acc = __builtin_amdgcn_mfma_f32_16x16x32_bf16(af[ks], bfr, acc, 0, 0, 0); }
#pragma unroll
                    for (int j = 0; j < 4; ++j) Lo[(16 * mi + 4 * q4 + j) * 64 + 16 * ni + r16] = acc[j];
                }
            }
            asm volatile("s_waitcnt lgkmcnt(0)" ::: "memory");
        }
    }
}

constexpr int AT_KV = 18432;
constexpr int AT_TBL = 4 * AT_KV;
__device__ __forceinline__ int pi32(int m) { return (m & ~12) | ((m & 4) << 1) | ((m & 8) >> 1); }

template <bool BIAS>
__device__ __forceinline__ void attn_unit(lds_u8* lds, const bf16_t* proj, const bf16_t* vt, bf16_t* mix, const bf16_t* po_far, const float* pl, const float* gq, const float* gk, const float* rope,
                                          int b, int h, int qblk, int qcol0, int kcol0, int vsel0, int mixcol0, const int tid) {
    const int lane = tid & 63, wave = __builtin_amdgcn_readfirstlane(tid >> 6);
    const int r32 = lane & 31, hi = lane >> 5;
    const int kvh = h / 3;
    const int q0 = qblk * 256;
    const int qp = q0 + 32 * wave + r32;
    int tlo = 0, ntile = SEQ / 64;
    if (BIAS) { const int klo = q0 - 256 < 0 ? 0 : q0 - 256, khi_ = q0 + 255 + 256 > SEQ - 1 ? SEQ - 1 : q0 + 255 + 256; tlo = klo >> 6; ntile = (khi_ >> 6) - tlo + 1; }
    const bf16_t* kbase = proj + (size_t)b * SEQ * INW + kcol0 + kvh * 64;
    const bf16_t* vbase = vt + ((size_t)b * 4 + vsel0 + kvh) * 64 * SEQ;
    const int lrow_ = tid >> 3, lc16 = tid & 7;
    u32x4 kreg, vreg;
#define AT_LOAD(tile) do { const int key0_ = (tile) * 64; kreg = *(const u32x4*)(kbase + (size_t)(key0_ + lrow_) * INW + lc16 * 8); vreg = *(const u32x4*)(vbase + (size_t)lrow_ * SEQ + key0_ + lc16 * 8); } while (0)
#define AT_STORE(bufi) do { lds_u8* bb_ = lds + (bufi) * AT_KV; *(LAS u32x4*)(bb_ + lrow_ * 144 + lc16 * 16) = kreg; *(LAS u32x4*)(bb_ + 9216 + lrow_ * 144 + lc16 * 16) = vreg; } while (0)
    u32x4 qraw[4];
    { const bf16_t* qrow = proj + ((size_t)b * SEQ + qp) * INW + qcol0 + h * 64 + 8 * hi;
#pragma unroll
      for (int d0 = 0; d0 < 4; ++d0) qraw[d0] = *(const u32x4*)(qrow + 16 * d0); }
    AT_LOAD(tlo);
    const float gql = gq[lane], gkl = gk[lane];
    f32x4 gqv[4][2];
#pragma unroll
    for (int d0 = 0; d0 < 4; ++d0) { gqv[d0][0] = *(const f32x4*)(gq + 16 * d0 + 8 * hi); gqv[d0][1] = *(const f32x4*)(gq + 16 * d0 + 8 * hi + 4); }
    f32x4 rpr[4], rpc[4];
    if (!BIAS) { const int pr = qp >> 6, pc = qp & 63;
#pragma unroll
        for (int j4 = 0; j4 < 4; ++j4) { rpr[j4] = *(const f32x4*)(rope + (pr * 16 + 8 * hi) * 2 + 4 * j4); rpc[j4] = *(const f32x4*)(rope + (pc * 16 + 8 * hi) * 2 + 4 * j4); } }
    float ref;
    { float a = fabsf(gql), c = fabsf(gkl);
#pragma unroll
      for (int o = 1; o < 64; o <<= 1) { a = fmaxf(a, __shfl_xor(a, o)); c = fmaxf(c, __shfl_xor(c, o)); }
      ref = 64.0f * 0.125f * 1.4426950408889634f * 1.02f * a * c + (BIAS ? 1.6f : 0.0f); }
    if (BIAS) {
        LAS float* tbl = (LAS float*)(lds + AT_TBL);
        const float slope = fast_exp2(-(float)(h + 1) * (4.0f / 3.0f));
        for (int e = tid; e < 4096; e += NTHREADS) { const int d = e - 2048, ad = d < 0 ? -d : d;
            const int mult = ad > 256 ? 0 : (ad <= 64 ? 1 : 0) + ((ad & 3) == 0 ? 1 : 0) + ((ad & 15) == 0 ? 1 : 0);
            const float lg = mult == 3 ? 1.5849625007211562f : (mult == 2 ? 1.0f : 0.0f);
            tbl[e] = mult ? (lg - slope * (float)ad * 1.4426950408889634f - ref) : -1e30f; }
    }
    bf16x8 qr[4];
    {
        float v[4][8]; float ss = 0.f;
#pragma unroll
        for (int d0 = 0; d0 < 4; ++d0) { const u32x4 w = qraw[d0];
            v[d0][0] = bflo(w.x); v[d0][1] = bfhi(w.x); v[d0][2] = bflo(w.y); v[d0][3] = bfhi(w.y); v[d0][4] = bflo(w.z); v[d0][5] = bfhi(w.z); v[d0][6] = bflo(w.w); v[d0][7] = bfhi(w.w);
#pragma unroll
            for (int j = 0; j < 8; ++j) ss += v[d0][j] * v[d0][j]; }
        ss += __shfl_xor(ss, 32);
        const float rstd = rsqrtf(ss * (1.f / 64) + EPS);
#pragma unroll
        for (int d0 = 0; d0 < 4; ++d0)
#pragma unroll
            for (int j = 0; j < 8; ++j) v[d0][j] *= rstd * gqv[d0][j >> 2][j & 3];
        if (!BIAS) {
#pragma unroll
            for (int j = 0; j < 8; ++j) {
                { const float c = rpr[j >> 1][2 * (j & 1)], s = rpr[j >> 1][2 * (j & 1) + 1]; const float x1 = v[0][j], x2 = v[1][j]; v[0][j] = x1 * c - x2 * s; v[1][j] = x2 * c + x1 * s; }
                { const float c = rpc[j >> 1][2 * (j & 1)], s = rpc[j >> 1][2 * (j & 1) + 1]; const float x1 = v[2][j], x2 = v[3][j]; v[2][j] = x1 * c - x2 * s; v[3][j] = x2 * c + x1 * s; } }
        }
        const float qsc = 0.125f * 1.4426950408889634f;
#pragma unroll
        for (int d0 = 0; d0 < 4; ++d0) { u32x4 w; w.x = pk2(v[d0][0] * qsc, v[d0][1] * qsc); w.y = pk2(v[d0][2] * qsc, v[d0][3] * qsc); w.z = pk2(v[d0][4] * qsc, v[d0][5] * qsc); w.w = pk2(v[d0][6] * qsc, v[d0][7] * qsc);
            qr[d0] = __builtin_bit_cast(bf16x8, w); }
    }
    AT_STORE(0);
    __syncthreads();
    float lrow = 0.f;
    f32x16 o0, o1, negref;
#pragma unroll
    for (int i = 0; i < 16; ++i) { o0[i] = 0.f; o1[i] = 0.f; negref[i] = -ref; }
    const int krow = pi32(r32);
    for (int step = 0; step < ntile; ++step) {
        const bool ldn = (step + 1 < ntile);
        if (ldn) AT_LOAD(tlo + step + 1);
        {
            const lds_u8* kb = lds + (step & 1) * AT_KV;
            const lds_u8* vb = kb + 9216;
            f32x16 p0, p1;
            if (BIAS) {
                const LAS float* tbl = (const LAS float*)(lds + AT_TBL) + ((tlo + step) * 64 + 8 * hi - qp + 2048);
#pragma unroll
                for (int i = 0; i < 16; ++i) { p0[i] = tbl[(i & 7) + 16 * (i >> 3)]; p1[i] = tbl[(i & 7) + 16 * (i >> 3) + 32]; }
            } else { p0 = negref; p1 = negref; }
#pragma unroll
            for (int d0 = 0; d0 < 4; ++d0) {
                const bf16x8 k0 = *(const LAS bf16x8*)(kb + krow * 144 + 32 * d0 + 16 * hi);
                const bf16x8 k1 = *(const LAS bf16x8*)(kb + (32 + krow) * 144 + 32 * d0 + 16 * hi);
                p0 = __builtin_amdgcn_mfma_f32_32x32x16_bf16(k0, qr[d0], p0, 0, 0, 0);
                p1 = __builtin_amdgcn_mfma_f32_32x32x16_bf16(k1, qr[d0], p1, 0, 0, 0);
            }
            float rs0 = 0.f, rs1 = 0.f;
#pragma unroll
            for (int i = 0; i < 16; ++i) { p0[i] = fast_exp2(p0[i]); p1[i] = fast_exp2(p1[i]); rs0 += p0[i]; rs1 += p1[i]; }
            lrow += rs0 + rs1;
            bf16x8 pb[2][2];
#pragma unroll
            for (int ks = 0; ks < 2; ++ks) {
                u32x4 w; w.x = pk2(p0[8 * ks + 0], p0[8 * ks + 1]); w.y = pk2(p0[8 * ks + 2], p0[8 * ks + 3]); w.z = pk2(p0[8 * ks + 4], p0[8 * ks + 5]); w.w = pk2(p0[8 * ks + 6], p0[8 * ks + 7]);
                pb[0][ks] = __builtin_bit_cast(bf16x8, w);
                u32x4 w1; w1.x = pk2(p1[8 * ks + 0], p1[8 * ks + 1]); w1.y = pk2(p1[8 * ks + 2], p1[8 * ks + 3]); w1.z = pk2(p1[8 * ks + 4], p1[8 * ks + 5]); w1.w = pk2(p1[8 * ks + 6], p1[8 * ks + 7]);
                pb[1][ks] = __builtin_bit_cast(bf16x8, w1);
            }
#pragma unroll
            for (int sub = 0; sub < 2; ++sub)
#pragma unroll
                for (int ks = 0; ks < 2; ++ks) {
                    const bf16x8 v0 = *(const LAS bf16x8*)(vb + r32 * 144 + (32 * sub + 16 * ks + 8 * hi) * 2);
                    const bf16x8 v1 = *(const LAS bf16x8*)(vb + (32 + r32) * 144 + (32 * sub + 16 * ks + 8 * hi) * 2);
                    o0 = __builtin_amdgcn_mfma_f32_32x32x16_bf16(v0, pb[sub][ks], o0, 0, 0, 0);
                    o1 = __builtin_amdgcn_mfma_f32_32x32x16_bf16(v1, pb[sub][ks], o1, 0, 0, 0);
                }
        }
        if (ldn) AT_STORE((step + 1) & 1);
        __syncthreads();
    }
#undef AT_LOAD
#undef AT_STORE
    lrow += __shfl_xor(lrow, 32);
    {
        const size_t grow = (size_t)b * SEQ + qp;
        const bf16_t* fpo = BIAS ? po_far + grow * 384 + h * 64 + 4 * hi : nullptr;
        const float inv = 1.0f / (lrow + (BIAS ? pl[grow * 6 + h] : 0.0f));
        bf16_t* orow = mix + grow * DM + mixcol0 + h * 64 + 4 * hi;
#pragma unroll
        for (int g4 = 0; g4 < 4; ++g4) {
            u32x2 f0 = (u32x2){0u, 0u}, f1 = (u32x2){0u, 0u};
            if (BIAS) { f0 = *(const u32x2*)(fpo + 8 * g4); f1 = *(const u32x2*)(fpo + 32 + 8 * g4); }
            { const float x0 = (o0[4 * g4] + bflo(f0.x)) * inv, x1 = (o0[4 * g4 + 1] + bfhi(f0.x)) * inv, x2 = (o0[4 * g4 + 2] + bflo(f0.y)) * inv, x3 = (o0[4 * g4 + 3] + bfhi(f0.y)) * inv;
              u32x2 w; w.x = pk2(x0, x1); w.y = pk2(x2, x3); *(u32x2*)(orow + 8 * g4) = w; }
            { const float x0 = (o1[4 * g4] + bflo(f1.x)) * inv, x1 = (o1[4 * g4 + 1] + bfhi(f1.x)) * inv, x2 = (o1[4 * g4 + 2] + bflo(f1.y)) * inv, x3 = (o1[4 * g4 + 3] + bfhi(f1.y)) * inv;
              u32x2 w; w.x = pk2(x0, x1); w.y = pk2(x2, x3); *(u32x2*)(orow + 32 + 8 * g4) = w; }
        }
    }
}

__device__ __forceinline__ void attn_r16_unit(lds_u8* lds, const bf16_t* proj, bf16_t* po, float* pl, const float* gq, const float* gk, int b, int kvh, int rho, const int tid) {
    const int lane = tid & 63, wave = __builtin_amdgcn_readfirstlane(tid >> 6);
    const int qs = wave & 3, kh = wave >> 2, r32 = lane & 31, hi = lane >> 5;
    const int iq = 32 * qs + r32;
    const size_t qrow_g = (size_t)b * SEQ + rho + 16 * iq;
    const bf16_t* qrow0 = proj + qrow_g * INW + C_CQ + (kvh * 3) * 64 + 8 * hi;
    u32x4 qcur[4], qnxt[4];
#pragma unroll
    for (int d0 = 0; d0 < 4; ++d0) { qcur[d0] = *(const u32x4*)(qrow0 + 16 * d0); qnxt[d0] = qcur[d0]; }
    u32x4 kst[2], vst[2];
    const int th = tid & 255;
#pragma unroll
    for (int i_ = 0; i_ < 2; ++i_) { const int c_ = th + 256 * i_, row_ = c_ >> 3, c16_ = c_ & 7;
        const bf16_t* src = proj + ((size_t)b * SEQ + rho + 16 * (64 * kh + row_)) * INW + kvh * 64 + c16_ * 8;
        kst[i_] = *(const u32x4*)(src + C_CK); vst[i_] = *(const u32x4*)(src + C_CV); }
    const float gql = gq[lane], gkl = gk[lane];
    float ref;
    { float a = fabsf(gql), c = fabsf(gkl);
#pragma unroll
      for (int o = 1; o < 64; o <<= 1) { a = fmaxf(a, __shfl_xor(a, o)); c = fmaxf(c, __shfl_xor(c, o)); }
      ref = 64.0f * 0.125f * 1.4426950408889634f * 1.02f * a * c + 1.6f; }
    LAS float* tb = (LAS float*)(lds + 40960);
    for (int e = tid; e < 768; e += NTHREADS) { const int hq = e >> 8, d = (e & 255) - 128, ad = d < 0 ? -d : d; const float slope = fast_exp2(-(float)(kvh * 3 + hq + 1) * (4.0f / 3.0f));
        tb[e] = (ad > 16 && ad <= 64) ? (-slope * 16.0f * (float)ad * 1.4426950408889634f - ref) : -1e30f; }
    lds_u8* hb = lds + kh * AT_KV;
#pragma unroll
    for (int i_ = 0; i_ < 2; ++i_) { const int c_ = th + 256 * i_, row_ = c_ >> 3, c16_ = c_ & 7;
        *(LAS u32x4*)(hb + row_ * 144 + c16_ * 16) = kst[i_]; *(LAS u32x4*)(hb + 9216 + row_ * 144 + c16_ * 16) = vst[i_]; }
    __syncthreads();
    const int krow = pi32(r32);
    bf16x8 kf[8], vf[8];
#pragma unroll
    for (int d0 = 0; d0 < 4; ++d0) { kf[2 * d0] = *(const LAS bf16x8*)(hb + krow * 144 + 32 * d0 + 16 * hi); kf[2 * d0 + 1] = *(const LAS bf16x8*)(hb + (32 + krow) * 144 + 32 * d0 + 16 * hi); }
    { const LAS bf16_t* vbase = (const LAS bf16_t*)(hb + 9216);
#pragma unroll
      for (int sub = 0; sub < 2; ++sub)
#pragma unroll
        for (int ks = 0; ks < 2; ++ks)
#pragma unroll
            for (int j = 0; j < 8; ++j) { const int key = 32 * sub + 16 * ks + 8 * hi + j;
                vf[(sub * 2 + ks) * 2][j] = (short)vbase[key * 72 + r32]; vf[(sub * 2 + ks) * 2 + 1][j] = (short)vbase[key * 72 + 32 + r32]; } }
    __syncthreads();
    LAS float* cs = (LAS float*)(lds) + (qs * 64 + lane) * 35;
#pragma unroll 1
    for (int hq = 0; hq < 3; ++hq) {
        const int h = kvh * 3 + hq;
        if (hq < 2) {
#pragma unroll
            for (int d0 = 0; d0 < 4; ++d0) qnxt[d0] = *(const u32x4*)(qrow0 + (hq + 1) * 64 + 16 * d0); }
        bf16x8 qr[4];
        {
            f32x4 gqv[4][2];
#pragma unroll
            for (int d0 = 0; d0 < 4; ++d0) { gqv[d0][0] = *(const f32x4*)(gq + 16 * d0 + 8 * hi); gqv[d0][1] = *(const f32x4*)(gq + 16 * d0 + 8 * hi + 4); }
            float v[4][8]; float ss = 0.f;
#pragma unroll
            for (int d0 = 0; d0 < 4; ++d0) { const u32x4 w = qcur[d0];
                v[d0][0] = bflo(w.x); v[d0][1] = bfhi(w.x); v[d0][2] = bflo(w.y); v[d0][3] = bfhi(w.y); v[d0][4] = bflo(w.z); v[d0][5] = bfhi(w.z); v[d0][6] = bflo(w.w); v[d0][7] = bfhi(w.w);
#pragma unroll
                for (int j = 0; j < 8; ++j) ss += v[d0][j] * v[d0][j]; }
            ss += __shfl_xor(ss, 32);
            const float rstd = rsqrtf(ss * (1.f / 64) + EPS) * (0.125f * 1.4426950408889634f);
#pragma unroll
            for (int d0 = 0; d0 < 4; ++d0) { float y[8];
#pragma unroll
                for (int j = 0; j < 8; ++j) y[j] = v[d0][j] * rstd * gqv[d0][j >> 2][j & 3];
                u32x4 w; w.x = pk2(y[0], y[1]); w.y = pk2(y[2], y[3]); w.z = pk2(y[4], y[5]); w.w = pk2(y[6], y[7]); qr[d0] = __builtin_bit_cast(bf16x8, w); }
        }
        f32x16 p0, p1;
        { const LAS float* tbl = tb + hq * 256 + (64 * kh + 8 * hi - iq + 128);
#pragma unroll
          for (int i = 0; i < 16; ++i) { p0[i] = tbl[(i & 7) + 16 * (i >> 3)]; p1[i] = tbl[(i & 7) + 16 * (i >> 3) + 32]; } }
#pragma unroll
        for (int d0 = 0; d0 < 4; ++d0) {
            p0 = __builtin_amdgcn_mfma_f32_32x32x16_bf16(kf[2 * d0], qr[d0], p0, 0, 0, 0);
            p1 = __builtin_amdgcn_mfma_f32_32x32x16_bf16(kf[2 * d0 + 1], qr[d0], p1, 0, 0, 0);
        }
        float lrow = 0.f;
#pragma unroll
        for (int i = 0; i < 16; ++i) { p0[i] = fast_exp2(p0[i]); p1[i] = fast_exp2(p1[i]); lrow += p0[i] + p1[i]; }
        bf16x8 pb[2][2];
#pragma unroll
        for (int ks = 0; ks < 2; ++ks) {
            u32x4 w; w.x = pk2(p0[8 * ks + 0], p0[8 * ks + 1]); w.y = pk2(p0[8 * ks + 2], p0[8 * ks + 3]); w.z = pk2(p0[8 * ks + 4], p0[8 * ks + 5]); w.w = pk2(p0[8 * ks + 6], p0[8 * ks + 7]);
            pb[0][ks] = __builtin_bit_cast(bf16x8, w);
            u32x4 w1; w1.x = pk2(p1[8 * ks + 0], p1[8 * ks + 1]); w1.y = pk2(p1[8 * ks + 2], p1[8 * ks + 3]); w1.z = pk2(p1[8 * ks + 4], p1[8 * ks + 5]); w1.w = pk2(p1[8 * ks + 6], p1[8 * ks + 7]);
            pb[1][ks] = __builtin_bit_cast(bf16x8, w1);
        }
        f32x16 o0, o1;
#pragma unroll
        for (int i = 0; i < 16; ++i) { o0[i] = 0.f; o1[i] = 0.f; }
#pragma unroll
        for (int sub = 0; sub < 2; ++sub)
#pragma unroll
            for (int ks = 0; ks < 2; ++ks) {
                o0 = __builtin_amdgcn_mfma_f32_32x32x16_bf16(vf[(sub * 2 + ks) * 2], pb[sub][ks], o0, 0, 0, 0);
                o1 = __builtin_amdgcn_mfma_f32_32x32x16_bf16(vf[(sub * 2 + ks) * 2 + 1], pb[sub][ks], o1, 0, 0, 0);
            }
        lrow += __shfl_xor(lrow, 32);
        if (kh == 1) { cs[1] = lrow;
#pragma unroll
            for (int i = 0; i < 16; ++i) { cs[2 + i] = o0[i]; cs[18 + i] = o1[i]; } }
        __syncthreads();
        if (kh == 0) {
            bf16_t* orow = po + qrow_g * 384 + h * 64 + 4 * hi;
            if (hi == 0) pl[qrow_g * 6 + h] = lrow + cs[1];
#pragma unroll
            for (int g4 = 0; g4 < 4; ++g4) {
                { u32x2 w; w.x = pk2(o0[4 * g4] + cs[2 + 4 * g4], o0[4 * g4 + 1] + cs[3 + 4 * g4]); w.y = pk2(o0[4 * g4 + 2] + cs[4 + 4 * g4], o0[4 * g4 + 3] + cs[5 + 4 * g4]); *(u32x2*)(orow + 8 * g4) = w; }
                { u32x2 w; w.x = pk2(o1[4 * g4] + cs[18 + 4 * g4], o1[4 * g4 + 1] + cs[19 + 4 * g4]); w.y = pk2(o1[4 * g4 + 2] + cs[20 + 4 * g4], o1[4 * g4 + 3] + cs[21 + 4 * g4]); *(u32x2*)(orow + 32 + 8 * g4) = w; }
            }
        }
        __syncthreads();
#pragma unroll
        for (int d0 = 0; d0 < 4; ++d0) qcur[d0] = qnxt[d0];
    }
}

__device__ __forceinline__ void phase_scan(const Args& a, int vcu, int G, const int tid) {
    const float* HL = (const float*)(a.ws + WS_HL); const float* HDp = (const float*)(a.ws + WS_HD); bf16_t* HS = (bf16_t*)(a.ws + WS_HS);
    for (int e = vcu * NTHREADS + tid; e < 64 * 4096; e += G * NTHREADS) {
        const int seq = e >> 12, idx = e & 4095, k = idx & 63, dir = seq & 1;
        float st = 0.f;
        float hd[32], hl[32];
#pragma unroll
        for (int j = 0; j < 32; ++j) { const int c = dir ? 31 - j : j; const size_t o = (size_t)seq * 32 + c; hd[j] = HDp[o * 64 + k]; hl[j] = HL[o * 4096 + idx]; }
#pragma unroll
        for (int j = 0; j < 32; ++j) { const int c = dir ? 31 - j : j; const size_t o = (size_t)seq * 32 + c; HS[o * 4096 + idx] = (bf16_t)f2bf(st); st = hd[j] * st + hl[j]; }
    }
}

constexpr int HG_OACC = 0, HG_QS = 65536, HG_QD = HG_QS + 9216, HG_KD = HG_QD + 9216, HG_KE = HG_KD + 9216, HG_Q2 = HG_KE + 9216, HG_K2 = HG_Q2 + 4608,
              HG_VT = HG_K2 + 4608, HG_AT = HG_VT + 9216, HG_ST = HG_AT + 9216, HG_GT = HG_ST + 9216, HG_END = HG_GT + 2048;
static_assert(HG_END <= LDS_BYTES, "HGRN LDS map");

__device__ __forceinline__ void hgrn_out_item(const Args& a, lds_u8* lds, int l, int item, const int tid) {
    const int lane = tid & 63, wave = __builtin_amdgcn_readfirstlane(tid >> 6);
    const int k = lane, rg = wave;
    const int b = item >> 5, hh = (item >> 3) & 3, grp = item & 7;
    const int c0 = grp * 4;
    unsigned char* ws = a.ws;
    const bf16_t* proj = (const bf16_t*)(ws + WS_PROJ);
    const float* HL = (const float*)(ws + WS_HL); const float* HDp = (const float*)(ws + WS_HD);
    LAS float* oacc = (LAS float*)(lds + HG_OACC);
    LAS bf16_t* Qs = (LAS bf16_t*)(lds + HG_QS); LAS bf16_t* Qd = (LAS bf16_t*)(lds + HG_QD); LAS bf16_t* Kd = (LAS bf16_t*)(lds + HG_KD); LAS bf16_t* Ke = (LAS bf16_t*)(lds + HG_KE);
    LAS bf16_t* Q2 = (LAS bf16_t*)(lds + HG_Q2); LAS bf16_t* K2 = (LAS bf16_t*)(lds + HG_K2); LAS bf16_t* VT = (LAS bf16_t*)(lds + HG_VT); LAS bf16_t* AT = (LAS bf16_t*)(lds + HG_AT);
    LAS bf16_t* ST = (LAS bf16_t*)(lds + HG_ST); LAS float* gt = (LAS float*)(lds + HG_GT);
    const int r16 = lane & 15, q4 = lane >> 4;
    const float lbv0 = hgrn_lb(a.in[I_BLB], 0, l, hh * 64 + k), lbv1 = hgrn_lb(a.in[I_BLB], 1, l, hh * 64 + k);
    unsigned short rq[8], rf[8], rv[8];
#define HG_LOADRAW(dir_, c_) do { const size_t rb_ = (size_t)b * SEQ + (c_) * 64; _Pragma("unroll") for (int i = 0; i < 8; ++i) { const int s_ = 8 * rg + i; const int tk_ = (dir_) ? (63 - s_) : s_; \
        const bf16_t* rp_ = proj + (rb_ + tk_) * INW; rq[i] = rp_[C_BQ + hh * 64 + k]; rf[i] = rp_[((dir_) ? C_BFB : C_BFF) + hh * 64 + k]; rv[i] = rp_[C_BI + hh * 64 + k]; } } while (0)
    HG_LOADRAW(0, c0);
    float st[8];
#pragma unroll
    for (int i = 0; i < 8; ++i) st[i] = 0.f;
    for (int stp = 0; stp < 8; ++stp) {
        {
            const int dir = stp >> 2, ci = stp & 3;
            const float lb = dir ? lbv1 : lbv0;
            const size_t sbase = (((size_t)b * 4 + hh) * 2 + dir) * 32;
            const int c = dir ? (c0 + 3 - ci) : (c0 + ci);
            if (ci == 0) { const bf16_t* HSp = (const bf16_t*)(ws + WS_HS) + (sbase + c) * 4096 + (8 * wave) * 64 + k;
#pragma unroll
                for (int i = 0; i < 8; ++i) st[i] = bf2f(HSp[i * 64]); }
            float qv[8], lf[8], kk[8];
            u32x4 vpk;
#pragma unroll
            for (int i = 0; i < 8; ++i) { qv[i] = bf2f(rq[i]); hgrn_fk(bf2f(rf[i]), lb, lf[i], kk[i]); }
            vpk.x = rv[0] | ((unsigned)rv[1] << 16); vpk.y = rv[2] | ((unsigned)rv[3] << 16); vpk.z = rv[4] | ((unsigned)rv[5] << 16); vpk.w = rv[6] | ((unsigned)rv[7] << 16);
            const float dk = HDp[(sbase + c) * 64 + k];
            float Ln[8];
            { const float* Lp = HL + (sbase + c) * 4096 + (8 * wave) * 64 + k;
#pragma unroll
              for (int i = 0; i < 8; ++i) Ln[i] = Lp[i * 64]; }
            if (stp < 7) { const int nd = (stp + 1) >> 2, nci = (stp + 1) & 3; const int nc = nd ? (c0 + 3 - nci) : (c0 + nci); HG_LOADRAW(nd, nc); }
#pragma unroll
            for (int i = 1; i < 8; ++i) lf[i] += lf[i - 1];
            gt[rg * 64 + k] = lf[7];
#pragma unroll
            for (int i = 0; i < 8; ++i) ST[(8 * wave + i) * 72 + k] = (bf16_t)f2bf(st[i]);
            __syncthreads();
            float gsum[9]; gsum[0] = 0.f;
#pragma unroll
            for (int g = 0; g < 8; ++g) gsum[g + 1] = gsum[g] + gt[g * 64 + k];
            float off = 0.f, bS = 0.f, bE = 0.f;
#pragma unroll
            for (int g = 0; g < 8; ++g) { if (g == rg) off = gsum[g]; if (g == (rg & ~1)) { bS = gsum[g]; bE = gsum[g + 2]; } }
            const float b31 = gsum[4];
            const float eS = fast_exp2(bS), e2 = fast_exp2(rg >= 4 ? bS - b31 : b31 - bE);
#pragma unroll
            for (int i = 0; i < 8; ++i) {
                const int s = 8 * rg + i; const float bb = off + lf[i];
                const float qd = qv[i] * fast_exp2(bb - bS), ke = kk[i] * fast_exp2(bE - bb);
                Qd[s * 72 + k] = (bf16_t)f2bf(qd);
                Qs[s * 72 + k] = (bf16_t)f2bf(qd * eS);
                Kd[s * 72 + k] = (bf16_t)f2bf(kk[i] * fast_exp2(fminf(bS - bb, 115.f)));
                Ke[s * 72 + k] = (bf16_t)f2bf(ke);
                { const bool hi2 = rg >= 4; LAS bf16_t* T2 = hi2 ? Q2 + (s - 32) * 72 + k : K2 + s * 72 + k;
                  *T2 = (bf16_t)f2bf((hi2 ? qd : ke) * e2); }
            }
            *(LAS u32x4*)(VT + k * 72 + 8 * rg) = vpk;
            __syncthreads();
            {
                const int I = wave >> 1;
#pragma unroll
                for (int jj = 0; jj < 2; ++jj) {
                    const int J = 2 * (wave & 1) + jj;
                    f32x4 acc = (f32x4){0.f, 0.f, 0.f, 0.f};
                    if (J <= I) {
                        const LAS bf16_t* Ap; const LAS bf16_t* Bp;
                        if (J == I) { Ap = Qd + (16 * I + r16) * 72; Bp = Kd + (16 * J + r16) * 72; }
                        else if ((I >> 1) == (J >> 1)) { Ap = Qd + (16 * I + r16) * 72; Bp = Ke + (16 * J + r16) * 72; }
                        else { Ap = Q2 + (16 * (I - 2) + r16) * 72; Bp = K2 + (16 * J + r16) * 72; }
#pragma unroll
                        for (int ks = 0; ks < 2; ++ks) { const bf16x8 af = *(const LAS bf16x8*)(Ap + 32 * ks + 8 * q4); const bf16x8 bfr = *(const LAS bf16x8*)(Bp + 32 * ks + 8 * q4);
                            acc = __builtin_amdgcn_mfma_f32_16x16x32_bf16(af, bfr, acc, 0, 0, 0); }
                        if (J == I) {
#pragma unroll
                            for (int j = 0; j < 4; ++j) if (r16 > 4 * q4 + j) acc[j] = 0.f;
                        }
                    }
#pragma unroll
                    for (int j = 0; j < 4; ++j) AT[(16 * I + 4 * q4 + j) * 72 + 16 * J + r16] = (bf16_t)f2bf(acc[j]);
                }
            }
            __syncthreads();
            {
                const int mi = wave >> 1;
#pragma unroll
                for (int jj = 0; jj < 2; ++jj) {
                    const int ni = 2 * (wave & 1) + jj;
                    f32x4 acc = (f32x4){0.f, 0.f, 0.f, 0.f};
#pragma unroll
                    for (int ks = 0; ks < 2; ++ks) { const bf16x8 af = *(const LAS bf16x8*)(Qs + (16 * mi + r16) * 72 + 32 * ks + 8 * q4); const bf16x8 bfr = *(const LAS bf16x8*)(ST + (16 * ni + r16) * 72 + 32 * ks + 8 * q4);
                        acc = __builtin_amdgcn_mfma_f32_16x16x32_bf16(af, bfr, acc, 0, 0, 0); }
#pragma unroll
                    for (int ks = 0; ks < 2; ++ks) { const bf16x8 af = *(const LAS bf16x8*)(AT + (16 * mi + r16) * 72 + 32 * ks + 8 * q4); const bf16x8 bfr = *(const LAS bf16x8*)(VT + (16 * ni + r16) * 72 + 32 * ks + 8 * q4);
                        acc = __builtin_amdgcn_mfma_f32_16x16x32_bf16(af, bfr, acc, 0, 0, 0); }
#pragma unroll
                    for (int j = 0; j < 4; ++j) { const int t = 16 * mi + 4 * q4 + j; const int tl = (c - c0) * 64 + (dir ? (63 - t) : t);
                        LAS float* op = oacc + tl * 64 + 16 * ni + r16;
                        if (dir == 0) *op = acc[j]; else *op += acc[j]; }
                }
            }
#pragma unroll
            for (int i = 0; i < 8; ++i) st[i] = dk * st[i] + Ln[i];
            __syncthreads();
        }
    }
#undef HG_LOADRAW

    {
        const float gn = a.in[I_BON][l * 64 + lane];
        bf16_t* mix = (bf16_t*)(ws + WS_MIX);
        for (int rb = 0; rb < 32; rb += 8) {
            unsigned short gv[8];
#pragma unroll
            for (int r = 0; r < 8; ++r) gv[r] = proj[((size_t)b * SEQ + c0 * 64 + 32 * wave + rb + r) * INW + C_BG + hh * 64 + lane];
#pragma unroll
            for (int r = 0; r < 8; ++r) {
                const int tl = 32 * wave + rb + r;
                const size_t row = (size_t)b * SEQ + c0 * 64 + tl;
                const float o = oacc[tl * 64 + lane];
                const float ss = wave_sum(o * o);
                mix[row * DM + 384 + hh * 64 + lane] = (bf16_t)f2bf(o * rsqrtf(ss * (1.f / 64) + EPS) * gn * silu_f(bf2f(gv[r])));
            }
        }
    }
    __syncthreads();
}

__device__ __forceinline__ void phase_mixers(const Args& a, lds_u8* lds, int l, int vcu, int G, const int tid) {
    unsigned char* ws = a.ws;
    const bf16_t* proj = (const bf16_t*)(ws + WS_PROJ); const bf16_t* vt = (const bf16_t*)(ws + WS_VT); bf16_t* mix = (bf16_t*)(ws + WS_MIX);
    const float* rope = (const float*)(ws + WS_ROPE);
    for (int rp = 0; rp < ((PROBE_DUP & 256) ? 2 : 1); ++rp)
    for (int it = vcu; it < NB * 4 * 8; it += G) hgrn_out_item(a, lds, l, it, tid);
    const bf16_t* po_far = (const bf16_t*)(ws + WS_PO); const float* pl_far = (const float*)(ws + WS_PL);
    for (int u = vcu; u < 768; u += G) {
        const int mixer = u / 384, r = u % 384, b = r / 48, rr = r % 48, kvh = rr / 24, r3 = rr % 24, hq = r3 / 8, qblk = r3 % 8;
        const int h = kvh * 3 + hq;
        if (mixer == 0) attn_unit<false>(lds, proj, vt, mix, nullptr, nullptr, a.in[I_AQN] + l * 64, a.in[I_AKN] + l * 64, rope, b, h, qblk, C_AQ, C_AK, 0, 0, tid);
        else attn_unit<true>(lds, proj, vt, mix, po_far, pl_far, a.in[I_CQN] + l * 64, a.in[I_CKN] + l * 64, rope, b, h, qblk, C_CQ, C_CK, 2, 640, tid);
    }
}

__device__ __forceinline__ void phase_mixc(const Args& a, lds_u8* lds, int l, int vcu, int G, const int tid) {
    unsigned char* ws = a.ws;
    const bf16_t* proj = (const bf16_t*)(ws + WS_PROJ);
    bf16_t* po = (bf16_t*)(ws + WS_PO); float* pl = (float*)(ws + WS_PL);
    for (int u = vcu; u < 256; u += G) {
        const int b = u >> 5, kvh = (u >> 4) & 1, rho = u & 15;
        attn_r16_unit(lds, proj, po, pl, a.in[I_CQN] + l * 64, a.in[I_CKN] + l * 64, b, kvh, rho, tid);
    }
}

#define XB_TMO      128
#define XB_XCNT(j)  (256  + 64 * (j))
#define XB_XSUB(j)  (1280 + 64 * (j))
#define XB_XGEN(j)  (2304 + 64 * (j))
#define XB_TOP      3328
#define XB_TOPGEN   3392
#define XCD_BAR_WORDS 3456
#define XB_SPIN_CAP (1u << 18)
__device__ __forceinline__ unsigned xb_ld(unsigned* p)              { return __hip_atomic_load(p, __ATOMIC_RELAXED, __HIP_MEMORY_SCOPE_AGENT); }
__device__ __forceinline__ unsigned xb_add(unsigned* p, unsigned v) { return __hip_atomic_fetch_add(p, v, __ATOMIC_RELAXED, __HIP_MEMORY_SCOPE_AGENT); }
__device__ __forceinline__ unsigned xb_xcc_id() { return (unsigned)__builtin_amdgcn_s_getreg((3 << 11) | 20) & 0xFu; }
#define XB_SPIN(cond, bar) do { unsigned _sp = 0; while (cond) { __builtin_amdgcn_s_sleep(1); \
    if ((++_sp & 255u) == 0u) { if (xb_ld(&(bar)[XB_TMO])) break; if (_sp > XB_SPIN_CAP) { atomicAdd(&(bar)[XB_TMO], 1u); break; } } } } while (0)
struct XcdBarrier { unsigned* bar; unsigned x; volatile LAS unsigned* st; int wave; };
__device__ __forceinline__ int lane_id() { return (int)__builtin_amdgcn_mbcnt_hi(~0u, __builtin_amdgcn_mbcnt_lo(~0u, 0u)); }
__device__ __forceinline__ XcdBarrier xcd_barrier_post(unsigned* bar, volatile LAS unsigned* st, int wave) {
    XcdBarrier b; b.bar = bar; b.x = xb_xcc_id(); b.st = st; b.wave = wave;
    if (wave == 0 && lane_id() == 0) (void)xb_add(&bar[XB_XCNT(b.x)], 1u);
    return b;
}
__device__ __forceinline__ void xcd_barrier_complete(unsigned* bar, unsigned x, unsigned& nloc, unsigned& nx) {
    const unsigned G = gridDim.x * gridDim.y * gridDim.z;
    unsigned sum, cnt, mine, sp = 0u;
    for (;;) {
        sum = 0u; cnt = 0u; mine = 0u;
#pragma unroll
        for (unsigned j = 0; j < 16; ++j) { const unsigned c = xb_ld(&bar[XB_XCNT(j)]); sum += c; cnt += (c > 0u) ? 1u : 0u; mine = (j == x) ? c : mine; }
        if (sum == G) break;
        __builtin_amdgcn_s_sleep(1);
        if ((++sp & 255u) == 0u) { if (xb_ld(&bar[XB_TMO])) break; if (sp > XB_SPIN_CAP) { atomicAdd(&bar[XB_TMO], 1u); break; } }
    }
    nloc = mine > 0u ? mine : 1u; nx = cnt > 0u ? cnt : 1u;
}
__device__ __forceinline__ void xcd_barrier(const XcdBarrier& b) {
    asm volatile("s_waitcnt vmcnt(0)" ::: "memory");
    __syncthreads();
    if (b.wave == 0 && lane_id() == 0) {
        unsigned* bar = b.bar;
        __builtin_amdgcn_s_waitcnt(0);
        unsigned nloc = b.st[0], nx = b.st[1];
        if (nloc == 0u) { xcd_barrier_complete(bar, b.x, nloc, nx); b.st[0] = nloc; b.st[1] = nx; }
        const unsigned old = xb_add(&bar[XB_XSUB(b.x)], 1u);
        const unsigned gen = old / nloc;
        if (old + 1u == (gen + 1u) * nloc) {
            __builtin_amdgcn_fence(__ATOMIC_RELEASE, "agent");
            asm volatile("s_waitcnt vmcnt(0)" ::: "memory");
            const unsigned og = xb_add(&bar[XB_TOP], 1u);
            const unsigned tg = og / nx;
            if (og + 1u == (tg + 1u) * nx) xb_add(&bar[XB_TOPGEN], 1u);
            else XB_SPIN(xb_ld(&bar[XB_TOPGEN]) == tg, bar);
            __builtin_amdgcn_fence(__ATOMIC_ACQUIRE, "agent");
            xb_add(&bar[XB_XGEN(b.x)], 1u);
            asm volatile("s_waitcnt vmcnt(0)" ::: "memory");
        } else {
            XB_SPIN(xb_ld(&bar[XB_XGEN(b.x)]) == gen, bar);
            __builtin_amdgcn_fence(__ATOMIC_ACQUIRE, "agent");
            asm volatile("s_waitcnt vmcnt(0)" ::: "memory");
        }
    }
    __syncthreads();
}
__device__ __forceinline__ void panel_norm(unsigned* cnt, const bf16_t* x, const float* g, const float* mod_l, int which_sh, bf16_t* h, int pm, int pn, const int tid) {
    asm volatile("s_waitcnt vmcnt(0)" ::: "memory");
    __syncthreads();
    if (tid == 0) {
        __builtin_amdgcn_fence(__ATOMIC_RELEASE, "agent");
        asm volatile("s_waitcnt vmcnt(0)" ::: "memory");
        (void)xb_add(cnt, 1u);
        unsigned sp = 0u;
        while (xb_ld(cnt) < 4u) { __builtin_amdgcn_s_sleep(1); if (++sp > (1u << 22)) break; }
        __builtin_amdgcn_fence(__ATOMIC_ACQUIRE, "agent");
        asm volatile("s_waitcnt vmcnt(0)" ::: "memory");
    }
    __syncthreads();
    const int lane = tid & 63, wave = tid >> 6;
    for (int r = 0; r < 8; r += 4) norm_rows4_bf(x, g, mod_l, which_sh, h, pm * 256 + pn * 64 + wave * 8 + r, lane);
}
constexpr int MISC_OFF = LDS_BYTES - 64;

constexpr int NPHASES = 2 + 9 * DEPTH - 1;

typedef const Args __attribute__((address_space(4))) KArgs;
template <int KMASK> __global__ void __launch_bounds__(NTHREADS, 2) fwd_kernel_t(Args a0) {
    extern __shared__ __attribute__((aligned(16))) unsigned char lds_raw[];
    lds_u8* lds = (lds_u8*)lds_raw;
    const int G = gridDim.x;
    unsigned char* ws = a0.ws;
    const int ph_lo = a0.ph_lo, ph_hi = a0.ph_hi;
    const float* mod = (const float*)(ws + WS_MOD);
    const int wave_s = __builtin_amdgcn_readfirstlane((int)(threadIdx.x >> 6));
    if (wave_s == 0 && lane_id() < 16) ((LAS unsigned*)(lds + MISC_OFF))[lane_id()] = 0u;
    __syncthreads();
    XcdBarrier bar = xcd_barrier_post((unsigned*)(ws + WS_CTL) + 4096, (volatile LAS unsigned*)(lds + MISC_OFF), wave_s);
    const bool fuse_norm = MK_ONE_LAUNCH && !PROBE_DUP && (G == 256);
    for (int ph = ph_lo; ph < ph_hi; ++ph) {
        KArgs* kap = (KArgs*)__builtin_amdgcn_kernarg_segment_ptr(); asm volatile("" : "+s"(kap));
        Args a;
#pragma unroll
        for (int i_ = 0; i_ < 17; ++i_) a.in[i_] = kap->in[i_];
        a.out = kap->out; a.ws = kap->ws; a.ph_lo = ph_lo; a.ph_hi = ph_hi;
        if (fuse_norm && ph >= 2 && ((ph - 2) % 9 == 5 || (ph - 2) % 9 == 8)) continue;
        int kbit = 0;
        if (PROBE_DUP) { if (ph == 0) kbit = 1; else if (ph == 1) kbit = 2; else { const int s_ = (ph - 2) % 9; kbit = s_ == 0 ? 4 : (s_ == 4 || s_ == 7) ? 8 : s_ == 1 ? 16 : s_ == 3 ? 32 : s_ == 6 ? 64 : s_ == 2 ? 128 : 2; } }
        const int nrep = (PROBE_DUP & kbit) ? 2 : 1;
        for (int rep = 0; rep < nrep; ++rep) {
        const bool dry = (rep + 1 < nrep); if (rep) __syncthreads();
        int tid = threadIdx.x; asm volatile("" : "+v"(tid));
        int bx = blockIdx.x; asm volatile("" : "+s"(bx));
        const int vcu = (G % 8 == 0) ? (bx % 8) * (G / 8) + bx / 8 : bx;
        if (ph == 0) { if (KMASK & 1) phase_prologue(a, lds, vcu, G, tid, bx); }
        else if (ph == 1) { if (KMASK & 2) phase_norm(a.in[I_X], a.in[I_NORMG], mod, 0, (bf16_t*)(ws + WS_H), vcu, G, tid); }
        else {
            const int l = (ph - 2) / 9, s = (ph - 2) % 9;
            const float* mod_l = mod + (size_t)l * 8 * 6144;
            if ((KMASK & 4) && s == 0) {
                const pg8::Gemm g{(const bf16_t*)(ws + WS_H), (const bf16_t*)(ws + WS_WIN) + (size_t)l * INW * DM, M, INW, DM}; const pg8::EpiStore E{(bf16_t*)(ws + WS_PROJ), INW};
                pg8::StaticOrder S; S.init(g.M, g.N, G, bx);
                pg8::gemm_phase<pg8::EpiStore, pg8::StaticOrder>(lds, g, S, E, tid);
            } else if ((KMASK & 64) && s == 6) {
                const pg8::Gemm g{(const bf16_t*)(ws + WS_H), (const bf16_t*)(ws + WS_WUP) + (size_t)l * UPW * DM, M, UPW, DM};
                const pg8::EpiConvGate E{(bf16_t*)(ws + WS_ACT), a.in[I_CONVW] + (size_t)l * 3 * UPW, a.in[I_CONVB] + (size_t)l * UPW};
                pg8::StaticOrder S; S.init(g.M, g.N, G, bx, 1);
                pg8::gemm_phase<pg8::EpiConvGate, pg8::StaticOrder>(lds, g, S, E, tid);
            } else if ((KMASK & 8) && (s == 4 || s == 7)) {
                pg8::Gemm g; pg8::EpiResid E;
                const bool nfuse = fuse_norm && !dry && !(s == 7 && l == DEPTH - 1);
                if (s == 4) { g = pg8::Gemm{(const bf16_t*)(ws + WS_MIX), (const bf16_t*)(ws + WS_WOUT) + (size_t)l * DM * DM, M, DM, DM};
                    E = pg8::EpiResid{ws, l == 0 ? a.in[I_X] : nullptr, nullptr, a.in[I_NORMG], l, 0, nfuse ? 1 : 0}; }
                else { g = pg8::Gemm{(const bf16_t*)(ws + WS_ACT), (const bf16_t*)(ws + WS_WDN) + (size_t)l * DM * FF, M, DM, FF};
                    E = pg8::EpiResid{ws, nullptr, (l == DEPTH - 1) ? a.out : nullptr, a.in[I_NORMG], l, 1, nfuse ? 1 : 0}; }
                pg8::StaticOrder S; S.init(g.M, g.N, G, bx);
                pg8::gemm_phase<pg8::EpiResid, pg8::StaticOrder>(lds, g, S, E, tid);
            } else if ((KMASK & 16) && s == 1) phase_prep(a, lds, l, vcu, G, tid, dry);
            else if ((KMASK & 16) && s == 2) { phase_scan(a, vcu, G, tid); phase_mixc(a, lds, l, vcu, G, tid); }
            else if ((KMASK & 32) && s == 3) phase_mixers(a, lds, l, vcu, G, tid);
            else if ((KMASK & 2) && s == 5) phase_norm_bf((const bf16_t*)(ws + WS_XB), a.in[I_NORMG] + (size_t)(l * 2 + 1) * DM, mod_l, 3, (bf16_t*)(ws + WS_H), vcu, G, tid);
            else if ((KMASK & 2) && s == 8) phase_norm_bf((const bf16_t*)(ws + WS_XB), a.in[I_NORMG] + (size_t)((l + 1) * 2) * DM, mod_l + 8 * 6144, 0, (bf16_t*)(ws + WS_H), vcu, G, tid);
        }
        }
        if (ph + 1 < ph_hi) { if (ph == 0) { __syncthreads(); cg::this_grid().sync(); } else xcd_barrier(bar); }
    }
}

typedef void (*kern_t)(Args);
static int phase_kind(int ph) { if (ph == 0) return 0; if (ph == 1) return 1; const int s = (ph - 2) % 9; return s == 0 ? 2 : s == 4 || s == 7 ? 3 : s == 1 || s == 2 ? 4 : s == 3 ? 5 : s == 6 ? 6 : 1; }
extern "C" void kernel_launch(void* const* d_in, const int* in_sizes, int n_in, void* d_out, int out_size, void* d_ws, size_t ws_size, hipStream_t stream) {
    static int grid = 0;
#if MK_ONE_LAUNCH
    static const kern_t kerns[1] = {fwd_kernel_t<127>}; constexpr int NK = 1;
#else
    static const kern_t kerns[7] = {fwd_kernel_t<1>, fwd_kernel_t<2>, fwd_kernel_t<4>, fwd_kernel_t<8>, fwd_kernel_t<16>, fwd_kernel_t<32>, fwd_kernel_t<64>}; constexpr int NK = 7;
#endif
    if (grid == 0) {
        if (n_in != 17 || out_size != M * DM || ws_size < WS_END) { fprintf(stderr, "kernel_launch: unexpected shapes (n_in %d, out %d, ws %zu)\n", n_in, out_size, ws_size); grid = -1; return; }
        int dev = 0, cus = 0;
        if (hipGetDevice(&dev) != hipSuccess || hipDeviceGetAttribute(&cus, hipDeviceAttributeMultiprocessorCount, dev) != hipSuccess) { grid = -1; return; }
        for (int i = 0; i < NK; ++i)
            if (hipFuncSetAttribute((const void*)kerns[i], hipFuncAttributeMaxDynamicSharedMemorySize, LDS_BYTES) != hipSuccess) { fprintf(stderr, "kernel_launch: hipFuncSetAttribute failed\n"); grid = -1; return; }
        int per_cu = 0;
        if (hipOccupancyMaxActiveBlocksPerMultiprocessor(&per_cu, (const void*)kerns[0], NTHREADS, LDS_BYTES) != hipSuccess || per_cu < 1) { fprintf(stderr, "kernel_launch: occupancy query says %d\n", per_cu); (void)hipGetLastError(); }
        grid = cus;
    }
    if (grid < 0) return;
    Args a{};
    for (int i = 0; i < 17; ++i) a.in[i] = (const float*)d_in[i];
    a.out = (float*)d_out; a.ws = (unsigned char*)d_ws;
#if MK_ONE_LAUNCH
    if (hipMemsetAsync((char*)d_ws + WS_CTL, 0, 65536, stream) != hipSuccess) { fprintf(stderr, "kernel_launch: memset failed\n"); return; }
    a.ph_lo = 0; a.ph_hi = NPHASES;
    void* args[] = {&a};
    hipError_t e = hipLaunchCooperativeKernel((const void*)kerns[0], dim3(grid), dim3(NTHREADS), args, LDS_BYTES, stream);
    if (e != hipSuccess) fprintf(stderr, "cooperative launch failed: %s (grid %d)\n", hipGetErrorString(e), grid);
#else
    for (int ph = 0; ph < NPHASES; ++ph) {
        a.ph_lo = ph; a.ph_hi = ph + 1;
        hipLaunchKernelGGL(kerns[phase_kind(ph)], dim3(grid), dim3(NTHREADS), LDS_BYTES, stream, a);
    }
#endif
}
```

```cpp
#include <hip/hip_runtime.h>
#include <hip/hip_cooperative_groups.h>
#include <cstdio>
#include <cstdint>
namespace cg = cooperative_groups;

#ifndef PROBE_DUP
#define PROBE_DUP 0
#endif
#ifndef MK_ONE_LAUNCH
#define MK_ONE_LAUNCH 1
#endif

#define LAS __attribute__((address_space(3)))
typedef unsigned short bf16_t;
typedef short bf16x8 __attribute__((ext_vector_type(8)));
typedef float f32x4 __attribute__((ext_vector_type(4)));
typedef float f32x16 __attribute__((ext_vector_type(16)));
typedef unsigned u32x4 __attribute__((ext_vector_type(4)));
typedef unsigned u32x2 __attribute__((ext_vector_type(2)));
typedef LAS unsigned char lds_u8;

constexpr int NB = 8, SEQ = 2048, DM = 1024, M = NB * SEQ, DEPTH = 4, INW = 2560, FF = 2816, UPW = 2 * FF;
constexpr float EPS = 1e-6f;
constexpr int C_AQ = 0, C_AK = 384, C_AV = 512, C_BQ = 640, C_BFF = 896, C_BFB = 1152, C_BI = 1408, C_BG = 1664, C_CQ = 1920, C_CK = 2304, C_CV = 2432;

constexpr size_t MiB = 1u << 20;
constexpr size_t WS_CTL = 0;
constexpr size_t WS_MOD = 1 * MiB;
constexpr size_t WS_ROPE = 2 * MiB;
constexpr size_t WS_WIN = 4 * MiB;
constexpr size_t WS_WOUT = 24 * MiB;
constexpr size_t WS_WUP = 32 * MiB;
constexpr size_t WS_WDN = 76 * MiB;
constexpr size_t WS_H = 98 * MiB;
constexpr size_t WS_PROJ = 130 * MiB;
constexpr size_t WS_MIX = 210 * MiB;
constexpr size_t WS_HL = 242 * MiB;
constexpr size_t WS_HD = 274 * MiB;
constexpr size_t WS_VT = 275 * MiB;
constexpr size_t WS_ACT = 190 * MiB;
constexpr size_t WS_HS = 283 * MiB;
constexpr size_t WS_PO = 300 * MiB;
constexpr size_t WS_PL = 326 * MiB;
constexpr size_t WS_XB = 332 * MiB;
constexpr size_t WS_U = 330 * MiB;
constexpr size_t WS_END = 366 * MiB;

constexpr int LDS_BYTES = 147456;
constexpr int NTHREADS = 512;

typedef float f32x2_t __attribute__((ext_vector_type(2))); typedef __bf16 bf16x2_t __attribute__((ext_vector_type(2)));
__device__ __forceinline__ unsigned pk2(float lo, float hi) { f32x2_t v = {lo, hi}; bf16x2_t b = __builtin_convertvector(v, bf16x2_t); return __builtin_bit_cast(unsigned, b); }
__device__ __forceinline__ unsigned f2bf(float f) { return pk2(f, 0.f) & 0xffffu; }
__device__ __forceinline__ float bf2f(unsigned short h) { return __builtin_bit_cast(float, (unsigned)h << 16); }
__device__ __forceinline__ float bflo(unsigned w) { return __builtin_bit_cast(float, w << 16); }
__device__ __forceinline__ float bfhi(unsigned w) { return __builtin_bit_cast(float, w & 0xffff0000u); }
__device__ __forceinline__ float wave_sum(float v) {
#pragma unroll
    for (int o = 1; o < 64; o <<= 1) v += __shfl_xor(v, o);
    return v;
}
__device__ __forceinline__ float fast_exp2(float x) { return __builtin_amdgcn_exp2f(x); }
__device__ __forceinline__ float fast_exp(float x) { return __builtin_amdgcn_exp2f(x * 1.4426950408889634f); }
__device__ __forceinline__ float silu_f(float x) { return x * __builtin_amdgcn_rcpf(1.0f + fast_exp2(-1.4426950408889634f * x)); }

__device__ __forceinline__ float dpp_ror1(float v) { return __builtin_bit_cast(float, __builtin_amdgcn_update_dpp(0, __builtin_bit_cast(int, v), 0x121, 0xf, 0xf, true)); }
__device__ __forceinline__ float dpp_ror15(float v) { return __builtin_bit_cast(float, __builtin_amdgcn_update_dpp(0, __builtin_bit_cast(int, v), 0x12f, 0xf, 0xf, true)); }
__device__ __forceinline__ float dpp_shr1(float old, float v) { return __builtin_bit_cast(float, __builtin_amdgcn_update_dpp(__builtin_bit_cast(int, old), __builtin_bit_cast(int, v), 0x111, 0xf, 0xf, false)); }
__device__ __forceinline__ float dpp_shl1(float old, float v) { return __builtin_bit_cast(float, __builtin_amdgcn_update_dpp(__builtin_bit_cast(int, old), __builtin_bit_cast(int, v), 0x101, 0xf, 0xf, false)); }

namespace pg8 {
constexpr int BM = 256, BK = 64, HALF = 128, HTB = HALF * BK * 2, STAGE_BYTES = 8 * HTB, NXCD = 8, WGM = 8;
__host__ __device__ __forceinline__ int lds_byte(int r, int c) { const int st = (r >> 4) * 2 + (c >> 5), rr = r & 15, cc = c & 31, ob = rr * 64 + cc * 2; return st * 1024 + (ob ^ (((ob >> 9) & 1) << 5)); }
__host__ __device__ __forceinline__ void stage_rc(int b, int& R, int& C) { const int st = b / 1024, sb = b % 1024, swz = sb ^ (((sb >> 9) & 1) << 5); R = (st >> 1) * 16 + swz / 64; C = (st & 1) * 32 + (swz % 64) / 2; }
__host__ __device__ __forceinline__ int perm32(int rho) { const int n = rho >> 4, i = rho & 15; return 8 * (i >> 2) + 4 * n + (i & 3); }

struct Unit { int pm, pn, ar; };
struct Gemm { const bf16_t* A; const bf16_t* Bt; int M, N, K; };

struct StaticOrder {
    int nM, nN, nwg, G, c, conv, Mrows;
    __host__ __device__ void init(int M_, int N_, int G_, int c_, int conv_ = 0) { conv = conv_; Mrows = M_; nM = conv_ ? (M_ + 253) / 254 : M_ / BM; nN = N_ / BM; nwg = nM * nN; G = G_; c = c_; }
    __host__ __device__ bool next(int i, Unit& u) const {
        const long L = (long)i * G + c; if (L >= nwg) return false;
        int wgid = (int)L; { const int q = nwg / NXCD, r = nwg % NXCD, xcd = wgid % NXCD, off = wgid / NXCD; wgid = (xcd < r ? xcd * (q + 1) : r * (q + 1) + (xcd - r) * q) + off; }
        const int nig = WGM * nN, gid = wgid / nig, fm = gid * WGM, gsz = (nM - fm) < WGM ? (nM - fm) : WGM;
        u.pm = fm + ((wgid % nig) % gsz); u.pn = (wgid % nig) / gsz;
        if (conv) { int s = 254 * u.pm - 1; s = s < 0 ? 0 : s; u.ar = s > Mrows - BM ? Mrows - BM : s; } else u.ar = u.pm * BM;
        return true;
    }
};

struct EpiStore {
    static constexpr bool PERM = true;
    bf16_t* O; int ldc;
    __device__ __forceinline__ void operator()(const f32x4 (&acc)[2][2][4][2], const Unit& u, int wr, int wc, int fr, int fq, lds_u8*) const {
        const int row0 = u.pm * BM + wr * 64 + fr, col0 = u.pn * BM + wc * 32 + 8 * fq;
#pragma unroll
        for (int ai = 0; ai < 2; ++ai)
#pragma unroll
            for (int m = 0; m < 4; ++m) { bf16_t* rowp = O + (size_t)(row0 + ai * HALF + m * 16) * ldc + col0;
#pragma unroll
                for (int bj = 0; bj < 2; ++bj) { const f32x4 v0 = acc[ai][bj][m][0], v1 = acc[ai][bj][m][1];
                    u32x4 w; w.x = pk2(v0[0], v0[1]); w.y = pk2(v0[2], v0[3]); w.z = pk2(v1[0], v1[1]); w.w = pk2(v1[2], v1[3]);
                    *(u32x4*)(rowp + bj * HALF) = w; } }
    }
};
struct EpiResid {
    static constexpr bool PERM = true;
    unsigned char* ws; const float* xin32; float* out32; const float* normg;
    int l, second, nfuse;
    __device__ __forceinline__ void operator()(f32x4 (&acc)[2][2][4][2], const Unit& u, int wr, int wc, int fr, int fq, lds_u8* lds) const {
        const int col0 = u.pn * BM + wc * 32 + 8 * fq;
        const int bidx = (u.pm * BM) / SEQ;
        bf16_t* const xb16 = (bf16_t*)(ws + WS_XB);
        const float* const modl = (const float*)(ws + WS_MOD) + (size_t)l * 8 * 6144;
        const float* const gate = modl + (second ? 5 : 2) * DM;
        const float* const ng = normg + (size_t)(second ? (l + 1) * 2 : l * 2 + 1) * DM;
        const float* const nmod = second ? modl + 8 * 6144 : modl + 3 * DM;
        const int nidx = nfuse ? l * 2 + second : -1;
        const float* gb = gate + (size_t)bidx * 6144 + col0;
        f32x4 gv[2][2];
#pragma unroll
        for (int bj = 0; bj < 2; ++bj)
#pragma unroll
            for (int n = 0; n < 2; ++n) gv[bj][n] = *(const f32x4*)(gb + bj * HALF + 4 * n);
#pragma unroll
        for (int ai = 0; ai < 2; ++ai)
#pragma unroll
            for (int m = 0; m < 4; ++m) { const size_t off = (size_t)(u.pm * BM + ai * HALF + wr * 64 + m * 16 + fr) * DM + col0;
#pragma unroll
                for (int bj = 0; bj < 2; ++bj) {
                    f32x4 x0, x1;
                    if (xin32) { x0 = *(const f32x4*)(xin32 + off + bj * HALF); x1 = *(const f32x4*)(xin32 + off + bj * HALF + 4); }
                    else { const u32x4 w = *(const u32x4*)(xb16 + off + bj * HALF); x0 = (f32x4){bflo(w.x), bfhi(w.x), bflo(w.y), bfhi(w.y)}; x1 = (f32x4){bflo(w.z), bfhi(w.z), bflo(w.w), bfhi(w.w)}; }
                    const f32x4 y0 = x0 + gv[bj][0] * acc[ai][bj][m][0], y1 = x1 + gv[bj][1] * acc[ai][bj][m][1];
                    acc[ai][bj][m][0] = y0; acc[ai][bj][m][1] = y1;
                    if (out32) { __builtin_nontemporal_store(y0, (f32x4*)(out32 + off + bj * HALF)); __builtin_nontemporal_store(y1, (f32x4*)(out32 + off + bj * HALF + 4)); }
                    else { u32x4 w; w.x = pk2(y0[0], y0[1]); w.y = pk2(y0[2], y0[3]); w.z = pk2(y1[0], y1[1]); w.w = pk2(y1[2], y1[3]); *(u32x4*)(xb16 + off + bj * HALF) = w; }
                } }
        if (nidx < 0) return;
        asm volatile("" : "+v"(fr), "+v"(fq));
        bf16_t* const hn = (bf16_t*)(ws + WS_H); float* const slots = (float*)(ws + WS_CTL + 512 * 1024); unsigned* const cnt = (unsigned*)(ws + WS_CTL) + 8192 + nidx * 1024;
        LAS float* P = (LAS float*)(lds + STAGE_BYTES);
        LAS float* S = P + 1024;
#pragma unroll
        for (int ai = 0; ai < 2; ++ai)
#pragma unroll
            for (int m = 0; m < 4; ++m) { float s = 0.f;
#pragma unroll
                for (int bj = 0; bj < 2; ++bj)
#pragma unroll
                    for (int n = 0; n < 2; ++n) { const f32x4 v = acc[ai][bj][m][n]; s += (v[0] * v[0] + v[1] * v[1]) + (v[2] * v[2] + v[3] * v[3]); }
                s += __shfl_xor(s, 16); s += __shfl_xor(s, 32);
                if (fq == 0) P[(ai * HALF + wr * 64 + m * 16 + fr) * 4 + wc] = s; }
        asm volatile("s_waitcnt lgkmcnt(0)" ::: "memory"); __builtin_amdgcn_s_barrier(); asm volatile("" ::: "memory");
        const int tid = (wr * 4 + wc) * 64 + fr + 16 * fq;
        unsigned* slot_u = (unsigned*)slots + ((size_t)u.pm * BM) * 4;
        if (tid < 256) { const float t = (P[tid * 4] + P[tid * 4 + 1]) + (P[tid * 4 + 2] + P[tid * 4 + 3]);
            __hip_atomic_store(slot_u + tid * 4 + u.pn, __builtin_bit_cast(unsigned, t), __ATOMIC_RELAXED, __HIP_MEMORY_SCOPE_AGENT); }
        asm volatile("s_waitcnt vmcnt(0)" ::: "memory"); __builtin_amdgcn_s_barrier(); asm volatile("" ::: "memory");
        if (tid == 0) {
            unsigned* c = cnt + u.pm * 16;
            __builtin_amdgcn_fence(__ATOMIC_RELEASE, "agent");
            asm volatile("s_waitcnt vmcnt(0)" ::: "memory");
            (void)__hip_atomic_fetch_add(c, 1u, __ATOMIC_RELAXED, __HIP_MEMORY_SCOPE_AGENT);
            unsigned sp = 0u;
            while (__hip_atomic_load(c, __ATOMIC_RELAXED, __HIP_MEMORY_SCOPE_AGENT) < 4u) { __builtin_amdgcn_s_sleep(1); if (++sp > (1u << 22)) break; }
            __builtin_amdgcn_fence(__ATOMIC_ACQUIRE, "agent");
            asm volatile("s_waitcnt vmcnt(0)" ::: "memory");
        }
        __builtin_amdgcn_s_barrier(); asm volatile("" ::: "memory");
        if (tid < 256) { float t = 0.f;
#pragma unroll
            for (int p = 0; p < 4; ++p) t += __builtin_bit_cast(float, __hip_atomic_load(slot_u + tid * 4 + p, __ATOMIC_RELAXED, __HIP_MEMORY_SCOPE_AGENT));
            S[tid] = rsqrtf(t * (1.f / DM) + EPS); }
        asm volatile("s_waitcnt lgkmcnt(0)" ::: "memory"); __builtin_amdgcn_s_barrier(); asm volatile("" ::: "memory");
        const float* shp = nmod + (size_t)bidx * 6144 + col0; const float* scp = shp + DM; const float* gp = ng + col0;
#pragma unroll
        for (int bj = 0; bj < 2; ++bj)
#pragma unroll
            for (int n = 0; n < 2; ++n) {
                const f32x4 gn = *(const f32x4*)(gp + bj * HALF + 4 * n) * (*(const f32x4*)(scp + bj * HALF + 4 * n) + 1.0f), sn = *(const f32x4*)(shp + bj * HALF + 4 * n);
#pragma unroll
                for (int ai = 0; ai < 2; ++ai)
#pragma unroll
                    for (int m = 0; m < 4; ++m) { const int rl = ai * HALF + wr * 64 + m * 16 + fr; const float rstd = S[rl];
                        const f32x4 h0 = acc[ai][bj][m][n] * rstd * gn + sn;
                        u32x2 w; w.x = pk2(h0[0], h0[1]); w.y = pk2(h0[2], h0[3]);
                        *(u32x2*)(hn + (size_t)(u.pm * BM + rl) * DM + col0 + bj * HALF + 4 * n) = w; }
            }
    }
};

struct EpiConvGate {
    static constexpr bool PERM = true;
    bf16_t* act; const float* cw; const float* cb;
    __device__ __forceinline__ void operator()(const f32x4 (&acc)[2][2][4][2], const Unit& u, int wr, int wc, int fr, int fq, lds_u8* lds) const {
        LAS float* xch = (LAS float*)(lds + STAGE_BYTES);
        int colw = wc * 32 + 8 * fq; asm volatile("" : "+v"(colw));
#pragma unroll
        for (int ai = 0; ai < 2; ++ai) { const int rho = 2 * ai + wr;
#pragma unroll
            for (int bj = 0; bj < 2; ++bj)
#pragma unroll
                for (int n = 0; n < 2; ++n) {
                    if (fr == 0) *(LAS f32x4*)(xch + (rho * 2) * 256 + bj * 128 + colw + 4 * n) = acc[ai][bj][0][n];
                    if (fr == 15) *(LAS f32x4*)(xch + (rho * 2 + 1) * 256 + bj * 128 + colw + 4 * n) = acc[ai][bj][3][n]; } }
        asm volatile("s_waitcnt lgkmcnt(0)" ::: "memory"); __builtin_amdgcn_s_barrier(); asm volatile("" ::: "memory");
        const int jcol = u.pn * 128 + colw;
        const int olo = 254 * u.pm, ohi = (olo + 254 < M) ? olo + 254 : M;
#pragma unroll
        for (int n = 0; n < 2; ++n) {
            const int ja = jcol + 4 * n, jb = FF + ja;
            const f32x4 wa0 = *(const f32x4*)(cw + ja), wa1 = *(const f32x4*)(cw + UPW + ja), wa2 = *(const f32x4*)(cw + 2 * UPW + ja), ba = *(const f32x4*)(cb + ja);
            const f32x4 wb0 = *(const f32x4*)(cw + jb), wb1 = *(const f32x4*)(cw + UPW + jb), wb2 = *(const f32x4*)(cw + 2 * UPW + jb), bb = *(const f32x4*)(cb + jb);
#pragma unroll
            for (int ai = 0; ai < 2; ++ai) {
                const int rho = 2 * ai + wr;
                const f32x4 z4 = (f32x4){0.f, 0.f, 0.f, 0.f};
#pragma unroll
                for (int m = 0; m < 4; ++m) {
                    f32x4 Xa = z4, Xb = z4, Ya = z4, Yb = z4;
                    if (m == 0 && rho > 0) { Xa = *(const LAS f32x4*)(xch + ((rho - 1) * 2 + 1) * 256 + colw + 4 * n); Xb = *(const LAS f32x4*)(xch + ((rho - 1) * 2 + 1) * 256 + 128 + colw + 4 * n); }
                    if (m == 3 && rho < 3) { Ya = *(const LAS f32x4*)(xch + ((rho + 1) * 2) * 256 + colw + 4 * n); Yb = *(const LAS f32x4*)(xch + ((rho + 1) * 2) * 256 + 128 + colw + 4 * n); }
                    const int gr = u.ar + ai * HALF + wr * 64 + m * 16 + fr;
                    const int t = gr & (SEQ - 1);
                    const bool hasp = t != 0, hasn = t != SEQ - 1;
                    const f32x4 va = acc[ai][0][m][n], vb = acc[ai][1][m][n];
                    f32x4 pa, pb, na, nb;
#pragma unroll
                    for (int j = 0; j < 4; ++j) {
                        pa[j] = dpp_shr1(m > 0 ? dpp_ror1(acc[ai][0][m > 0 ? m - 1 : 0][n][j]) : Xa[j], va[j]);
                        pb[j] = dpp_shr1(m > 0 ? dpp_ror1(acc[ai][1][m > 0 ? m - 1 : 0][n][j]) : Xb[j], vb[j]);
                        na[j] = dpp_shl1(m < 3 ? dpp_ror15(acc[ai][0][m < 3 ? m + 1 : 3][n][j]) : Ya[j], va[j]);
                        nb[j] = dpp_shl1(m < 3 ? dpp_ror15(acc[ai][1][m < 3 ? m + 1 : 3][n][j]) : Yb[j], vb[j]);
                    }
                    const float fp = hasp ? 1.0f : 0.0f, fn = hasn ? 1.0f : 0.0f;
                    const f32x4 ca = ba + (wa0 * fp) * pa + wa1 * va + (wa2 * fn) * na;
                    const f32x4 cbv = bb + (wb0 * fp) * pb + wb1 * vb + (wb2 * fn) * nb;
                    const f32x4 ex = ca * -1.4426950408889634f;
                    f32x4 sg;
#pragma unroll
                    for (int j = 0; j < 4; ++j) sg[j] = __builtin_amdgcn_rcpf(1.0f + fast_exp2(ex[j]));
                    const f32x4 r = ca * sg * cbv;
                    if (gr >= olo && gr < ohi) { u32x2 w; w.x = pk2(r[0], r[1]); w.y = pk2(r[2], r[3]); *(u32x2*)(act + (size_t)gr * FF + ja) = w; }
                }
            }
        }
    }
};

template <class Epi, class Sched>
__device__ __forceinline__ void gemm_phase(lds_u8* lds, const Gemm g, const Sched& S, const Epi& E, const int tid) {
    const int wid = __builtin_amdgcn_readfirstlane(tid >> 6), lane = tid & 63, wr = wid >> 2, wc = wid & 3, fr = lane & 15, fq = lane >> 4;
    const int K = g.K, nt = K / BK;
    unsigned voffA[2], voffB[2];
#pragma unroll
    for (int i = 0; i < 2; ++i) { int R, C; stage_rc(tid * 16 + i * 8192, R, C); const int Rb = Epi::PERM ? ((R & ~31) + perm32(R & 31)) : R;
        voffA[i] = (unsigned)(R * K + C) * 2u; voffB[i] = (unsigned)(Rb * K + C) * 2u; }
    const size_t kstep = (size_t)(BK * 2);
    const size_t hstep = (size_t)HALF * K * 2;
    const size_t tstep = 2 * hstep;
    const unsigned ldsw = (unsigned)wid * 1024u;
    const int aoff = lds_byte(wr * 64 + fr, fq * 8), boff = lds_byte(wc * 32 + fr, fq * 8);
#define PG8_SA(b, h) (((b) * 2 + (h)) * HTB)
#define PG8_SB(b, h) ((4 + (b) * 2 + (h)) * HTB)
#define PG8_STAGE(bufoff, gbase, voff) do { _Pragma("unroll") for (int _i = 0; _i < 2; ++_i) \
        __builtin_amdgcn_global_load_lds((const unsigned*)((const char*)(gbase) + (voff)[_i]), (LAS unsigned*)(lds + (bufoff) + ldsw + _i * 8192), 16, 0, 0); } while (0)
#define PG8_LDA(dst, b, h) do { _Pragma("unroll") for (int m = 0; m < 4; ++m) _Pragma("unroll") for (int k = 0; k < 2; ++k) dst[m][k] = *(const LAS bf16x8*)(lds + PG8_SA(b, h) + aoff + m * 2048 + k * 1024); } while (0)
#define PG8_LDB(dst, b, h) do { _Pragma("unroll") for (int n = 0; n < 2; ++n) _Pragma("unroll") for (int k = 0; k < 2; ++k) dst[n][k] = *(const LAS bf16x8*)(lds + PG8_SB(b, h) + boff + n * 2048 + k * 1024); } while (0)
#define PG8_MMA(ai, bj, At, Bt) do { __builtin_amdgcn_s_setprio(1); _Pragma("unroll") for (int m = 0; m < 4; ++m) _Pragma("unroll") for (int n = 0; n < 2; ++n) _Pragma("unroll") for (int k = 0; k < 2; ++k) \
        acc[ai][bj][m][n] = __builtin_amdgcn_mfma_f32_16x16x32_bf16(Bt[n][k], At[m][k], acc[ai][bj][m][n], 0, 0, 0); __builtin_amdgcn_s_setprio(0); } while (0)
#define PG8_WAIT_V(n) asm volatile("s_waitcnt vmcnt(" #n ")" ::: "memory")
#define PG8_WAIT_L(n) asm volatile("s_waitcnt lgkmcnt(" #n ")" ::: "memory")
#define PG8_BAR __builtin_amdgcn_s_barrier()
#define PG8_SCHED __builtin_amdgcn_sched_barrier(0)
    Unit cur, nxt; int ui = 0;
    if (!S.next(0, cur)) return;
    f32x4 acc[2][2][4][2];
#pragma unroll
    for (int a = 0; a < 2; ++a)
#pragma unroll
        for (int b = 0; b < 2; ++b)
#pragma unroll
            for (int m = 0; m < 4; ++m)
#pragma unroll
                for (int n = 0; n < 2; ++n) acc[a][b][m][n] = (f32x4){0.f, 0.f, 0.f, 0.f};
    bf16x8 At[4][2], B0[2][2], B1[2][2];
    const char* cA = (const char*)g.A + (size_t)cur.ar * (size_t)(K * 2); const char* cB = (const char*)g.Bt + (size_t)cur.pn * tstep;
    PG8_STAGE(PG8_SB(0, 0), cB, voffB); PG8_STAGE(PG8_SB(0, 1), cB + hstep, voffB); PG8_STAGE(PG8_SA(0, 0), cA, voffA); PG8_STAGE(PG8_SA(0, 1), cA + hstep, voffA);
    if (wr == 1) PG8_BAR;
    PG8_WAIT_V(2); PG8_BAR;
    PG8_STAGE(PG8_SB(1, 0), cB + kstep, voffB); PG8_STAGE(PG8_SA(1, 0), cA + kstep, voffA); PG8_STAGE(PG8_SB(1, 1), cB + hstep + kstep, voffB);
    PG8_WAIT_V(6); PG8_BAR;
    for (;;) {
        const bool has_next = S.next(ui + 1, nxt);
        const char* nA = has_next ? (const char*)g.A + (size_t)nxt.ar * (size_t)(K * 2) : cA; const char* nB = has_next ? (const char*)g.Bt + (size_t)nxt.pn * tstep : cB;
        for (int t = 0; t < nt; t += 2) {
            const bool last = (t == nt - 2);
            const char* a1 = cA + (size_t)(t + 1) * kstep;
            const char* a2 = last ? nA : cA + (size_t)(t + 2) * kstep; const char* b2 = last ? nB : cB + (size_t)(t + 2) * kstep;
            const char* a3 = a2 + kstep; const char* b3 = b2 + kstep;
            PG8_LDB(B0, 0, 0); PG8_LDB(B1, 0, 1); PG8_SCHED; PG8_LDA(At, 0, 0); PG8_STAGE(PG8_SA(1, 1), a1 + hstep, voffA);
            PG8_WAIT_V(8); PG8_WAIT_L(0); PG8_BAR; PG8_MMA(0, 0, At, B0); PG8_MMA(0, 1, At, B1); PG8_BAR; PG8_SCHED;
            PG8_LDA(At, 0, 1); PG8_STAGE(PG8_SB(0, 0), b2, voffB); PG8_STAGE(PG8_SB(0, 1), b2 + hstep, voffB); PG8_STAGE(PG8_SA(0, 0), a2, voffA);
            PG8_WAIT_V(8); PG8_WAIT_L(0); PG8_BAR; PG8_MMA(1, 0, At, B0); PG8_MMA(1, 1, At, B1); PG8_BAR; PG8_SCHED;
            PG8_LDB(B0, 1, 0); PG8_LDB(B1, 1, 1); PG8_SCHED; PG8_LDA(At, 1, 0); PG8_STAGE(PG8_SA(0, 1), a2 + hstep, voffA);
            PG8_WAIT_V(8); PG8_WAIT_L(0); PG8_BAR; PG8_MMA(0, 0, At, B0); PG8_MMA(0, 1, At, B1); PG8_BAR; PG8_SCHED;
            PG8_LDA(At, 1, 1); PG8_STAGE(PG8_SB(1, 0), b3, voffB); PG8_STAGE(PG8_SB(1, 1), b3 + hstep, voffB); PG8_STAGE(PG8_SA(1, 0), a3, voffA);
            PG8_WAIT_V(8); PG8_WAIT_L(0); PG8_BAR; PG8_MMA(1, 0, At, B0); PG8_MMA(1, 1, At, B1); PG8_BAR; PG8_SCHED;
        }
        if (wr == 0) PG8_BAR;
        E(acc, cur, wr, wc, fr, fq, lds);
        if (!has_next) break;
#pragma unroll
        for (int a = 0; a < 2; ++a)
#pragma unroll
            for (int b = 0; b < 2; ++b)
#pragma unroll
                for (int m = 0; m < 4; ++m)
#pragma unroll
                    for (int n = 0; n < 2; ++n) acc[a][b][m][n] = (f32x4){0.f, 0.f, 0.f, 0.f};
        cur = nxt; cA = nA; cB = nB; ++ui;
        if (wr == 1) PG8_BAR;
    }
    PG8_WAIT_V(0);
    PG8_BAR;
#undef PG8_SA
#undef PG8_SB
#undef PG8_STAGE
#undef PG8_LDA
#undef PG8_LDB
#undef PG8_MMA
#undef PG8_WAIT_V
#undef PG8_WAIT_L
#undef PG8_BAR
#undef PG8_SCHED
}
}

struct Args {
    const float* in[17];
    float* out; unsigned char* ws;
    int ph_lo, ph_hi;
};
enum { I_X = 0, I_C, I_WADA, I_BADA, I_NORMG, I_WIN, I_AQN, I_AKN, I_BLB, I_BON, I_CQN, I_CKN, I_WOUT, I_WUP, I_CONVW, I_CONVB, I_WDOWN };

__device__ __forceinline__ void p0_transpose_item(const float* W, int K, int N, bf16_t* WT, int mode, LAS float* scr, int item, int lane) {
    const int nblk = N / 32, kb = item / nblk, nb = item % nblk, k0 = 64 * kb, n0 = 32 * nb;
    int rbase = n0;
    if (mode == 1) { const int isb = n0 / FF, j0 = n0 % FF; rbase = 256 * (j0 / 128) + (j0 % 128) + 128 * isb; }
    { float tmp[32];
#pragma unroll
      for (int i = 0; i < 32; ++i) { const int kk = 2 * i + (lane >> 5); tmp[i] = __builtin_nontemporal_load(&W[(size_t)(k0 + kk) * N + n0 + (lane & 31)]); }
#pragma unroll
      for (int i = 0; i < 32; ++i) { const int kk = 2 * i + (lane >> 5); scr[kk * 33 + (lane & 31)] = tmp[i]; } }
    asm volatile("s_waitcnt lgkmcnt(0)" ::: "memory");
    const int c = lane & 7;
#pragma unroll
    for (int j = 0; j < 4; ++j) { const int n = (lane >> 3) + 8 * j; const LAS float* s = scr + (8 * c) * 33 + n;
        u32x4 o; o.x = pk2(s[0 * 33], s[1 * 33]); o.y = pk2(s[2 * 33], s[3 * 33]); o.z = pk2(s[4 * 33], s[5 * 33]); o.w = pk2(s[6 * 33], s[7 * 33]);
        *(u32x4*)(WT + (size_t)(rbase + n) * K + k0 + 8 * c) = o; }
    asm volatile("s_waitcnt lgkmcnt(0)" ::: "memory");
}

__device__ __forceinline__ void phase_prologue(const Args& a, lds_u8* lds, int vcu, int G, const int tid, const int bx) {
    const int lane = tid & 63, wave = tid >> 6;
    unsigned char* ws = a.ws;
    if (bx == 0) {
        float* tb = (float*)(ws + WS_ROPE);
        for (int e = tid; e < 1024; e += NTHREADS) { const int pos = e >> 4, i = e & 15; const float inv = exp2f(-(float)i * (13.287712379549449f / 16.0f)); const float ang = (float)pos * inv;
            tb[2 * e] = cosf(ang); tb[2 * e + 1] = sinf(ang); }
    }
    {
        LAS float* sc = (LAS float*)(lds + 0);
        LAS float* red = (LAS float*)(lds + 32768);
        bool have = false;
        for (int it = vcu; it < DEPTH * 96; it += G) {
            if (!have) { const float* c = a.in[I_C];
                for (int e = tid; e < NB * DM; e += NTHREADS) { const int b = e >> 10, k = e & 1023; sc[k * 8 + b] = silu_f(c[e]); }
                have = true; __syncthreads(); }
            const int l = it / 96, n0 = 64 * (it % 96);
            const float* wp = a.in[I_WADA] + ((size_t)l * DM + 128 * wave) * 6144 + n0 + lane;
            float acc[8];
#pragma unroll
            for (int b = 0; b < 8; ++b) acc[b] = 0.f;
#pragma unroll 32
            for (int kk = 0; kk < 128; ++kk) { const float wv = __builtin_nontemporal_load(&wp[(size_t)kk * 6144]); const LAS f32x4* s4 = (const LAS f32x4*)(sc + (128 * wave + kk) * 8); const f32x4 s0 = s4[0], s1 = s4[1];
                acc[0] += s0[0] * wv; acc[1] += s0[1] * wv; acc[2] += s0[2] * wv; acc[3] += s0[3] * wv; acc[4] += s1[0] * wv; acc[5] += s1[1] * wv; acc[6] += s1[2] * wv; acc[7] += s1[3] * wv; }
#pragma unroll
            for (int b = 0; b < 8; ++b) red[(wave * 8 + b) * 64 + lane] = acc[b];
            __syncthreads();
            { const int b = tid >> 6, col = tid & 63; float s = 0.f;
#pragma unroll
              for (int w = 0; w < 8; ++w) s += red[(w * 8 + b) * 64 + col];
              ((float*)(ws + WS_MOD))[((size_t)l * 8 + b) * 6144 + n0 + col] = s + a.in[I_BADA][(size_t)l * 6144 + n0 + col]; }
            __syncthreads();
        }
        __syncthreads();
    }
    {
        LAS float* scr = (LAS float*)(lds + wave * 8448);
        const int gw = vcu * 8 + wave, NGW = G * 8;
        constexpr int I_IN = 16 * (INW / 32), I_OUT = 16 * (DM / 32), I_UP = 16 * (UPW / 32), I_DN = (FF / 64) * (DM / 32), I_LAYER = I_IN + I_OUT + I_UP + I_DN;
        const int nheavy = (DEPTH * 96 > G && DEPTH * 96 < 2 * G) ? DEPTH * 96 - G : 0, nlight = G - nheavy;
        const int npre = nheavy ? 3 * nlight * 8 : 0;
        for (int pass = 0; pass < 2; ++pass) {
            int it0, ie, st;
            if (pass == 0) { if (!nheavy || vcu < nheavy) continue; it0 = (vcu - nheavy) * 8 + wave; ie = npre; st = nlight * 8; }
            else { it0 = npre + gw; ie = DEPTH * I_LAYER; st = NGW; }
            for (int it = it0; it < ie; it += st) {
                const int l = it / I_LAYER; int r = it % I_LAYER;
                if (r < I_IN) { p0_transpose_item(a.in[I_WIN] + (size_t)l * DM * INW, DM, INW, (bf16_t*)(ws + WS_WIN) + (size_t)l * INW * DM, 0, scr, r, lane); continue; } r -= I_IN;
                if (r < I_OUT) { p0_transpose_item(a.in[I_WOUT] + (size_t)l * DM * DM, DM, DM, (bf16_t*)(ws + WS_WOUT) + (size_t)l * DM * DM, 0, scr, r, lane); continue; } r -= I_OUT;
                if (r < I_UP) { p0_transpose_item(a.in[I_WUP] + (size_t)l * DM * UPW, DM, UPW, (bf16_t*)(ws + WS_WUP) + (size_t)l * UPW * DM, 1, scr, r, lane); continue; } r -= I_UP;
                p0_transpose_item(a.in[I_WDOWN] + (size_t)l * FF * DM, FF, DM, (bf16_t*)(ws + WS_WDN) + (size_t)l * DM * FF, 0, scr, r, lane);
            }
        }
    }
}

__device__ __forceinline__ void norm_rows4(const float* x, const float* g, const float* mod_l  , int which_sh, bf16_t* h, int m0, int lane) {
    const int b = m0 / SEQ;
    const f32x4* gr = (const f32x4*)g + lane;
    const f32x4* shr = (const f32x4*)(mod_l + (size_t)b * 6144 + which_sh * DM) + lane;
    const f32x4* scr = (const f32x4*)(mod_l + (size_t)b * 6144 + (which_sh + 1) * DM) + lane;
    f32x4 v[4][4];
#pragma unroll
    for (int r = 0; r < 4; ++r) { const f32x4* xr = (const f32x4*)(x + (size_t)(m0 + r) * DM) + lane;
#pragma unroll
        for (int j = 0; j < 4; ++j) v[r][j] = xr[64 * j]; }
    f32x4 gs[4], sh[4];
#pragma unroll
    for (int j = 0; j < 4; ++j) { gs[j] = gr[64 * j] * (scr[64 * j] + 1.0f); sh[j] = shr[64 * j]; }
#pragma unroll
    for (int r = 0; r < 4; ++r) {
        float s = 0.f;
#pragma unroll
        for (int j = 0; j < 4; ++j) s += (v[r][j].x * v[r][j].x + v[r][j].y * v[r][j].y) + (v[r][j].z * v[r][j].z + v[r][j].w * v[r][j].w);
        const float rstd = rsqrtf(wave_sum(s) * (1.f / DM) + EPS);
        u32x2* o8 = (u32x2*)(h + (size_t)(m0 + r) * DM) + lane;
#pragma unroll
        for (int j = 0; j < 4; ++j) { const f32x4 y = v[r][j] * rstd * gs[j] + sh[j];
            u32x2 w; w.x = pk2(y.x, y.y); w.y = pk2(y.z, y.w); o8[64 * j] = w; }
    }
}
__device__ __forceinline__ void norm_rows4_bf(const bf16_t* x, const float* g, const float* mod_l  , int which_sh, bf16_t* h, int m0, int lane) {
    const int b = m0 / SEQ;
    const float* shp = mod_l + (size_t)b * 6144 + which_sh * DM; const float* scp = shp + DM;
    u32x4 raw[4][2];
#pragma unroll
    for (int r = 0; r < 4; ++r) { const u32x4* xr = (const u32x4*)(x + (size_t)(m0 + r) * DM) + lane; raw[r][0] = xr[0]; raw[r][1] = xr[64]; }
    f32x4 gs[2][2], sh[2][2];
#pragma unroll
    for (int c = 0; c < 2; ++c)
#pragma unroll
        for (int q = 0; q < 2; ++q) { const int col = 512 * c + 8 * lane + 4 * q; gs[c][q] = *(const f32x4*)(g + col) * (*(const f32x4*)(scp + col) + 1.0f); sh[c][q] = *(const f32x4*)(shp + col); }
#pragma unroll
    for (int r = 0; r < 4; ++r) {
        f32x4 v[2][2]; float s = 0.f;
#pragma unroll
        for (int c = 0; c < 2; ++c) { const u32x4 w = raw[r][c]; v[c][0] = (f32x4){bflo(w.x), bfhi(w.x), bflo(w.y), bfhi(w.y)}; v[c][1] = (f32x4){bflo(w.z), bfhi(w.z), bflo(w.w), bfhi(w.w)};
#pragma unroll
            for (int q = 0; q < 2; ++q) s += (v[c][q].x * v[c][q].x + v[c][q].y * v[c][q].y) + (v[c][q].z * v[c][q].z + v[c][q].w * v[c][q].w); }
        const float rstd = rsqrtf(wave_sum(s) * (1.f / DM) + EPS);
        u32x4* o16 = (u32x4*)(h + (size_t)(m0 + r) * DM) + lane;
#pragma unroll
        for (int c = 0; c < 2; ++c) { const f32x4 y0 = v[c][0] * rstd * gs[c][0] + sh[c][0], y1 = v[c][1] * rstd * gs[c][1] + sh[c][1];
            u32x4 w; w.x = pk2(y0.x, y0.y); w.y = pk2(y0.z, y0.w); w.z = pk2(y1.x, y1.y); w.w = pk2(y1.z, y1.w); o16[64 * c] = w; }
    }
}
__device__ __forceinline__ void phase_norm_bf(const bf16_t* x, const float* g, const float* mod_l, int which_sh, bf16_t* h, int vcu, int G, const int tid) {
    const int lane = tid & 63, wave = tid >> 6;
    const int gw = vcu * 8 + wave, NGW = G * 8;
    for (int m0 = gw * 4; m0 < M; m0 += NGW * 4) norm_rows4_bf(x, g, mod_l, which_sh, h, m0, lane);
}
__device__ __forceinline__ void phase_norm(const float* x, const float* g, const float* mod_l, int which_sh, bf16_t* h, int vcu, int G, const int tid) {
    const int lane = tid & 63, wave = tid >> 6;
    const int gw = vcu * 8 + wave, NGW = G * 8;
    for (int m0 = gw * 4; m0 < M; m0 += NGW * 4) norm_rows4(x, g, mod_l, which_sh, h, m0, lane);
}

__device__ __forceinline__ float hgrn_lb(const float* b_lb, int dir, int l, int col) {
    const float* p = b_lb + (size_t)dir * DEPTH * 256 + col;
    const float v0 = p[0], v1 = p[256], v2 = p[512], v3 = p[768];
    const float mx = fmaxf(fmaxf(v0, v1), fmaxf(v2, v3));
    const float e0 = __expf(v0 - mx), e1 = __expf(v1 - mx), e2 = __expf(v2 - mx), e3 = __expf(v3 - mx);
    const float s = e0 + e1 + e2 + e3;
    float acc = 0.f; if (l >= 1) acc += e1; if (l >= 2) acc += e2; if (l >= 3) acc += e3;
    return acc / s;
}
__device__ __forceinline__ void hgrn_fk(float xpre, float lb, float& lf, float& kk) {
    float f = lb + (1.0f - lb) * __builtin_amdgcn_rcpf(1.0f + fast_exp2(-1.4426950408889634f * xpre));
    f = fmaxf(f, 1e-6f);
    lf = __builtin_amdgcn_logf(f); kk = 1.0f - f;
}

__device__ __forceinline__ void phase_prep(const Args& a, lds_u8* lds, int l, int vcu, int G, const int tid, const bool dry) {
    const int lane = tid & 63, wave = tid >> 6;
    const int gw = vcu * 8 + wave, NGW = G * 8;
    unsigned char* ws = a.ws;
    bf16_t* proj = (bf16_t*)(ws + WS_PROJ);
    const float* rope = (const float*)(ws + WS_ROPE);
    {
        const float gak = a.in[I_AKN][l * 64 + lane], gck = a.in[I_CKN][l * 64 + lane];
        const int half = lane >> 5, side = (lane >> 4) & 1, i = lane & 15;
        for (int m0 = gw * 4; m0 < M; m0 += NGW * 4) {
            unsigned short raw[4][4];
#pragma unroll
            for (int r = 0; r < 4; ++r) { const bf16_t* row = proj + (size_t)(m0 + r) * INW;
                raw[r][0] = row[C_AK + lane]; raw[r][1] = row[C_AK + 64 + lane]; raw[r][2] = row[C_CK + lane]; raw[r][3] = row[C_CK + 64 + lane]; }
#pragma unroll
            for (int r = 0; r < 4; ++r) {
                const int m = m0 + r, t = m & (SEQ - 1);
                bf16_t* wrow = (dry ? (bf16_t*)(ws + WS_U) : proj) + (size_t)m * INW;
                const int pos = half ? (t & 63) : (t >> 6);
                const float cs = rope[(pos * 16 + i) * 2], sn = rope[(pos * 16 + i) * 2 + 1];
#pragma unroll
                for (int hh = 0; hh < 2; ++hh) {
                    float v = bf2f(raw[r][hh]);
                    const float ss = wave_sum(v * v);
                    v = v * rsqrtf(ss * (1.f / 64) + EPS) * gak;
                    const float pr = __shfl_xor(v, 16);
                    const float o = side ? (v * cs + pr * sn) : (v * cs - pr * sn);
                    wrow[C_AK + hh * 64 + lane] = (bf16_t)f2bf(o);
                }
#pragma unroll
                for (int hh = 0; hh < 2; ++hh) {
                    float v = bf2f(raw[r][2 + hh]);
                    const float ss = wave_sum(v * v);
                    v = v * rsqrtf(ss * (1.f / 64) + EPS) * gck;
                    wrow[C_CK + hh * 64 + lane] = (bf16_t)f2bf(v);
                }
            }
        }
    }
    {
        LAS bf16_t* scr = (LAS bf16_t*)(lds + wave * 9216);
        bf16_t* vt = (bf16_t*)(ws + WS_VT);
        for (int it = gw; it < NB * 4 * 32; it += NGW) {
            const int b = it >> 7, kv4 = (it >> 5) & 3, tb = it & 31;
            const int col0 = (kv4 < 2 ? C_AV : C_CV) + (kv4 & 1) * 64;
            const bf16_t* src = proj + ((size_t)b * SEQ + tb * 64) * INW + col0 + lane;
#pragma unroll
            for (int rb = 0; rb < 64; rb += 32) { unsigned short tmp[32];
#pragma unroll
              for (int r = 0; r < 32; ++r) tmp[r] = src[(size_t)(rb + r) * INW];
#pragma unroll
              for (int r = 0; r < 32; ++r) scr[(rb + r) * 66 + lane] = tmp[r]; }
            asm volatile("s_waitcnt lgkmcnt(0)" ::: "memory");
            bf16_t* dst = vt + (((size_t)b * 4 + kv4) * 64) * SEQ + tb * 64 + lane;
#pragma unroll 16
            for (int d = 0; d < 64; ++d) dst[(size_t)d * SEQ] = scr[lane * 66 + d];
            asm volatile("s_waitcnt lgkmcnt(0)" ::: "memory");
        }
    }
    {
        LAS bf16_t* klt = (LAS bf16_t*)(lds + wave * 9216);
        float* HL = (float*)(ws + WS_HL); float* HDp = (float*)(ws + WS_HD);
        const int r16 = lane & 15, q4 = lane >> 4;
        for (int it = gw; it < NB * 4 * 2 * 32; it += NGW) {
            const int c = it & 31, dir = (it >> 5) & 1, hh = (it >> 6) & 3, b = it >> 8;
            const float lb = hgrn_lb(a.in[I_BLB], dir, l, hh * 64 + lane);
            const size_t rbase = (size_t)b * SEQ + c * 64;
            const int fcol = (dir ? C_BFB : C_BFF) + hh * 64 + lane;
            unsigned fpk[32];
#pragma unroll
            for (int s = 0; s < 64; s += 2) { const int t0 = dir ? (63 - s) : s, t1 = dir ? (62 - s) : s + 1; fpk[s >> 1] = (unsigned)proj[(rbase + t0) * INW + fcol] | ((unsigned)proj[(rbase + t1) * INW + fcol] << 16); }
            float total = 0.f;
#pragma unroll
            for (int s = 63; s >= 0; --s) { float lf, kk; hgrn_fk((s & 1) ? bfhi(fpk[s >> 1]) : bflo(fpk[s >> 1]), lb, lf, kk);
                klt[lane * 72 + s] = (bf16_t)f2bf(kk * fast_exp2(total)); total += lf; }
            asm volatile("s_waitcnt lgkmcnt(0)" ::: "memory");
            HDp[(size_t)it * 64 + lane] = fast_exp2(total);
            const int vcol = C_BI + hh * 64;
            float* Lo = HL + (size_t)it * 4096;
#pragma unroll
            for (int mi = 0; mi < 4; ++mi) {
                bf16x8 af[2];
#pragma unroll
                for (int ks = 0; ks < 2; ++ks)
#pragma unroll
                    for (int j = 0; j < 8; ++j) { const int s = 32 * ks + 8 * q4 + j; const int tk = dir ? (63 - s) : s; af[ks][j] = (short)proj[(rbase + tk) * INW + vcol + 16 * mi + r16]; }
#pragma unroll
                for (int ni = 0; ni < 4; ++ni) {
                    f32x4 acc = (f32x4){0.f, 0.f, 0.f, 0.f};
#pragma unroll
                    for (int ks = 0; ks < 2; ++ks) { const bf16x8 bfr = *(const LAS bf16x8*)(klt + (16 * ni + r16) * 72 + 32 * ks + 8 * q4);
                        acc = __builtin_amdgcn_mfma_f32_16x16x32_bf16(af[ks], bfr, acc, 0, 0, 0); }
#pragma unroll
                    for (int j = 0; j < 4; ++j) Lo[(16 * mi + 4 * q4 + j) * 64 + 16 * ni + r16] = acc[j];
                }
            }
            asm volatile("s_waitcnt lgkmcnt(0)" ::: "memory");
        }
    }
}

constexpr int AT_KV = 18432;
constexpr int AT_TBL = 4 * AT_KV;
__device__ __forceinline__ int pi32(int m) { return (m & ~12) | ((m & 4) << 1) | ((m & 8) >> 1); }

template <bool BIAS>
__device__ __forceinline__ void attn_unit(lds_u8* lds, const bf16_t* proj, const bf16_t* vt, bf16_t* mix, const bf16_t* po_far, const float* pl, const float* gq, const float* gk, const float* rope,
                                          int b, int h, int qblk, int qcol0, int kcol0, int vsel0, int mixcol0, const int tid) {
    const int lane = tid & 63, wave = __builtin_amdgcn_readfirstlane(tid >> 6);
    const int r32 = lane & 31, hi = lane >> 5;
    const int kvh = h / 3;
    const int q0 = qblk * 256;
    const int qp = q0 + 32 * wave + r32;
    int tlo = 0, ntile = SEQ / 64;
    if (BIAS) { const int klo = q0 - 256 < 0 ? 0 : q0 - 256, khi_ = q0 + 255 + 256 > SEQ - 1 ? SEQ - 1 : q0 + 255 + 256; tlo = klo >> 6; ntile = (khi_ >> 6) - tlo + 1; }
    const bf16_t* kbase = proj + (size_t)b * SEQ * INW + kcol0 + kvh * 64;
    const bf16_t* vbase = vt + ((size_t)b * 4 + vsel0 + kvh) * 64 * SEQ;
    const int lrow_ = tid >> 3, lc16 = tid & 7;
    u32x4 kreg, vreg;
#define AT_LOAD(tile) do { const int key0_ = (tile) * 64; kreg = *(const u32x4*)(kbase + (size_t)(key0_ + lrow_) * INW + lc16 * 8); vreg = *(const u32x4*)(vbase + (size_t)lrow_ * SEQ + key0_ + lc16 * 8); } while (0)
#define AT_STORE(bufi) do { lds_u8* bb_ = lds + (bufi) * AT_KV; *(LAS u32x4*)(bb_ + lrow_ * 144 + lc16 * 16) = kreg; *(LAS u32x4*)(bb_ + 9216 + lrow_ * 144 + lc16 * 16) = vreg; } while (0)
    u32x4 qraw[4];
    { const bf16_t* qrow = proj + ((size_t)b * SEQ + qp) * INW + qcol0 + h * 64 + 8 * hi;
#pragma unroll
      for (int d0 = 0; d0 < 4; ++d0) qraw[d0] = *(const u32x4*)(qrow + 16 * d0); }
    AT_LOAD(tlo);
    const float gql = gq[lane], gkl = gk[lane];
    f32x4 gqv[4][2];
#pragma unroll
    for (int d0 = 0; d0 < 4; ++d0) { gqv[d0][0] = *(const f32x4*)(gq + 16 * d0 + 8 * hi); gqv[d0][1] = *(const f32x4*)(gq + 16 * d0 + 8 * hi + 4); }
    f32x4 rpr[4], rpc[4];
    if (!BIAS) { const int pr = qp >> 6, pc = qp & 63;
#pragma unroll
        for (int j4 = 0; j4 < 4; ++j4) { rpr[j4] = *(const f32x4*)(rope + (pr * 16 + 8 * hi) * 2 + 4 * j4); rpc[j4] = *(const f32x4*)(rope + (pc * 16 + 8 * hi) * 2 + 4 * j4); } }
    float ref;
    { float a = fabsf(gql), c = fabsf(gkl);
#pragma unroll
      for (int o = 1; o < 64; o <<= 1) { a = fmaxf(a, __shfl_xor(a, o)); c = fmaxf(c, __shfl_xor(c, o)); }
      ref = 64.0f * 0.125f * 1.4426950408889634f * 1.02f * a * c + (BIAS ? 1.6f : 0.0f); }
    if (BIAS) {
        LAS float* tbl = (LAS float*)(lds + AT_TBL);
        const float slope = fast_exp2(-(float)(h + 1) * (4.0f / 3.0f));
        for (int e = tid; e < 4096; e += NTHREADS) { const int d = e - 2048, ad = d < 0 ? -d : d;
            const int mult = ad > 256 ? 0 : (ad <= 64 ? 1 : 0) + ((ad & 3) == 0 ? 1 : 0) + ((ad & 15) == 0 ? 1 : 0);
            const float lg = mult == 3 ? 1.5849625007211562f : (mult == 2 ? 1.0f : 0.0f);
            tbl[e] = mult ? (lg - slope * (float)ad * 1.4426950408889634f - ref) : -1e30f; }
    }
    bf16x8 qr[4];
    {
        float v[4][8]; float ss = 0.f;
#pragma unroll
        for (int d0 = 0; d0 < 4; ++d0) { const u32x4 w = qraw[d0];
            v[d0][0] = bflo(w.x); v[d0][1] = bfhi(w.x); v[d0][2] = bflo(w.y); v[d0][3] = bfhi(w.y); v[d0][4] = bflo(w.z); v[d0][5] = bfhi(w.z); v[d0][6] = bflo(w.w); v[d0][7] = bfhi(w.w);
#pragma unroll
            for (int j = 0; j < 8; ++j) ss += v[d0][j] * v[d0][j]; }
        ss += __shfl_xor(ss, 32);
        const float rstd = rsqrtf(ss * (1.f / 64) + EPS);
#pragma unroll
        for (int d0 = 0; d0 < 4; ++d0)
#pragma unroll
            for (int j = 0; j < 8; ++j) v[d0][j] *= rstd * gqv[d0][j >> 2][j & 3];
        if (!BIAS) {
#pragma unroll
            for (int j = 0; j < 8; ++j) {
                { const float c = rpr[j >> 1][2 * (j & 1)], s = rpr[j >> 1][2 * (j & 1) + 1]; const float x1 = v[0][j], x2 = v[1][j]; v[0][j] = x1 * c - x2 * s; v[1][j] = x2 * c + x1 * s; }
                { const float c = rpc[j >> 1][2 * (j & 1)], s = rpc[j >> 1][2 * (j & 1) + 1]; const float x1 = v[2][j], x2 = v[3][j]; v[2][j] = x1 * c - x2 * s; v[3][j] = x2 * c + x1 * s; } }
        }
        const float qsc = 0.125f * 1.4426950408889634f;
#pragma unroll
        for (int d0 = 0; d0 < 4; ++d0) { u32x4 w; w.x = pk2(v[d0][0] * qsc, v[d0][1] * qsc); w.y = pk2(v[d0][2] * qsc, v[d0][3] * qsc); w.z = pk2(v[d0][4] * qsc, v[d0][5] * qsc); w.w = pk2(v[d0][6] * qsc, v[d0][7] * qsc);
            qr[d0] = __builtin_bit_cast(bf16x8, w); }
    }
    AT_STORE(0);
    __syncthreads();
    float lrow = 0.f;
    f32x16 o0, o1, negref;
#pragma unroll
    for (int i = 0; i < 16; ++i) { o0[i] = 0.f; o1[i] = 0.f; negref[i] = -ref; }
    const int krow = pi32(r32);
    for (int step = 0; step < ntile; ++step) {
        const bool ldn = (step + 1 < ntile);
        if (ldn) AT_LOAD(tlo + step + 1);
        {
            const lds_u8* kb = lds + (step & 1) * AT_KV;
            const lds_u8* vb = kb + 9216;
            f32x16 p0, p1;
            if (BIAS) {
                const LAS float* tbl = (const LAS float*)(lds + AT_TBL) + ((tlo + step) * 64 + 8 * hi - qp + 2048);
#pragma unroll
                for (int i = 0; i < 16; ++i) { p0[i] = tbl[(i & 7) + 16 * (i >> 3)]; p1[i] = tbl[(i & 7) + 16 * (i >> 3) + 32]; }
            } else { p0 = negref; p1 = negref; }
#pragma unroll
            for (int d0 = 0; d0 < 4; ++d0) {
                const bf16x8 k0 = *(const LAS bf16x8*)(kb + krow * 144 + 32 * d0 + 16 * hi);
                const bf16x8 k1 = *(const LAS bf16x8*)(kb + (32 + krow) * 144 + 32 * d0 + 16 * hi);
                p0 = __builtin_amdgcn_mfma_f32_32x32x16_bf16(k0, qr[d0], p0, 0, 0, 0);
                p1 = __builtin_amdgcn_mfma_f32_32x32x16_bf16(k1, qr[d0], p1, 0, 0, 0);
            }
            float rs0 = 0.f, rs1 = 0.f;
#pragma unroll
            for (int i = 0; i < 16; ++i) { p0[i] = fast_exp2(p0[i]); p1[i] = fast_exp2(p1[i]); rs0 += p0[i]; rs1 += p1[i]; }
            lrow += rs0 + rs1;
            bf16x8 pb[2][2];
#pragma unroll
            for (int ks = 0; ks < 2; ++ks) {
                u32x4 w; w.x = pk2(p0[8 * ks + 0], p0[8 * ks + 1]); w.y = pk2(p0[8 * ks + 2], p0[8 * ks + 3]); w.z = pk2(p0[8 * ks + 4], p0[8 * ks + 5]); w.w = pk2(p0[8 * ks + 6], p0[8 * ks + 7]);
                pb[0][ks] = __builtin_bit_cast(bf16x8, w);
                u32x4 w1; w1.x = pk2(p1[8 * ks + 0], p1[8 * ks + 1]); w1.y = pk2(p1[8 * ks + 2], p1[8 * ks + 3]); w1.z = pk2(p1[8 * ks + 4], p1[8 * ks + 5]); w1.w = pk2(p1[8 * ks + 6], p1[8 * ks + 7]);
                pb[1][ks] = __builtin_bit_cast(bf16x8, w1);
            }
#pragma unroll
            for (int sub = 0; sub < 2; ++sub)
#pragma unroll
                for (int ks = 0; ks < 2; ++ks) {
                    const bf16x8 v0 = *(const LAS bf16x8*)(vb + r32 * 144 + (32 * sub + 16 * ks + 8 * hi) * 2);
                    const bf16x8 v1 = *(const LAS bf16x8*)(vb + (32 + r32) * 144 + (32 * sub + 16 * ks + 8 * hi) * 2);
                    o0 = __builtin_amdgcn_mfma_f32_32x32x16_bf16(v0, pb[sub][ks], o0, 0, 0, 0);
                    o1 = __builtin_amdgcn_mfma_f32_32x32x16_bf16(v1, pb[sub][ks], o1, 0, 0, 0);
                }
        }
        if (ldn) AT_STORE((step + 1) & 1);
        __syncthreads();
    }
#undef AT_LOAD
#undef AT_STORE
    lrow += __shfl_xor(lrow, 32);
    {
        const size_t grow = (size_t)b * SEQ + qp;
        const bf16_t* fpo = BIAS ? po_far + grow * 384 + h * 64 + 4 * hi : nullptr;
        const float inv = 1.0f / (lrow + (BIAS ? pl[grow * 6 + h] : 0.0f));
        bf16_t* orow = mix + grow * DM + mixcol0 + h * 64 + 4 * hi;
#pragma unroll
        for (int g4 = 0; g4 < 4; ++g4) {
            u32x2 f0 = (u32x2){0u, 0u}, f1 = (u32x2){0u, 0u};
            if (BIAS) { f0 = *(const u32x2*)(fpo + 8 * g4); f1 = *(const u32x2*)(fpo + 32 + 8 * g4); }
            { const float x0 = (o0[4 * g4] + bflo(f0.x)) * inv, x1 = (o0[4 * g4 + 1] + bfhi(f0.x)) * inv, x2 = (o0[4 * g4 + 2] + bflo(f0.y)) * inv, x3 = (o0[4 * g4 + 3] + bfhi(f0.y)) * inv;
              u32x2 w; w.x = pk2(x0, x1); w.y = pk2(x2, x3); *(u32x2*)(orow + 8 * g4) = w; }
            { const float x0 = (o1[4 * g4] + bflo(f1.x)) * inv, x1 = (o1[4 * g4 + 1] + bfhi(f1.x)) * inv, x2 = (o1[4 * g4 + 2] + bflo(f1.y)) * inv, x3 = (o1[4 * g4 + 3] + bfhi(f1.y)) * inv;
              u32x2 w; w.x = pk2(x0, x1); w.y = pk2(x2, x3); *(u32x2*)(orow + 32 + 8 * g4) = w; }
        }
    }
}

__device__ __forceinline__ void attn_r16_unit(lds_u8* lds, const bf16_t* proj, bf16_t* po, float* pl, const float* gq, const float* gk, int b, int kvh, int rho, const int tid) {
    const int lane = tid & 63, wave = __builtin_amdgcn_readfirstlane(tid >> 6);
    const int qs = wave & 3, kh = wave >> 2, r32 = lane & 31, hi = lane >> 5;
    const int iq = 32 * qs + r32;
    const size_t qrow_g = (size_t)b * SEQ + rho + 16 * iq;
    const bf16_t* qrow0 = proj + qrow_g * INW + C_CQ + (kvh * 3) * 64 + 8 * hi;
    u32x4 qcur[4], qnxt[4];
#pragma unroll
    for (int d0 = 0; d0 < 4; ++d0) { qcur[d0] = *(const u32x4*)(qrow0 + 16 * d0); qnxt[d0] = qcur[d0]; }
    u32x4 kst[2], vst[2];
    const int th = tid & 255;
#pragma unroll
    for (int i_ = 0; i_ < 2; ++i_) { const int c_ = th + 256 * i_, row_ = c_ >> 3, c16_ = c_ & 7;
        const bf16_t* src = proj + ((size_t)b * SEQ + rho + 16 * (64 * kh + row_)) * INW + kvh * 64 + c16_ * 8;
        kst[i_] = *(const u32x4*)(src + C_CK); vst[i_] = *(const u32x4*)(src + C_CV); }
    const float gql = gq[lane], gkl = gk[lane];
    float ref;
    { float a = fabsf(gql), c = fabsf(gkl);
#pragma unroll
      for (int o = 1; o < 64; o <<= 1) { a = fmaxf(a, __shfl_xor(a, o)); c = fmaxf(c, __shfl_xor(c, o)); }
      ref = 64.0f * 0.125f * 1.4426950408889634f * 1.02f * a * c + 1.6f; }
    LAS float* tb = (LAS float*)(lds + 40960);
    for (int e = tid; e < 768; e += NTHREADS) { const int hq = e >> 8, d = (e & 255) - 128, ad = d < 0 ? -d : d; const float slope = fast_exp2(-(float)(kvh * 3 + hq + 1) * (4.0f / 3.0f));
        tb[e] = (ad > 16 && ad <= 64) ? (-slope * 16.0f * (float)ad * 1.4426950408889634f - ref) : -1e30f; }
    lds_u8* hb = lds + kh * AT_KV;
#pragma unroll
    for (int i_ = 0; i_ < 2; ++i_) { const int c_ = th + 256 * i_, row_ = c_ >> 3, c16_ = c_ & 7;
        *(LAS u32x4*)(hb + row_ * 144 + c16_ * 16) = kst[i_]; *(LAS u32x4*)(hb + 9216 + row_ * 144 + c16_ * 16) = vst[i_]; }
    __syncthreads();
    const int krow = pi32(r32);
    bf16x8 kf[8], vf[8];
#pragma unroll
    for (int d0 = 0; d0 < 4; ++d0) { kf[2 * d0] = *(const LAS bf16x8*)(hb + krow * 144 + 32 * d0 + 16 * hi); kf[2 * d0 + 1] = *(const LAS bf16x8*)(hb + (32 + krow) * 144 + 32 * d0 + 16 * hi); }
    { const LAS bf16_t* vbase = (const LAS bf16_t*)(hb + 9216);
#pragma unroll
      for (int sub = 0; sub < 2; ++sub)
#pragma unroll
        for (int ks = 0; ks < 2; ++ks)
#pragma unroll
            for (int j = 0; j < 8; ++j) { const int key = 32 * sub + 16 * ks + 8 * hi + j;
                vf[(sub * 2 + ks) * 2][j] = (short)vbase[key * 72 + r32]; vf[(sub * 2 + ks) * 2 + 1][j] = (short)vbase[key * 72 + 32 + r32]; } }
    __syncthreads();
    LAS float* cs = (LAS float*)(lds) + (qs * 64 + lane) * 35;
#pragma unroll 1
    for (int hq = 0; hq < 3; ++hq) {
        const int h = kvh * 3 + hq;
        if (hq < 2) {
#pragma unroll
            for (int d0 = 0; d0 < 4; ++d0) qnxt[d0] = *(const u32x4*)(qrow0 + (hq + 1) * 64 + 16 * d0); }
        bf16x8 qr[4];
        {
            f32x4 gqv[4][2];
#pragma unroll
            for (int d0 = 0; d0 < 4; ++d0) { gqv[d0][0] = *(const f32x4*)(gq + 16 * d0 + 8 * hi); gqv[d0][1] = *(const f32x4*)(gq + 16 * d0 + 8 * hi + 4); }
            float v[4][8]; float ss = 0.f;
#pragma unroll
            for (int d0 = 0; d0 < 4; ++d0) { const u32x4 w = qcur[d0];
                v[d0][0] = bflo(w.x); v[d0][1] = bfhi(w.x); v[d0][2] = bflo(w.y); v[d0][3] = bfhi(w.y); v[d0][4] = bflo(w.z); v[d0][5] = bfhi(w.z); v[d0][6] = bflo(w.w); v[d0][7] = bfhi(w.w);
#pragma unroll
                for (int j = 0; j < 8; ++j) ss += v[d0][j] * v[d0][j]; }
            ss += __shfl_xor(ss, 32);
            const float rstd = rsqrtf(ss * (1.f / 64) + EPS) * (0.125f * 1.4426950408889634f);
#pragma unroll
            for (int d0 = 0; d0 < 4; ++d0) { float y[8];
#pragma unroll
                for (int j = 0; j < 8; ++j) y[j] = v[d0][j] * rstd * gqv[d0][j >> 2][j & 3];
                u32x4 w; w.x = pk2(y[0], y[1]); w.y = pk2(y[2], y[3]); w.z = pk2(y[4], y[5]); w.w = pk2(y[6], y[7]); qr[d0] = __builtin_bit_cast(bf16x8, w); }
        }
        f32x16 p0, p1;
        { const LAS float* tbl = tb + hq * 256 + (64 * kh + 8 * hi - iq + 128);
#pragma unroll
          for (int i = 0; i < 16; ++i) { p0[i] = tbl[(i & 7) + 16 * (i >> 3)]; p1[i] = tbl[(i & 7) + 16 * (i >> 3) + 32]; } }
#pragma unroll
        for (int d0 = 0; d0 < 4; ++d0) {
            p0 = __builtin_amdgcn_mfma_f32_32x32x16_bf16(kf[2 * d0], qr[d0], p0, 0, 0, 0);
            p1 = __builtin_amdgcn_mfma_f32_32x32x16_bf16(kf[2 * d0 + 1], qr[d0], p1, 0, 0, 0);
        }
        float lrow = 0.f;
#pragma unroll
        for (int i = 0; i < 16; ++i) { p0[i] = fast_exp2(p0[i]); p1[i] = fast_exp2(p1[i]); lrow += p0[i] + p1[i]; }
        bf16x8 pb[2][2];
#pragma unroll
        for (int ks = 0; ks < 2; ++ks) {
            u32x4 w; w.x = pk2(p0[8 * ks + 0], p0[8 * ks + 1]); w.y = pk2(p0[8 * ks + 2], p0[8 * ks + 3]); w.z = pk2(p0[8 * ks + 4], p0[8 * ks + 5]); w.w = pk2(p0[8 * ks + 6], p0[8 * ks + 7]);
            pb[0][ks] = __builtin_bit_cast(bf16x8, w);
            u32x4 w1; w1.x = pk2(p1[8 * ks + 0], p1[8 * ks + 1]); w1.y = pk2(p1[8 * ks + 2], p1[8 * ks + 3]); w1.z = pk2(p1[8 * ks + 4], p1[8 * ks + 5]); w1.w = pk2(p1[8 * ks + 6], p1[8 * ks + 7]);
            pb[1][ks] = __builtin_bit_cast(bf16x8, w1);
        }
        f32x16 o0, o1;
#pragma unroll
        for (int i = 0; i < 16; ++i) { o0[i] = 0.f; o1[i] = 0.f; }
#pragma unroll
        for (int sub = 0; sub < 2; ++sub)
#pragma unroll
            for (int ks = 0; ks < 2; ++ks) {
                o0 = __builtin_amdgcn_mfma_f32_32x32x16_bf16(vf[(sub * 2 + ks) * 2], pb[sub][ks], o0, 0, 0, 0);
                o1 = __builtin_amdgcn_mfma_f32_32x32x16_bf16(vf[(sub * 2 + ks) * 2 + 1], pb[sub][ks], o1, 0, 0, 0);
            }
        lrow += __shfl_xor(lrow, 32);
        if (kh == 1) { cs[1] = lrow;
#pragma unroll
            for (int i = 0; i < 16; ++i) { cs[2 + i] = o0[i]; cs[18 + i] = o1[i]; } }
        __syncthreads();
        if (kh == 0) {
            bf16_t* orow = po + qrow_g * 384 + h * 64 + 4 * hi;
            if (hi == 0) pl[qrow_g * 6 + h] = lrow + cs[1];
#pragma unroll
            for (int g4 = 0; g4 < 4; ++g4) {
                { u32x2 w; w.x = pk2(o0[4 * g4] + cs[2 + 4 * g4], o0[4 * g4 + 1] + cs[3 + 4 * g4]); w.y = pk2(o0[4 * g4 + 2] + cs[4 + 4 * g4], o0[4 * g4 + 3] + cs[5 + 4 * g4]); *(u32x2*)(orow + 8 * g4) = w; }
                { u32x2 w; w.x = pk2(o1[4 * g4] + cs[18 + 4 * g4], o1[4 * g4 + 1] + cs[19 + 4 * g4]); w.y = pk2(o1[4 * g4 + 2] + cs[20 + 4 * g4], o1[4 * g4 + 3] + cs[21 + 4 * g4]); *(u32x2*)(orow + 32 + 8 * g4) = w; }
            }
        }
        __syncthreads();
#pragma unroll
        for (int d0 = 0; d0 < 4; ++d0) qcur[d0] = qnxt[d0];
    }
}

__device__ __forceinline__ void phase_scan(const Args& a, int vcu, int G, const int tid) {
    const float* HL = (const float*)(a.ws + WS_HL); const float* HDp = (const float*)(a.ws + WS_HD); bf16_t* HS = (bf16_t*)(a.ws + WS_HS);
    for (int e = vcu * NTHREADS + tid; e < 64 * 4096; e += G * NTHREADS) {
        const int seq = e >> 12, idx = e & 4095, k = idx & 63, dir = seq & 1;
        float st = 0.f;
        float hd[32], hl[32];
#pragma unroll
        for (int j = 0; j < 32; ++j) { const int c = dir ? 31 - j : j; const size_t o = (size_t)seq * 32 + c; hd[j] = HDp[o * 64 + k]; hl[j] = HL[o * 4096 + idx]; }
#pragma unroll
        for (int j = 0; j < 32; ++j) { const int c = dir ? 31 - j : j; const size_t o = (size_t)seq * 32 + c; HS[o * 4096 + idx] = (bf16_t)f2bf(st); st = hd[j] * st + hl[j]; }
    }
}

constexpr int HG_OACC = 0, HG_QS = 65536, HG_QD = HG_QS + 9216, HG_KD = HG_QD + 9216, HG_KE = HG_KD + 9216, HG_Q2 = HG_KE + 9216, HG_K2 = HG_Q2 + 4608,
              HG_VT = HG_K2 + 4608, HG_AT = HG_VT + 9216, HG_ST = HG_AT + 9216, HG_GT = HG_ST + 9216, HG_END = HG_GT + 2048;
static_assert(HG_END <= LDS_BYTES, "HGRN LDS map");

__device__ __forceinline__ void hgrn_out_item(const Args& a, lds_u8* lds, int l, int item, const int tid) {
    const int lane = tid & 63, wave = __builtin_amdgcn_readfirstlane(tid >> 6);
    const int k = lane, rg = wave;
    const int b = item >> 5, hh = (item >> 3) & 3, grp = item & 7;
    const int c0 = grp * 4;
    unsigned char* ws = a.ws;
    const bf16_t* proj = (const bf16_t*)(ws + WS_PROJ);
    const float* HL = (const float*)(ws + WS_HL); const float* HDp = (const float*)(ws + WS_HD);
    LAS float* oacc = (LAS float*)(lds + HG_OACC);
    LAS bf16_t* Qs = (LAS bf16_t*)(lds + HG_QS); LAS bf16_t* Qd = (LAS bf16_t*)(lds + HG_QD); LAS bf16_t* Kd = (LAS bf16_t*)(lds + HG_KD); LAS bf16_t* Ke = (LAS bf16_t*)(lds + HG_KE);
    LAS bf16_t* Q2 = (LAS bf16_t*)(lds + HG_Q2); LAS bf16_t* K2 = (LAS bf16_t*)(lds + HG_K2); LAS bf16_t* VT = (LAS bf16_t*)(lds + HG_VT); LAS bf16_t* AT = (LAS bf16_t*)(lds + HG_AT);
    LAS bf16_t* ST = (LAS bf16_t*)(lds + HG_ST); LAS float* gt = (LAS float*)(lds + HG_GT);
    const int r16 = lane & 15, q4 = lane >> 4;
    const float lbv0 = hgrn_lb(a.in[I_BLB], 0, l, hh * 64 + k), lbv1 = hgrn_lb(a.in[I_BLB], 1, l, hh * 64 + k);
    unsigned short rq[8], rf[8], rv[8];
#define HG_LOADRAW(dir_, c_) do { const size_t rb_ = (size_t)b * SEQ + (c_) * 64; _Pragma("unroll") for (int i = 0; i < 8; ++i) { const int s_ = 8 * rg + i; const int tk_ = (dir_) ? (63 - s_) : s_; \
        const bf16_t* rp_ = proj + (rb_ + tk_) * INW; rq[i] = rp_[C_BQ + hh * 64 + k]; rf[i] = rp_[((dir_) ? C_BFB : C_BFF) + hh * 64 + k]; rv[i] = rp_[C_BI + hh * 64 + k]; } } while (0)
    HG_LOADRAW(0, c0);
    float st[8];
#pragma unroll
    for (int i = 0; i < 8; ++i) st[i] = 0.f;
    for (int stp = 0; stp < 8; ++stp) {
        {
            const int dir = stp >> 2, ci = stp & 3;
            const float lb = dir ? lbv1 : lbv0;
            const size_t sbase = (((size_t)b * 4 + hh) * 2 + dir) * 32;
            const int c = dir ? (c0 + 3 - ci) : (c0 + ci);
            if (ci == 0) { const bf16_t* HSp = (const bf16_t*)(ws + WS_HS) + (sbase + c) * 4096 + (8 * wave) * 64 + k;
#pragma unroll
                for (int i = 0; i < 8; ++i) st[i] = bf2f(HSp[i * 64]); }
            float qv[8], lf[8], kk[8];
            u32x4 vpk;
#pragma unroll
            for (int i = 0; i < 8; ++i) { qv[i] = bf2f(rq[i]); hgrn_fk(bf2f(rf[i]), lb, lf[i], kk[i]); }
            vpk.x = rv[0] | ((unsigned)rv[1] << 16); vpk.y = rv[2] | ((unsigned)rv[3] << 16); vpk.z = rv[4] | ((unsigned)rv[5] << 16); vpk.w = rv[6] | ((unsigned)rv[7] << 16);
            const float dk = HDp[(sbase + c) * 64 + k];
            float Ln[8];
            { const float* Lp = HL + (sbase + c) * 4096 + (8 * wave) * 64 + k;
#pragma unroll
              for (int i = 0; i < 8; ++i) Ln[i] = Lp[i * 64]; }
            if (stp < 7) { const int nd = (stp + 1) >> 2, nci = (stp + 1) & 3; const int nc = nd ? (c0 + 3 - nci) : (c0 + nci); HG_LOADRAW(nd, nc); }
#pragma unroll
            for (int i = 1; i < 8; ++i) lf[i] += lf[i - 1];
            gt[rg * 64 + k] = lf[7];
#pragma unroll
            for (int i = 0; i < 8; ++i) ST[(8 * wave + i) * 72 + k] = (bf16_t)f2bf(st[i]);
            __syncthreads();
            float gsum[9]; gsum[0] = 0.f;
#pragma unroll
            for (int g = 0; g < 8; ++g) gsum[g + 1] = gsum[g] + gt[g * 64 + k];
            float off = 0.f, bS = 0.f, bE = 0.f;
#pragma unroll
            for (int g = 0; g < 8; ++g) { if (g == rg) off = gsum[g]; if (g == (rg & ~1)) { bS = gsum[g]; bE = gsum[g + 2]; } }
            const float b31 = gsum[4];
            const float eS = fast_exp2(bS), e2 = fast_exp2(rg >= 4 ? bS - b31 : b31 - bE);
#pragma unroll
            for (int i = 0; i < 8; ++i) {
                const int s = 8 * rg + i; const float bb = off + lf[i];
                const float qd = qv[i] * fast_exp2(bb - bS), ke = kk[i] * fast_exp2(bE - bb);
                Qd[s * 72 + k] = (bf16_t)f2bf(qd);
                Qs[s * 72 + k] = (bf16_t)f2bf(qd * eS);
                Kd[s * 72 + k] = (bf16_t)f2bf(kk[i] * fast_exp2(fminf(bS - bb, 115.f)));
                Ke[s * 72 + k] = (bf16_t)f2bf(ke);
                { const bool hi2 = rg >= 4; LAS bf16_t* T2 = hi2 ? Q2 + (s - 32) * 72 + k : K2 + s * 72 + k;
                  *T2 = (bf16_t)f2bf((hi2 ? qd : ke) * e2); }
            }
            *(LAS u32x4*)(VT + k * 72 + 8 * rg) = vpk;
            __syncthreads();
            {
                const int I = wave >> 1;
#pragma unroll
                for (int jj = 0; jj < 2; ++jj) {
                    const int J = 2 * (wave & 1) + jj;
                    f32x4 acc = (f32x4){0.f, 0.f, 0.f, 0.f};
                    if (J <= I) {
                        const LAS bf16_t* Ap; const LAS bf16_t* Bp;
                        if (J == I) { Ap = Qd + (16 * I + r16) * 72; Bp = Kd + (16 * J + r16) * 72; }
                        else if ((I >> 1) == (J >> 1)) { Ap = Qd + (16 * I + r16) * 72; Bp = Ke + (16 * J + r16) * 72; }
                        else { Ap = Q2 + (16 * (I - 2) + r16) * 72; Bp = K2 + (16 * J + r16) * 72; }
#pragma unroll
                        for (int ks = 0; ks < 2; ++ks) { const bf16x8 af = *(const LAS bf16x8*)(Ap + 32 * ks + 8 * q4); const bf16x8 bfr = *(const LAS bf16x8*)(Bp + 32 * ks + 8 * q4);
                            acc = __builtin_amdgcn_mfma_f32_16x16x32_bf16(af, bfr, acc, 0, 0, 0); }
                        if (J == I) {
#pragma unroll
                            for (int j = 0; j < 4; ++j) if (r16 > 4 * q4 + j) acc[j] = 0.f;
                        }
                    }
#pragma unroll
                    for (int j = 0; j < 4; ++j) AT[(16 * I + 4 * q4 + j) * 72 + 16 * J + r16] = (bf16_t)f2bf(acc[j]);
                }
            }
            __syncthreads();
            {
                const int mi = wave >> 1;
#pragma unroll
                for (int jj = 0; jj < 2; ++jj) {
                    const int ni = 2 * (wave & 1) + jj;
                    f32x4 acc = (f32x4){0.f, 0.f, 0.f, 0.f};
#pragma unroll
                    for (int ks = 0; ks < 2; ++ks) { const bf16x8 af = *(const LAS bf16x8*)(Qs + (16 * mi + r16) * 72 + 32 * ks + 8 * q4); const bf16x8 bfr = *(const LAS bf16x8*)(ST + (16 * ni + r16) * 72 + 32 * ks + 8 * q4);
                        acc = __builtin_amdgcn_mfma_f32_16x16x32_bf16(af, bfr, acc, 0, 0, 0); }
#pragma unroll
                    for (int ks = 0; ks < 2; ++ks) { const bf16x8 af = *(const LAS bf16x8*)(AT + (16 * mi + r16) * 72 + 32 * ks + 8 * q4); const bf16x8 bfr = *(const LAS bf16x8*)(VT + (16 * ni + r16) * 72 + 32 * ks + 8 * q4);
                        acc = __builtin_amdgcn_mfma_f32_16x16x32_bf16(af, bfr, acc, 0, 0, 0); }
#pragma unroll
                    for (int j = 0; j < 4; ++j) { const int t = 16 * mi + 4 * q4 + j; const int tl = (c - c0) * 64 + (dir ? (63 - t) : t);
                        LAS float* op = oacc + tl * 64 + 16 * ni + r16;
                        if (dir == 0) *op = acc[j]; else *op += acc[j]; }
                }
            }
#pragma unroll
            for (int i = 0; i < 8; ++i) st[i] = dk * st[i] + Ln[i];
            __syncthreads();
        }
    }
#undef HG_LOADRAW

    {
        const float gn = a.in[I_BON][l * 64 + lane];
        bf16_t* mix = (bf16_t*)(ws + WS_MIX);
        for (int rb = 0; rb < 32; rb += 8) {
            unsigned short gv[8];
#pragma unroll
            for (int r = 0; r < 8; ++r) gv[r] = proj[((size_t)b * SEQ + c0 * 64 + 32 * wave + rb + r) * INW + C_BG + hh * 64 + lane];
#pragma unroll
            for (int r = 0; r < 8; ++r) {
                const int tl = 32 * wave + rb + r;
                const size_t row = (size_t)b * SEQ + c0 * 64 + tl;
                const float o = oacc[tl * 64 + lane];
                const float ss = wave_sum(o * o);
                mix[row * DM + 384 + hh * 64 + lane] = (bf16_t)f2bf(o * rsqrtf(ss * (1.f / 64) + EPS) * gn * silu_f(bf2f(gv[r])));
            }
        }
    }
    __syncthreads();
}

__device__ __forceinline__ void phase_mixers(const Args& a, lds_u8* lds, int l, int vcu, int G, const int tid) {
    unsigned char* ws = a.ws;
    const bf16_t* proj = (const bf16_t*)(ws + WS_PROJ); const bf16_t* vt = (const bf16_t*)(ws + WS_VT); bf16_t* mix = (bf16_t*)(ws + WS_MIX);
    const float* rope = (const float*)(ws + WS_ROPE);
    for (int rp = 0; rp < ((PROBE_DUP & 256) ? 2 : 1); ++rp)
    for (int it = vcu; it < NB * 4 * 8; it += G) hgrn_out_item(a, lds, l, it, tid);
    const bf16_t* po_far = (const bf16_t*)(ws + WS_PO); const float* pl_far = (const float*)(ws + WS_PL);
    for (int u = vcu; u < 768; u += G) {
        const int mixer = u / 384, r = u % 384, b = r / 48, rr = r % 48, kvh = rr / 24, r3 = rr % 24, hq = r3 / 8, qblk = r3 % 8;
        const int h = kvh * 3 + hq;
        if (mixer == 0) attn_unit<false>(lds, proj, vt, mix, nullptr, nullptr, a.in[I_AQN] + l * 64, a.in[I_AKN] + l * 64, rope, b, h, qblk, C_AQ, C_AK, 0, 0, tid);
        else attn_unit<true>(lds, proj, vt, mix, po_far, pl_far, a.in[I_CQN] + l * 64, a.in[I_CKN] + l * 64, rope, b, h, qblk, C_CQ, C_CK, 2, 640, tid);
    }
}

__device__ __forceinline__ void phase_mixc(const Args& a, lds_u8* lds, int l, int vcu, int G, const int tid) {
    unsigned char* ws = a.ws;
    const bf16_t* proj = (const bf16_t*)(ws + WS_PROJ);
    bf16_t* po = (bf16_t*)(ws + WS_PO); float* pl = (float*)(ws + WS_PL);
    for (int u = vcu; u < 256; u += G) {
        const int b = u >> 5, kvh = (u >> 4) & 1, rho = u & 15;
        attn_r16_unit(lds, proj, po, pl, a.in[I_CQN] + l * 64, a.in[I_CKN] + l * 64, b, kvh, rho, tid);
    }
}

#define XB_TMO      128
#define XB_XCNT(j)  (256  + 64 * (j))
#define XB_XSUB(j)  (1280 + 64 * (j))
#define XB_XGEN(j)  (2304 + 64 * (j))
#define XB_TOP      3328
#define XB_TOPGEN   3392
#define XCD_BAR_WORDS 3456
#define XB_SPIN_CAP (1u << 18)
__device__ __forceinline__ unsigned xb_ld(unsigned* p)              { return __hip_atomic_load(p, __ATOMIC_RELAXED, __HIP_MEMORY_SCOPE_AGENT); }
__device__ __forceinline__ unsigned xb_add(unsigned* p, unsigned v) { return __hip_atomic_fetch_add(p, v, __ATOMIC_RELAXED, __HIP_MEMORY_SCOPE_AGENT); }
__device__ __forceinline__ unsigned xb_xcc_id() { return (unsigned)__builtin_amdgcn_s_getreg((3 << 11) | 20) & 0xFu; }
#define XB_SPIN(cond, bar) do { unsigned _sp = 0; while (cond) { __builtin_amdgcn_s_sleep(1); \
    if ((++_sp & 255u) == 0u) { if (xb_ld(&(bar)[XB_TMO])) break; if (_sp > XB_SPIN_CAP) { atomicAdd(&(bar)[XB_TMO], 1u); break; } } } } while (0)
struct XcdBarrier { unsigned* bar; unsigned x; volatile LAS unsigned* st; int wave; };
__device__ __forceinline__ int lane_id() { return (int)__builtin_amdgcn_mbcnt_hi(~0u, __builtin_amdgcn_mbcnt_lo(~0u, 0u)); }
__device__ __forceinline__ XcdBarrier xcd_barrier_post(unsigned* bar, volatile LAS unsigned* st, int wave) {
    XcdBarrier b; b.bar = bar; b.x = xb_xcc_id(); b.st = st; b.wave = wave;
    if (wave == 0 && lane_id() == 0) (void)xb_add(&bar[XB_XCNT(b.x)], 1u);
    return b;
}
__device__ __forceinline__ void xcd_barrier_complete(unsigned* bar, unsigned x, unsigned& nloc, unsigned& nx) {
    const unsigned G = gridDim.x * gridDim.y * gridDim.z;
    unsigned sum, cnt, mine, sp = 0u;
    for (;;) {
        sum = 0u; cnt = 0u; mine = 0u;
#pragma unroll
        for (unsigned j = 0; j < 16; ++j) { const unsigned c = xb_ld(&bar[XB_XCNT(j)]); sum += c; cnt += (c > 0u) ? 1u : 0u; mine = (j == x) ? c : mine; }
        if (sum == G) break;
        __builtin_amdgcn_s_sleep(1);
        if ((++sp & 255u) == 0u) { if (xb_ld(&bar[XB_TMO])) break; if (sp > XB_SPIN_CAP) { atomicAdd(&bar[XB_TMO], 1u); break; } }
    }
    nloc = mine > 0u ? mine : 1u; nx = cnt > 0u ? cnt : 1u;
}
__device__ __forceinline__ void xcd_barrier(const XcdBarrier& b) {
    asm volatile("s_waitcnt vmcnt(0)" ::: "memory");
    __syncthreads();
    if (b.wave == 0 && lane_id() == 0) {
        unsigned* bar = b.bar;
        __builtin_amdgcn_s_waitcnt(0);
        unsigned nloc = b.st[0], nx = b.st[1];
        if (nloc == 0u) { xcd_barrier_complete(bar, b.x, nloc, nx); b.st[0] = nloc; b.st[1] = nx; }
        const unsigned old = xb_add(&bar[XB_XSUB(b.x)], 1u);
        const unsigned gen = old / nloc;
        if (old + 1u == (gen + 1u) * nloc) {
            __builtin_amdgcn_fence(__ATOMIC_RELEASE, "agent");
            asm volatile("s_waitcnt vmcnt(0)" ::: "memory");
            const unsigned og = xb_add(&bar[XB_TOP], 1u);
            const unsigned tg = og / nx;
            if (og + 1u == (tg + 1u) * nx) xb_add(&bar[XB_TOPGEN], 1u);
            else XB_SPIN(xb_ld(&bar[XB_TOPGEN]) == tg, bar);
            __builtin_amdgcn_fence(__ATOMIC_ACQUIRE, "agent");
            xb_add(&bar[XB_XGEN(b.x)], 1u);
            asm volatile("s_waitcnt vmcnt(0)" ::: "memory");
        } else {
            XB_SPIN(xb_ld(&bar[XB_XGEN(b.x)]) == gen, bar);
            __builtin_amdgcn_fence(__ATOMIC_ACQUIRE, "agent");
            asm volatile("s_waitcnt vmcnt(0)" ::: "memory");
        }
    }
    __syncthreads();
}
__device__ __forceinline__ void panel_norm(unsigned* cnt, const bf16_t* x, const float* g, const float* mod_l, int which_sh, bf16_t* h, int pm, int pn, const int tid) {
    asm volatile("s_waitcnt vmcnt(0)" ::: "memory");
    __syncthreads();
    if (tid == 0) {
        __builtin_amdgcn_fence(__ATOMIC_RELEASE, "agent");
        asm volatile("s_waitcnt vmcnt(0)" ::: "memory");
        (void)xb_add(cnt, 1u);
        unsigned sp = 0u;
        while (xb_ld(cnt) < 4u) { __builtin_amdgcn_s_sleep(1); if (++sp > (1u << 22)) break; }
        __builtin_amdgcn_fence(__ATOMIC_ACQUIRE, "agent");
        asm volatile("s_waitcnt vmcnt(0)" ::: "memory");
    }
    __syncthreads();
    const int lane = tid & 63, wave = tid >> 6;
    for (int r = 0; r < 8; r += 4) norm_rows4_bf(x, g, mod_l, which_sh, h, pm * 256 + pn * 64 + wave * 8 + r, lane);
}
constexpr int MISC_OFF = LDS_BYTES - 64;

constexpr int NPHASES = 2 + 9 * DEPTH - 1;

typedef const Args __attribute__((address_space(4))) KArgs;
template <int KMASK> __global__ void __launch_bounds__(NTHREADS, 2) fwd_kernel_t(Args a0) {
    extern __shared__ __attribute__((aligned(16))) unsigned char lds_raw[];
    lds_u8* lds = (lds_u8*)lds_raw;
    const int G = gridDim.x;
    unsigned char* ws = a0.ws;
    const int ph_lo = a0.ph_lo, ph_hi = a0.ph_hi;
    const float* mod = (const float*)(ws + WS_MOD);
    const int wave_s = __builtin_amdgcn_readfirstlane((int)(threadIdx.x >> 6));
    if (wave_s == 0 && lane_id() < 16) ((LAS unsigned*)(lds + MISC_OFF))[lane_id()] = 0u;
    __syncthreads();
    XcdBarrier bar = xcd_barrier_post((unsigned*)(ws + WS_CTL) + 4096, (volatile LAS unsigned*)(lds + MISC_OFF), wave_s);
    const bool fuse_norm = MK_ONE_LAUNCH && !PROBE_DUP && (G == 256);
    for (int ph = ph_lo; ph < ph_hi; ++ph) {
        KArgs* kap = (KArgs*)__builtin_amdgcn_kernarg_segment_ptr(); asm volatile("" : "+s"(kap));
        Args a;
#pragma unroll
        for (int i_ = 0; i_ < 17; ++i_) a.in[i_] = kap->in[i_];
        a.out = kap->out; a.ws = kap->ws; a.ph_lo = ph_lo; a.ph_hi = ph_hi;
        if (fuse_norm && ph >= 2 && ((ph - 2) % 9 == 5 || (ph - 2) % 9 == 8)) continue;
        int kbit = 0;
        if (PROBE_DUP) { if (ph == 0) kbit = 1; else if (ph == 1) kbit = 2; else { const int s_ = (ph - 2) % 9; kbit = s_ == 0 ? 4 : (s_ == 4 || s_ == 7) ? 8 : s_ == 1 ? 16 : s_ == 3 ? 32 : s_ == 6 ? 64 : s_ == 2 ? 128 : 2; } }
        const int nrep = (PROBE_DUP & kbit) ? 2 : 1;
        for (int rep = 0; rep < nrep; ++rep) {
        const bool dry = (rep + 1 < nrep); if (rep) __syncthreads();
        int tid = threadIdx.x; asm volatile("" : "+v"(tid));
        int bx = blockIdx.x; asm volatile("" : "+s"(bx));
        const int vcu = (G % 8 == 0) ? (bx % 8) * (G / 8) + bx / 8 : bx;
        if (ph == 0) { if (KMASK & 1) phase_prologue(a, lds, vcu, G, tid, bx); }
        else if (ph == 1) { if (KMASK & 2) phase_norm(a.in[I_X], a.in[I_NORMG], mod, 0, (bf16_t*)(ws + WS_H), vcu, G, tid); }
        else {
            const int l = (ph - 2) / 9, s = (ph - 2) % 9;
            const float* mod_l = mod + (size_t)l * 8 * 6144;
            if ((KMASK & 4) && s == 0) {
                const pg8::Gemm g{(const bf16_t*)(ws + WS_H), (const bf16_t*)(ws + WS_WIN) + (size_t)l * INW * DM, M, INW, DM}; const pg8::EpiStore E{(bf16_t*)(ws + WS_PROJ), INW};
                pg8::StaticOrder S; S.init(g.M, g.N, G, bx);
                pg8::gemm_phase<pg8::EpiStore, pg8::StaticOrder>(lds, g, S, E, tid);
            } else if ((KMASK & 64) && s == 6) {
                const pg8::Gemm g{(const bf16_t*)(ws + WS_H), (const bf16_t*)(ws + WS_WUP) + (size_t)l * UPW * DM, M, UPW, DM};
                const pg8::EpiConvGate E{(bf16_t*)(ws + WS_ACT), a.in[I_CONVW] + (size_t)l * 3 * UPW, a.in[I_CONVB] + (size_t)l * UPW};
                pg8::StaticOrder S; S.init(g.M, g.N, G, bx, 1);
                pg8::gemm_phase<pg8::EpiConvGate, pg8::StaticOrder>(lds, g, S, E, tid);
            } else if ((KMASK & 8) && (s == 4 || s == 7)) {
                pg8::Gemm g; pg8::EpiResid E;
                const bool nfuse = fuse_norm && !dry && !(s == 7 && l == DEPTH - 1);
                if (s == 4) { g = pg8::Gemm{(const bf16_t*)(ws + WS_MIX), (const bf16_t*)(ws + WS_WOUT) + (size_t)l * DM * DM, M, DM, DM};
                    E = pg8::EpiResid{ws, l == 0 ? a.in[I_X] : nullptr, nullptr, a.in[I_NORMG], l, 0, nfuse ? 1 : 0}; }
                else { g = pg8::Gemm{(const bf16_t*)(ws + WS_ACT), (const bf16_t*)(ws + WS_WDN) + (size_t)l * DM * FF, M, DM, FF};
                    E = pg8::EpiResid{ws, nullptr, (l == DEPTH - 1) ? a.out : nullptr, a.in[I_NORMG], l, 1, nfuse ? 1 : 0}; }
                pg8::StaticOrder S; S.init(g.M, g.N, G, bx);
                pg8::gemm_phase<pg8::EpiResid, pg8::StaticOrder>(lds, g, S, E, tid);
            } else if ((KMASK & 16) && s == 1) phase_prep(a, lds, l, vcu, G, tid, dry);
            else if ((KMASK & 16) && s == 2) { phase_scan(a, vcu, G, tid); phase_mixc(a, lds, l, vcu, G, tid); }
            else if ((KMASK & 32) && s == 3) phase_mixers(a, lds, l, vcu, G, tid);
            else if ((KMASK & 2) && s == 5) phase_norm_bf((const bf16_t*)(ws + WS_XB), a.in[I_NORMG] + (size_t)(l * 2 + 1) * DM, mod_l, 3, (bf16_t*)(ws + WS_H), vcu, G, tid);
            else if ((KMASK & 2) && s == 8) phase_norm_bf((const bf16_t*)(ws + WS_XB), a.in[I_NORMG] + (size_t)((l + 1) * 2) * DM, mod_l + 8 * 6144, 0, (bf16_t*)(ws + WS_H), vcu, G, tid);
        }
        }
        if (ph + 1 < ph_hi) xcd_barrier(bar);
    }
}

typedef void (*kern_t)(Args);
static int phase_kind(int ph) { if (ph == 0) return 0; if (ph == 1) return 1; const int s = (ph - 2) % 9; return s == 0 ? 2 : s == 4 || s == 7 ? 3 : s == 1 || s == 2 ? 4 : s == 3 ? 5 : s == 6 ? 6 : 1; }
extern "C" void kernel_launch(void* const* d_in, const int* in_sizes, int n_in, void* d_out, int out_size, void* d_ws, size_t ws_size, hipStream_t stream) {
    static int grid = 0;
#if MK_ONE_LAUNCH
    static const kern_t kerns[1] = {fwd_kernel_t<127>}; constexpr int NK = 1;
#else
    static const kern_t kerns[7] = {fwd_kernel_t<1>, fwd_kernel_t<2>, fwd_kernel_t<4>, fwd_kernel_t<8>, fwd_kernel_t<16>, fwd_kernel_t<32>, fwd_kernel_t<64>}; constexpr int NK = 7;
#endif
    if (grid == 0) {
        if (n_in != 17 || out_size != M * DM || ws_size < WS_END) { fprintf(stderr, "kernel_launch: unexpected shapes (n_in %d, out %d, ws %zu)\n", n_in, out_size, ws_size); grid = -1; return; }
        int dev = 0, cus = 0;
        if (hipGetDevice(&dev) != hipSuccess || hipDeviceGetAttribute(&cus, hipDeviceAttributeMultiprocessorCount, dev) != hipSuccess) { grid = -1; return; }
        for (int i = 0; i < NK; ++i)
            if (hipFuncSetAttribute((const void*)kerns[i], hipFuncAttributeMaxDynamicSharedMemorySize, LDS_BYTES) != hipSuccess) { fprintf(stderr, "kernel_launch: hipFuncSetAttribute failed\n"); grid = -1; return; }
        int per_cu = 0;
        if (hipOccupancyMaxActiveBlocksPerMultiprocessor(&per_cu, (const void*)kerns[0], NTHREADS, LDS_BYTES) != hipSuccess || per_cu < 1) { fprintf(stderr, "kernel_launch: occupancy query says %d\n", per_cu); (void)hipGetLastError(); }
        grid = cus;
    }
    if (grid < 0) return;
    Args a{};
    for (int i = 0; i < 17; ++i) a.in[i] = (const float*)d_in[i];
    a.out = (float*)d_out; a.ws = (unsigned char*)d_ws;
#if MK_ONE_LAUNCH
    if (hipMemsetAsync((char*)d_ws + WS_CTL, 0, 65536, stream) != hipSuccess) { fprintf(stderr, "kernel_launch: memset failed\n"); return; }
    a.ph_lo = 0; a.ph_hi = NPHASES;
    void* args[] = {&a};
    hipError_t e = hipLaunchCooperativeKernel((const void*)kerns[0], dim3(grid), dim3(NTHREADS), args, LDS_BYTES, stream);
    if (e != hipSuccess) fprintf(stderr, "cooperative launch failed: %s (grid %d)\n", hipGetErrorString(e), grid);
#else
    for (int ph = 0; ph < NPHASES; ++ph) {
        a.ph_lo = ph; a.ph_hi = ph + 1;
        hipLaunchKernelGGL(kerns[phase_kind(ph)], dim3(grid), dim3(NTHREADS), LDS_BYTES, stream, a);
    }
#endif
}
```

```cpp
#include <hip/hip_runtime.h>
#include <hip/hip_cooperative_groups.h>
#include <cstdio>
#include <cstdint>
namespace cg = cooperative_groups;

#ifndef PROBE_DUP
#define PROBE_DUP 0
#endif
#ifndef MK_ONE_LAUNCH
#define MK_ONE_LAUNCH 1
#endif

#define LAS __attribute__((address_space(3)))
typedef unsigned short bf16_t;
typedef short bf16x8 __attribute__((ext_vector_type(8)));
typedef float f32x4 __attribute__((ext_vector_type(4)));
typedef float f32x16 __attribute__((ext_vector_type(16)));
typedef unsigned u32x4 __attribute__((ext_vector_type(4)));
typedef unsigned u32x2 __attribute__((ext_vector_type(2)));
typedef LAS unsigned char lds_u8;

constexpr int NB = 8, SEQ = 2048, DM = 1024, M = NB * SEQ, DEPTH = 4, INW = 2560, FF = 2816, UPW = 2 * FF;
constexpr float EPS = 1e-6f;
constexpr int C_AQ = 0, C_AK = 384, C_AV = 512, C_BQ = 640, C_BFF = 896, C_BFB = 1152, C_BI = 1408, C_BG = 1664, C_CQ = 1920, C_CK = 2304, C_CV = 2432;

constexpr size_t MiB = 1u << 20;
constexpr size_t WS_CTL = 0;
constexpr size_t WS_MOD = 1 * MiB;
constexpr size_t WS_ROPE = 2 * MiB;
constexpr size_t WS_WIN = 4 * MiB;
constexpr size_t WS_WOUT = 24 * MiB;
constexpr size_t WS_WUP = 32 * MiB;
constexpr size_t WS_WDN = 76 * MiB;
constexpr size_t WS_H = 98 * MiB;
constexpr size_t WS_PROJ = 130 * MiB;
constexpr size_t WS_MIX = 210 * MiB;
constexpr size_t WS_HL = 242 * MiB;
constexpr size_t WS_HD = 274 * MiB;
constexpr size_t WS_VT = 275 * MiB;
constexpr size_t WS_ACT = 190 * MiB;
constexpr size_t WS_HS = 283 * MiB;
constexpr size_t WS_PO = 300 * MiB;
constexpr size_t WS_PL = 326 * MiB;
constexpr size_t WS_XB = 332 * MiB;
constexpr size_t WS_U = 330 * MiB;
constexpr size_t WS_END = 366 * MiB;

constexpr int LDS_BYTES = 147456;
constexpr int NTHREADS = 512;

typedef float f32x2_t __attribute__((ext_vector_type(2))); typedef __bf16 bf16x2_t __attribute__((ext_vector_type(2)));
__device__ __forceinline__ unsigned pk2(float lo, float hi) { f32x2_t v = {lo, hi}; bf16x2_t b = __builtin_convertvector(v, bf16x2_t); return __builtin_bit_cast(unsigned, b); }
__device__ __forceinline__ unsigned f2bf(float f) { return pk2(f, 0.f) & 0xffffu; }
__device__ __forceinline__ float bf2f(unsigned short h) { return __builtin_bit_cast(float, (unsigned)h << 16); }
__device__ __forceinline__ float bflo(unsigned w) { return __builtin_bit_cast(float, w << 16); }
__device__ __forceinline__ float bfhi(unsigned w) { return __builtin_bit_cast(float, w & 0xffff0000u); }
__device__ __forceinline__ float wave_sum(float v) {
#pragma unroll
    for (int o = 1; o < 64; o <<= 1) v += __shfl_xor(v, o);
    return v;
}
__device__ __forceinline__ float fast_exp2(float x) { return __builtin_amdgcn_exp2f(x); }
__device__ __forceinline__ float fast_exp(float x) { return __builtin_amdgcn_exp2f(x * 1.4426950408889634f); }
__device__ __forceinline__ float silu_f(float x) { return x * __builtin_amdgcn_rcpf(1.0f + fast_exp2(-1.4426950408889634f * x)); }

__device__ __forceinline__ float dpp_ror1(float v) { return __builtin_bit_cast(float, __builtin_amdgcn_update_dpp(0, __builtin_bit_cast(int, v), 0x121, 0xf, 0xf, true)); }
__device__ __forceinline__ float dpp_ror15(float v) { return __builtin_bit_cast(float, __builtin_amdgcn_update_dpp(0, __builtin_bit_cast(int, v), 0x12f, 0xf, 0xf, true)); }
__device__ __forceinline__ float dpp_shr1(float old, float v) { return __builtin_bit_cast(float, __builtin_amdgcn_update_dpp(__builtin_bit_cast(int, old), __builtin_bit_cast(int, v), 0x111, 0xf, 0xf, false)); }
__device__ __forceinline__ float dpp_shl1(float old, float v) { return __builtin_bit_cast(float, __builtin_amdgcn_update_dpp(__builtin_bit_cast(int, old), __builtin_bit_cast(int, v), 0x101, 0xf, 0xf, false)); }

namespace pg8 {
constexpr int BM = 256, BK = 64, HALF = 128, HTB = HALF * BK * 2, STAGE_BYTES = 8 * HTB, NXCD = 8, WGM = 8;
__host__ __device__ __forceinline__ int lds_byte(int r, int c) { const int st = (r >> 4) * 2 + (c >> 5), rr = r & 15, cc = c & 31, ob = rr * 64 + cc * 2; return st * 1024 + (ob ^ (((ob >> 9) & 1) << 5)); }
__host__ __device__ __forceinline__ void stage_rc(int b, int& R, int& C) { const int st = b / 1024, sb = b % 1024, swz = sb ^ (((sb >> 9) & 1) << 5); R = (st >> 1) * 16 + swz / 64; C = (st & 1) * 32 + (swz % 64) / 2; }
__host__ __device__ __forceinline__ int perm32(int rho) { const int n = rho >> 4, i = rho & 15; return 8 * (i >> 2) + 4 * n + (i & 3); }

struct Unit { int pm, pn, ar; };
struct Gemm { const bf16_t* A; const bf16_t* Bt; int M, N, K; };

struct StaticOrder {
    int nM, nN, nwg, G, c, conv, Mrows;
    __host__ __device__ void init(int M_, int N_, int G_, int c_, int conv_ = 0) { conv = conv_; Mrows = M_; nM = conv_ ? (M_ + 253) / 254 : M_ / BM; nN = N_ / BM; nwg = nM * nN; G = G_; c = c_; }
    __host__ __device__ bool next(int i, Unit& u) const {
        const long L = (long)i * G + c; if (L >= nwg) return false;
        int wgid = (int)L; { const int q = nwg / NXCD, r = nwg % NXCD, xcd = wgid % NXCD, off = wgid / NXCD; wgid = (xcd < r ? xcd * (q + 1) : r * (q + 1) + (xcd - r) * q) + off; }
        const int nig = WGM * nN, gid = wgid / nig, fm = gid * WGM, gsz = (nM - fm) < WGM ? (nM - fm) : WGM;
        u.pm = fm + ((wgid % nig) % gsz); u.pn = (wgid % nig) / gsz;
        if (conv) { int s = 254 * u.pm - 1; s = s < 0 ? 0 : s; u.ar = s > Mrows - BM ? Mrows - BM : s; } else u.ar = u.pm * BM;
        return true;
    }
};

struct EpiStore {
    static constexpr bool PERM = true;
    bf16_t* O; int ldc;
    __device__ __forceinline__ void operator()(const f32x4 (&acc)[2][2][4][2], const Unit& u, int wr, int wc, int fr, int fq, lds_u8*) const {
        const int row0 = u.pm * BM + wr * 64 + fr, col0 = u.pn * BM + wc * 32 + 8 * fq;
#pragma unroll
        for (int ai = 0; ai < 2; ++ai)
#pragma unroll
            for (int m = 0; m < 4; ++m) { bf16_t* rowp = O + (size_t)(row0 + ai * HALF + m * 16) * ldc + col0;
#pragma unroll
                for (int bj = 0; bj < 2; ++bj) { const f32x4 v0 = acc[ai][bj][m][0], v1 = acc[ai][bj][m][1];
                    u32x4 w; w.x = pk2(v0[0], v0[1]); w.y = pk2(v0[2], v0[3]); w.z = pk2(v1[0], v1[1]); w.w = pk2(v1[2], v1[3]);
                    *(u32x4*)(rowp + bj * HALF) = w; } }
    }
};
struct EpiResid {
    static constexpr bool PERM = true;
    unsigned char* ws; const float* xin32; float* out32; const float* normg;
    int l, second, nfuse;
    __device__ __forceinline__ void operator()(f32x4 (&acc)[2][2][4][2], const Unit& u, int wr, int wc, int fr, int fq, lds_u8* lds) const {
        const int col0 = u.pn * BM + wc * 32 + 8 * fq;
        const int bidx = (u.pm * BM) / SEQ;
        bf16_t* const xb16 = (bf16_t*)(ws + WS_XB);
        const float* const modl = (const float*)(ws + WS_MOD) + (size_t)l * 8 * 6144;
        const float* const gate = modl + (second ? 5 : 2) * DM;
        const float* const ng = normg + (size_t)(second ? (l + 1) * 2 : l * 2 + 1) * DM;
        const float* const nmod = second ? modl + 8 * 6144 : modl + 3 * DM;
        const int nidx = nfuse ? l * 2 + second : -1;
        const float* gb = gate + (size_t)bidx * 6144 + col0;
        f32x4 gv[2][2];
#pragma unroll
        for (int bj = 0; bj < 2; ++bj)
#pragma unroll
            for (int n = 0; n < 2; ++n) gv[bj][n] = *(const f32x4*)(gb + bj * HALF + 4 * n);
#pragma unroll
        for (int ai = 0; ai < 2; ++ai)
#pragma unroll
            for (int m = 0; m < 4; ++m) { const size_t off = (size_t)(u.pm * BM + ai * HALF + wr * 64 + m * 16 + fr) * DM + col0;
#pragma unroll
                for (int bj = 0; bj < 2; ++bj) {
                    f32x4 x0, x1;
                    if (xin32) { x0 = *(const f32x4*)(xin32 + off + bj * HALF); x1 = *(const f32x4*)(xin32 + off + bj * HALF + 4); }
                    else { const u32x4 w = *(const u32x4*)(xb16 + off + bj * HALF); x0 = (f32x4){bflo(w.x), bfhi(w.x), bflo(w.y), bfhi(w.y)}; x1 = (f32x4){bflo(w.z), bfhi(w.z), bflo(w.w), bfhi(w.w)}; }
                    const f32x4 y0 = x0 + gv[bj][0] * acc[ai][bj][m][0], y1 = x1 + gv[bj][1] * acc[ai][bj][m][1];
                    acc[ai][bj][m][0] = y0; acc[ai][bj][m][1] = y1;
                    if (out32) { __builtin_nontemporal_store(y0, (f32x4*)(out32 + off + bj * HALF)); __builtin_nontemporal_store(y1, (f32x4*)(out32 + off + bj * HALF + 4)); }
                    else { u32x4 w; w.x = pk2(y0[0], y0[1]); w.y = pk2(y0[2], y0[3]); w.z = pk2(y1[0], y1[1]); w.w = pk2(y1[2], y1[3]); *(u32x4*)(xb16 + off + bj * HALF) = w; }
                } }
        if (nidx < 0) return;
        asm volatile("" : "+v"(fr), "+v"(fq));
        bf16_t* const hn = (bf16_t*)(ws + WS_H); float* const slots = (float*)(ws + WS_CTL + 512 * 1024); unsigned* const cnt = (unsigned*)(ws + WS_CTL) + 8192 + nidx * 1024;
        LAS float* P = (LAS float*)(lds + STAGE_BYTES);
        LAS float* S = P + 1024;
#pragma unroll
        for (int ai = 0; ai < 2; ++ai)
#pragma unroll
            for (int m = 0; m < 4; ++m) { float s = 0.f;
#pragma unroll
                for (int bj = 0; bj < 2; ++bj)
#pragma unroll
                    for (int n = 0; n < 2; ++n) { const f32x4 v = acc[ai][bj][m][n]; s += (v[0] * v[0] + v[1] * v[1]) + (v[2] * v[2] + v[3] * v[3]); }
                s += __shfl_xor(s, 16); s += __shfl_xor(s, 32);
                if (fq == 0) P[(ai * HALF + wr * 64 + m * 16 + fr) * 4 + wc] = s; }
        asm volatile("s_waitcnt lgkmcnt(0)" ::: "memory"); __builtin_amdgcn_s_barrier(); asm volatile("" ::: "memory");
        const int tid = (wr * 4 + wc) * 64 + fr + 16 * fq;
        unsigned* slot_u = (unsigned*)slots + ((size_t)u.pm * BM) * 4;
        if (tid < 256) { const float t = (P[tid * 4] + P[tid * 4 + 1]) + (P[tid * 4 + 2] + P[tid * 4 + 3]);
            __hip_atomic_store(slot_u + tid * 4 + u.pn, __builtin_bit_cast(unsigned, t), __ATOMIC_RELAXED, __HIP_MEMORY_SCOPE_AGENT); }
        asm volatile("s_waitcnt vmcnt(0)" ::: "memory"); __builtin_amdgcn_s_barrier(); asm volatile("" ::: "memory");
        if (tid == 0) {
            unsigned* c = cnt + u.pm * 16;
            __builtin_amdgcn_fence(__ATOMIC_RELEASE, "agent");
            asm volatile("s_waitcnt vmcnt(0)" ::: "memory");
            (void)__hip_atomic_fetch_add(c, 1u, __ATOMIC_RELAXED, __HIP_MEMORY_SCOPE_AGENT);
            unsigned sp = 0u;
            while (__hip_atomic_load(c, __ATOMIC_RELAXED, __HIP_MEMORY_SCOPE_AGENT) < 4u) { __builtin_amdgcn_s_sleep(1); if (++sp > (1u << 22)) break; }
            __builtin_amdgcn_fence(__ATOMIC_ACQUIRE, "agent");
            asm volatile("s_waitcnt vmcnt(0)" ::: "memory");
        }
        __builtin_amdgcn_s_barrier(); asm volatile("" ::: "memory");
        if (tid < 256) { float t = 0.f;
#pragma unroll
            for (int p = 0; p < 4; ++p) t += __builtin_bit_cast(float, __hip_atomic_load(slot_u + tid * 4 + p, __ATOMIC_RELAXED, __HIP_MEMORY_SCOPE_AGENT));
            S[tid] = rsqrtf(t * (1.f / DM) + EPS); }
        asm volatile("s_waitcnt lgkmcnt(0)" ::: "memory"); __builtin_amdgcn_s_barrier(); asm volatile("" ::: "memory");
        const float* shp = nmod + (size_t)bidx * 6144 + col0; const float* scp = shp + DM; const float* gp = ng + col0;
#pragma unroll
        for (int bj = 0; bj < 2; ++bj)
#pragma unroll
            for (int n = 0; n < 2; ++n) {
                const f32x4 gn = *(const f32x4*)(gp + bj * HALF + 4 * n) * (*(const f32x4*)(scp + bj * HALF + 4 * n) + 1.0f), sn = *(const f32x4*)(shp + bj * HALF + 4 * n);
#pragma unroll
                for (int ai = 0; ai < 2; ++ai)
#pragma unroll
                    for (int m = 0; m < 4; ++m) { const int rl = ai * HALF + wr * 64 + m * 16 + fr; const float rstd = S[rl];
                        const f32x4 h0 = acc[ai][bj][m][n] * rstd * gn + sn;
                        u32x2 w; w.x = pk2(h0[0], h0[1]); w.y = pk2(h0[2], h0[3]);
                        *(u32x2*)(hn + (size_t)(u.pm * BM + rl) * DM + col0 + bj * HALF + 4 * n) = w; }
            }
    }
};

struct EpiConvGate {
    static constexpr bool PERM = true;
    bf16_t* act; const float* cw; const float* cb;
    __device__ __forceinline__ void operator()(const f32x4 (&acc)[2][2][4][2], const Unit& u, int wr, int wc, int fr, int fq, lds_u8* lds) const {
        LAS float* xch = (LAS float*)(lds + STAGE_BYTES);
        int colw = wc * 32 + 8 * fq; asm volatile("" : "+v"(colw));
#pragma unroll
        for (int ai = 0; ai < 2; ++ai) { const int rho = 2 * ai + wr;
#pragma unroll
            for (int bj = 0; bj < 2; ++bj)
#pragma unroll
                for (int n = 0; n < 2; ++n) {
                    if (fr == 0) *(LAS f32x4*)(xch + (rho * 2) * 256 + bj * 128 + colw + 4 * n) = acc[ai][bj][0][n];
                    if (fr == 15) *(LAS f32x4*)(xch + (rho * 2 + 1) * 256 + bj * 128 + colw + 4 * n) = acc[ai][bj][3][n]; } }
        asm volatile("s_waitcnt lgkmcnt(0)" ::: "memory"); __builtin_amdgcn_s_barrier(); asm volatile("" ::: "memory");
        const int jcol = u.pn * 128 + colw;
        const int olo = 254 * u.pm, ohi = (olo + 254 < M) ? olo + 254 : M;
#pragma unroll
        for (int n = 0; n < 2; ++n) {
            const int ja = jcol + 4 * n, jb = FF + ja;
            const f32x4 wa0 = *(const f32x4*)(cw + ja), wa1 = *(const f32x4*)(cw + UPW + ja), wa2 = *(const f32x4*)(cw + 2 * UPW + ja), ba = *(const f32x4*)(cb + ja);
            const f32x4 wb0 = *(const f32x4*)(cw + jb), wb1 = *(const f32x4*)(cw + UPW + jb), wb2 = *(const f32x4*)(cw + 2 * UPW + jb), bb = *(const f32x4*)(cb + jb);
#pragma unroll
            for (int ai = 0; ai < 2; ++ai) {
                const int rho = 2 * ai + wr;
                const f32x4 z4 = (f32x4){0.f, 0.f, 0.f, 0.f};
#pragma unroll
                for (int m = 0; m < 4; ++m) {
                    f32x4 Xa = z4, Xb = z4, Ya = z4, Yb = z4;
                    if (m == 0 && rho > 0) { Xa = *(const LAS f32x4*)(xch + ((rho - 1) * 2 + 1) * 256 + colw + 4 * n); Xb = *(const LAS f32x4*)(xch + ((rho - 1) * 2 + 1) * 256 + 128 + colw + 4 * n); }
                    if (m == 3 && rho < 3) { Ya = *(const LAS f32x4*)(xch + ((rho + 1) * 2) * 256 + colw + 4 * n); Yb = *(const LAS f32x4*)(xch + ((rho + 1) * 2) * 256 + 128 + colw + 4 * n); }
                    const int gr = u.ar + ai * HALF + wr * 64 + m * 16 + fr;
                    const int t = gr & (SEQ - 1);
                    const bool hasp = t != 0, hasn = t != SEQ - 1;
                    const f32x4 va = acc[ai][0][m][n], vb = acc[ai][1][m][n];
                    f32x4 pa, pb, na, nb;
#pragma unroll
                    for (int j = 0; j < 4; ++j) {
                        pa[j] = dpp_shr1(m > 0 ? dpp_ror1(acc[ai][0][m > 0 ? m - 1 : 0][n][j]) : Xa[j], va[j]);
                        pb[j] = dpp_shr1(m > 0 ? dpp_ror1(acc[ai][1][m > 0 ? m - 1 : 0][n][j]) : Xb[j], vb[j]);
                        na[j] = dpp_shl1(m < 3 ? dpp_ror15(acc[ai][0][m < 3 ? m + 1 : 3][n][j]) : Ya[j], va[j]);
                        nb[j] = dpp_shl1(m < 3 ? dpp_ror15(acc[ai][1][m < 3 ? m + 1 : 3][n][j]) : Yb[j], vb[j]);
                    }
                    const float fp = hasp ? 1.0f : 0.0f, fn = hasn ? 1.0f : 0.0f;
                    const f32x4 ca = ba + (wa0 * fp) * pa + wa1 * va + (wa2 * fn) * na;
                    const f32x4 cbv = bb + (wb0 * fp) * pb + wb1 * vb + (wb2 * fn) * nb;
                    const f32x4 ex = ca * -1.4426950408889634f;
                    f32x4 sg;
#pragma unroll
                    for (int j = 0; j < 4; ++j) sg[j] = __builtin_amdgcn_rcpf(1.0f + fast_exp2(ex[j]));
                    const f32x4 r = ca * sg * cbv;
                    if (gr >= olo && gr < ohi) { u32x2 w; w.x = pk2(r[0], r[1]); w.y = pk2(r[2], r[3]); *(u32x2*)(act + (size_t)gr * FF + ja) = w; }
                }
            }
        }
    }
};

template <class Epi, class Sched>
__device__ __forceinline__ void gemm_phase(lds_u8* lds, const Gemm g, const Sched& S, const Epi& E, const int tid) {
    const int wid = __builtin_amdgcn_readfirstlane(tid >> 6), lane = tid & 63, wr = wid >> 2, wc = wid & 3, fr = lane & 15, fq = lane >> 4;
    const int K = g.K, nt = K / BK;
    unsigned voffA[2], voffB[2];
#pragma unroll
    for (int i = 0; i < 2; ++i) { int R, C; stage_rc(tid * 16 + i * 8192, R, C); const int Rb = Epi::PERM ? ((R & ~31) + perm32(R & 31)) : R;
        voffA[i] = (unsigned)(R * K + C) * 2u; voffB[i] = (unsigned)(Rb * K + C) * 2u; }
    const size_t kstep = (size_t)(BK * 2);
    const size_t hstep = (size_t)HALF * K * 2;
    const size_t tstep = 2 * hstep;
    const unsigned ldsw = (unsigned)wid * 1024u;
    const int aoff = lds_byte(wr * 64 + fr, fq * 8), boff = lds_byte(wc * 32 + fr, fq * 8);
#define PG8_SA(b, h) (((b) * 2 + (h)) * HTB)
#define PG8_SB(b, h) ((4 + (b) * 2 + (h)) * HTB)
#define PG8_STAGE(bufoff, gbase, voff) do { _Pragma("unroll") for (int _i = 0; _i < 2; ++_i) \
        __builtin_amdgcn_global_load_lds((const unsigned*)((const char*)(gbase) + (voff)[_i]), (LAS unsigned*)(lds + (bufoff) + ldsw + _i * 8192), 16, 0, 0); } while (0)
#define PG8_LDA(dst, b, h) do { _Pragma("unroll") for (int m = 0; m < 4; ++m) _Pragma("unroll") for (int k = 0; k < 2; ++k) dst[m][k] = *(const LAS bf16x8*)(lds + PG8_SA(b, h) + aoff + m * 2048 + k * 1024); } while (0)
#define PG8_LDB(dst, b, h) do { _Pragma("unroll") for (int n = 0; n < 2; ++n) _Pragma("unroll") for (int k = 0; k < 2; ++k) dst[n][k] = *(const LAS bf16x8*)(lds + PG8_SB(b, h) + boff + n * 2048 + k * 1024); } while (0)
#define PG8_MMA(ai, bj, At, Bt) do { __builtin_amdgcn_s_setprio(1); _Pragma("unroll") for (int m = 0; m < 4; ++m) _Pragma("unroll") for (int n = 0; n < 2; ++n) _Pragma("unroll") for (int k = 0; k < 2; ++k) \
        acc[ai][bj][m][n] = __builtin_amdgcn_mfma_f32_16x16x32_bf16(Bt[n][k], At[m][k], acc[ai][bj][m][n], 0, 0, 0); __builtin_amdgcn_s_setprio(0); } while (0)
#define PG8_WAIT_V(n) asm volatile("s_waitcnt vmcnt(" #n ")" ::: "memory")
#define PG8_WAIT_L(n) asm volatile("s_waitcnt lgkmcnt(" #n ")" ::: "memory")
#define PG8_BAR __builtin_amdgcn_s_barrier()
#define PG8_SCHED __builtin_amdgcn_sched_barrier(0)
    Unit cur, nxt; int ui = 0;
    if (!S.next(0, cur)) return;
    f32x4 acc[2][2][4][2];
#pragma unroll
    for (int a = 0; a < 2; ++a)
#pragma unroll
        for (int b = 0; b < 2; ++b)
#pragma unroll
            for (int m = 0; m < 4; ++m)
#pragma unroll
                for (int n = 0; n < 2; ++n) acc[a][b][m][n] = (f32x4){0.f, 0.f, 0.f, 0.f};
    bf16x8 At[4][2], B0[2][2], B1[2][2];
    const char* cA = (const char*)g.A + (size_t)cur.ar * (size_t)(K * 2); const char* cB = (const char*)g.Bt + (size_t)cur.pn * tstep;
    PG8_STAGE(PG8_SB(0, 0), cB, voffB); PG8_STAGE(PG8_SB(0, 1), cB + hstep, voffB); PG8_STAGE(PG8_SA(0, 0), cA, voffA); PG8_STAGE(PG8_SA(0, 1), cA + hstep, voffA);
    if (wr == 1) PG8_BAR;
    PG8_WAIT_V(2); PG8_BAR;
    PG8_STAGE(PG8_SB(1, 0), cB + kstep, voffB); PG8_STAGE(PG8_SA(1, 0), cA + kstep, voffA); PG8_STAGE(PG8_SB(1, 1), cB + hstep + kstep, voffB);
    PG8_WAIT_V(6); PG8_BAR;
    for (;;) {
        const bool has_next = S.next(ui + 1, nxt);
        const char* nA = has_next ? (const char*)g.A + (size_t)nxt.ar * (size_t)(K * 2) : cA; const char* nB = has_next ? (const char*)g.Bt + (size_t)nxt.pn * tstep : cB;
        for (int t = 0; t < nt; t += 2) {
            const bool last = (t == nt - 2);
            const char* a1 = cA + (size_t)(t + 1) * kstep;
            const char* a2 = last ? nA : cA + (size_t)(t + 2) * kstep; const char* b2 = last ? nB : cB + (size_t)(t + 2) * kstep;
            const char* a3 = a2 + kstep; const char* b3 = b2 + kstep;
            PG8_LDB(B0, 0, 0); PG8_LDB(B1, 0, 1); PG8_SCHED; PG8_LDA(At, 0, 0); PG8_STAGE(PG8_SA(1, 1), a1 + hstep, voffA);
            PG8_WAIT_V(8); PG8_WAIT_L(0); PG8_BAR; PG8_MMA(0, 0, At, B0); PG8_MMA(0, 1, At, B1); PG8_BAR; PG8_SCHED;
            PG8_LDA(At, 0, 1); PG8_STAGE(PG8_SB(0, 0), b2, voffB); PG8_STAGE(PG8_SB(0, 1), b2 + hstep, voffB); PG8_STAGE(PG8_SA(0, 0), a2, voffA);
            PG8_WAIT_V(8); PG8_WAIT_L(0); PG8_BAR; PG8_MMA(1, 0, At, B0); PG8_MMA(1, 1, At, B1); PG8_BAR; PG8_SCHED;
            PG8_LDB(B0, 1, 0); PG8_LDB(B1, 1, 1); PG8_SCHED; PG8_LDA(At, 1, 0); PG8_STAGE(PG8_SA(0, 1), a2 + hstep, voffA);
            PG8_WAIT_V(8); PG8_WAIT_L(0); PG8_BAR; PG8_MMA(0, 0, At, B0); PG8_MMA(0, 1, At, B1); PG8_BAR; PG8_SCHED;
            PG8_LDA(At, 1, 1); PG8_STAGE(PG8_SB(1, 0), b3, voffB); PG8_STAGE(PG8_SB(1, 1), b3 + hstep, voffB); PG8_STAGE(PG8_SA(1, 0), a3, voffA);
            PG8_WAIT_V(8); PG8_WAIT_L(0); PG8_BAR; PG8_MMA(1, 0, At, B0); PG8_MMA(1, 1, At, B1); PG8_BAR; PG8_SCHED;
        }
        if (wr == 0) PG8_BAR;
        E(acc, cur, wr, wc, fr, fq, lds);
        if (!has_next) break;
#pragma unroll
        for (int a = 0; a < 2; ++a)
#pragma unroll
            for (int b = 0; b < 2; ++b)
#pragma unroll
                for (int m = 0; m < 4; ++m)
#pragma unroll
                    for (int n = 0; n < 2; ++n) acc[a][b][m][n] = (f32x4){0.f, 0.f, 0.f, 0.f};
        cur = nxt; cA = nA; cB = nB; ++ui;
        if (wr == 1) PG8_BAR;
    }
    PG8_WAIT_V(0);
    PG8_BAR;
#undef PG8_SA
#undef PG8_SB
#undef PG8_STAGE
#undef PG8_LDA
#undef PG8_LDB
#undef PG8_MMA
#undef PG8_WAIT_V
#undef PG8_WAIT_L
#undef PG8_BAR
#undef PG8_SCHED
}
}

struct Args {
    const float* in[17];
    float* out; unsigned char* ws;
    int ph_lo, ph_hi;
};
enum { I_X = 0, I_C, I_WADA, I_BADA, I_NORMG, I_WIN, I_AQN, I_AKN, I_BLB, I_BON, I_CQN, I_CKN, I_WOUT, I_WUP, I_CONVW, I_CONVB, I_WDOWN };

__device__ __forceinline__ void p0_transpose_item(const float* W, int K, int N, bf16_t* WT, int mode, LAS float* scr, int item, int lane) {
    const int nblk = N / 32, kb = item / nblk, nb = item % nblk, k0 = 64 * kb, n0 = 32 * nb;
    int rbase = n0;
    if (mode == 1) { const int isb = n0 / FF, j0 = n0 % FF; rbase = 256 * (j0 / 128) + (j0 % 128) + 128 * isb; }
    { float tmp[32];
#pragma unroll
      for (int i = 0; i < 32; ++i) { const int kk = 2 * i + (lane >> 5); tmp[i] = __builtin_nontemporal_load(&W[(size_t)(k0 + kk) * N + n0 + (lane & 31)]); }
#pragma unroll
      for (int i = 0; i < 32; ++i) { const int kk = 2 * i + (lane >> 5); scr[kk * 33 + (lane & 31)] = tmp[i]; } }
    asm volatile("s_waitcnt lgkmcnt(0)" ::: "memory");
    const int c = lane & 7;
#pragma unroll
    for (int j = 0; j < 4; ++j) { const int n = (lane >> 3) + 8 * j; const LAS float* s = scr + (8 * c) * 33 + n;
        u32x4 o; o.x = pk2(s[0 * 33], s[1 * 33]); o.y = pk2(s[2 * 33], s[3 * 33]); o.z = pk2(s[4 * 33], s[5 * 33]); o.w = pk2(s[6 * 33], s[7 * 33]);
        *(u32x4*)(WT + (size_t)(rbase + n) * K + k0 + 8 * c) = o; }
    asm volatile("s_waitcnt lgkmcnt(0)" ::: "memory");
}

__device__ __forceinline__ void phase_prologue(const Args& a, lds_u8* lds, int vcu, int G, const int tid, const int bx) {
    const int lane = tid & 63, wave = tid >> 6;
    unsigned char* ws = a.ws;
    if (bx == 0) {
        float* tb = (float*)(ws + WS_ROPE);
        for (int e = tid; e < 1024; e += NTHREADS) { const int pos = e >> 4, i = e & 15; const float inv = exp2f(-(float)i * (13.287712379549449f / 16.0f)); const float ang = (float)pos * inv;
            tb[2 * e] = cosf(ang); tb[2 * e + 1] = sinf(ang); }
    }
    {
        LAS float* sc = (LAS float*)(lds + 0);
        LAS float* red = (LAS float*)(lds + 32768);
        bool have = false;
        for (int it = vcu; it < DEPTH * 96; it += G) {
            if (!have) { const float* c = a.in[I_C];
                for (int e = tid; e < NB * DM; e += NTHREADS) { const int b = e >> 10, k = e & 1023; sc[k * 8 + b] = silu_f(c[e]); }
                have = true; __syncthreads(); }
            const int l = it / 96, n0 = 64 * (it % 96);
            const float* wp = a.in[I_WADA] + ((size_t)l * DM + 128 * wave) * 6144 + n0 + lane;
            float acc[8];
#pragma unroll
            for (int b = 0; b < 8; ++b) acc[b] = 0.f;
#pragma unroll 32
            for (int kk = 0; kk < 128; ++kk) { const float wv = __builtin_nontemporal_load(&wp[(size_t)kk * 6144]); const LAS f32x4* s4 = (const LAS f32x4*)(sc + (128 * wave + kk) * 8); const f32x4 s0 = s4[0], s1 = s4[1];
                acc[0] += s0[0] * wv; acc[1] += s0[1] * wv; acc[2] += s0[2] * wv; acc[3] += s0[3] * wv; acc[4] += s1[0] * wv; acc[5] += s1[1] * wv; acc[6] += s1[2] * wv; acc[7] += s1[3] * wv; }
#pragma unroll
            for (int b = 0; b < 8; ++b) red[(wave * 8 + b) * 64 + lane] = acc[b];
            __syncthreads();
            { const int b = tid >> 6, col = tid & 63; float s = 0.f;
#pragma unroll
              for (int w = 0; w < 8; ++w) s += red[(w * 8 + b) * 64 + col];
              ((float*)(ws + WS_MOD))[((size_t)l * 8 + b) * 6144 + n0 + col] = s + a.in[I_BADA][(size_t)l * 6144 + n0 + col]; }
            __syncthreads();
        }
        __syncthreads();
    }
    {
        LAS float* scr = (LAS float*)(lds + wave * 8448);
        const int gw = vcu * 8 + wave, NGW = G * 8;
        constexpr int I_IN = 16 * (INW / 32), I_OUT = 16 * (DM / 32), I_UP = 16 * (UPW / 32), I_DN = (FF / 64) * (DM / 32), I_LAYER = I_IN + I_OUT + I_UP + I_DN;
        const int nheavy = (DEPTH * 96 > G && DEPTH * 96 < 2 * G) ? DEPTH * 96 - G : 0, nlight = G - nheavy;
        const int npre = nheavy ? 3 * nlight * 8 : 0;
        for (int pass = 0; pass < 2; ++pass) {
            int it0, ie, st;
            if (pass == 0) { if (!nheavy || vcu < nheavy) continue; it0 = (vcu - nheavy) * 8 + wave; ie = npre; st = nlight * 8; }
            else { it0 = npre + gw; ie = DEPTH * I_LAYER; st = NGW; }
            for (int it = it0; it < ie; it += st) {
                const int l = it / I_LAYER; int r = it % I_LAYER;
                if (r < I_IN) { p0_transpose_item(a.in[I_WIN] + (size_t)l * DM * INW, DM, INW, (bf16_t*)(ws + WS_WIN) + (size_t)l * INW * DM, 0, scr, r, lane); continue; } r -= I_IN;
                if (r < I_OUT) { p0_transpose_item(a.in[I_WOUT] + (size_t)l * DM * DM, DM, DM, (bf16_t*)(ws + WS_WOUT) + (size_t)l * DM * DM, 0, scr, r, lane); continue; } r -= I_OUT;
                if (r < I_UP) { p0_transpose_item(a.in[I_WUP] + (size_t)l * DM * UPW, DM, UPW, (bf16_t*)(ws + WS_WUP) + (size_t)l * UPW * DM, 1, scr, r, lane); continue; } r -= I_UP;
                p0_transpose_item(a.in[I_WDOWN] + (size_t)l * FF * DM, FF, DM, (bf16_t*)(ws + WS_WDN) + (size_t)l * DM * FF, 0, scr, r, lane);
            }
        }
    }
}

__device__ __forceinline__ void norm_rows4(const float* x, const float* g, const float* mod_l  , int which_sh, bf16_t* h, int m0, int lane) {
    const int b = m0 / SEQ;
    const f32x4* gr = (const f32x4*)g + lane;
    const f32x4* shr = (const f32x4*)(mod_l + (size_t)b * 6144 + which_sh * DM) + lane;
    const f32x4* scr = (const f32x4*)(mod_l + (size_t)b * 6144 + (which_sh + 1) * DM) + lane;
    f32x4 v[4][4];
#pragma unroll
    for (int r = 0; r < 4; ++r) { const f32x4* xr = (const f32x4*)(x + (size_t)(m0 + r) * DM) + lane;
#pragma unroll
        for (int j = 0; j < 4; ++j) v[r][j] = xr[64 * j]; }
    f32x4 gs[4], sh[4];
#pragma unroll
    for (int j = 0; j < 4; ++j) { gs[j] = gr[64 * j] * (scr[64 * j] + 1.0f); sh[j] = shr[64 * j]; }
#pragma unroll
    for (int r = 0; r < 4; ++r) {
        float s = 0.f;
#pragma unroll
        for (int j = 0; j < 4; ++j) s += (v[r][j].x * v[r][j].x + v[r][j].y * v[r][j].y) + (v[r][j].z * v[r][j].z + v[r][j].w * v[r][j].w);
        const float rstd = rsqrtf(wave_sum(s) * (1.f / DM) + EPS);
        u32x2* o8 = (u32x2*)(h + (size_t)(m0 + r) * DM) + lane;
#pragma unroll
        for (int j = 0; j < 4; ++j) { const f32x4 y = v[r][j] * rstd * gs[j] + sh[j];
            u32x2 w; w.x = pk2(y.x, y.y); w.y = pk2(y.z, y.w); o8[64 * j] = w; }
    }
}
__device__ __forceinline__ void norm_rows4_bf(const bf16_t* x, const float* g, const float* mod_l  , int which_sh, bf16_t* h, int m0, int lane) {
    const int b = m0 / SEQ;
    const float* shp = mod_l + (size_t)b * 6144 + which_sh * DM; const float* scp = shp + DM;
    u32x4 raw[4][2];
#pragma unroll
    for (int r = 0; r < 4; ++r) { const u32x4* xr = (const u32x4*)(x + (size_t)(m0 + r) * DM) + lane; raw[r][0] = xr[0]; raw[r][1] = xr[64]; }
    f32x4 gs[2][2], sh[2][2];
#pragma unroll
    for (int c = 0; c < 2; ++c)
#pragma unroll
        for (int q = 0; q < 2; ++q) { const int col = 512 * c + 8 * lane + 4 * q; gs[c][q] = *(const f32x4*)(g + col) * (*(const f32x4*)(scp + col) + 1.0f); sh[c][q] = *(const f32x4*)(shp + col); }
#pragma unroll
    for (int r = 0; r < 4; ++r) {
        f32x4 v[2][2]; float s = 0.f;
#pragma unroll
        for (int c = 0; c < 2; ++c) { const u32x4 w = raw[r][c]; v[c][0] = (f32x4){bflo(w.x), bfhi(w.x), bflo(w.y), bfhi(w.y)}; v[c][1] = (f32x4){bflo(w.z), bfhi(w.z), bflo(w.w), bfhi(w.w)};
#pragma unroll
            for (int q = 0; q < 2; ++q) s += (v[c][q].x * v[c][q].x + v[c][q].y * v[c][q].y) + (v[c][q].z * v[c][q].z + v[c][q].w * v[c][q].w); }
        const float rstd = rsqrtf(wave_sum(s) * (1.f / DM) + EPS);
        u32x4* o16 = (u32x4*)(h + (size_t)(m0 + r) * DM) + lane;
#pragma unroll
        for (int c = 0; c < 2; ++c) { const f32x4 y0 = v[c][0] * rstd * gs[c][0] + sh[c][0], y1 = v[c][1] * rstd * gs[c][1] + sh[c][1];
            u32x4 w; w.x = pk2(y0.x, y0.y); w.y = pk2(y0.z, y0.w); w.z = pk2(y1.x, y1.y); w.w = pk2(y1.z, y1.w); o16[64 * c] = w; }
    }
}
__device__ __forceinline__ void phase_norm_bf(const bf16_t* x, const float* g, const float* mod_l, int which_sh, bf16_t* h, int vcu, int G, const int tid) {
    const int lane = tid & 63, wave = tid >> 6;
    const int gw = vcu * 8 + wave, NGW = G * 8;
    for (int m0 = gw * 4; m0 < M; m0 += NGW * 4) norm_rows4_bf(x, g, mod_l, which_sh, h, m0, lane);
}
__device__ __forceinline__ void phase_norm(const float* x, const float* g, const float* mod_l, int which_sh, bf16_t* h, int vcu, int G, const int tid) {
    const int lane = tid & 63, wave = tid >> 6;
    const int gw = vcu * 8 + wave, NGW = G * 8;
    for (int m0 = gw * 4; m0 < M; m0 += NGW * 4) norm_rows4(x, g, mod_l, which_sh, h, m0, lane);
}

__device__ __forceinline__ float hgrn_lb(const float* b_lb, int dir, int l, int col) {
    const float* p = b_lb + (size_t)dir * DEPTH * 256 + col;
    const float v0 = p[0], v1 = p[256], v2 = p[512], v3 = p[768];
    const float mx = fmaxf(fmaxf(v0, v1), fmaxf(v2, v3));
    const float e0 = __expf(v0 - mx), e1 = __expf(v1 - mx), e2 = __expf(v2 - mx), e3 = __expf(v3 - mx);
    const float s = e0 + e1 + e2 + e3;
    float acc = 0.f; if (l >= 1) acc += e1; if (l >= 2) acc += e2; if (l >= 3) acc += e3;
    return acc / s;
}
__device__ __forceinline__ void hgrn_fk(float xpre, float lb, float& lf, float& kk) {
    float f = lb + (1.0f - lb) * __builtin_amdgcn_rcpf(1.0f + fast_exp2(-1.4426950408889634f * xpre));
    f = fmaxf(f, 1e-6f);
    lf = __builtin_amdgcn_logf(f); kk = 1.0f - f;
}

__device__ __forceinline__ void phase_prep(const Args& a, lds_u8* lds, int l, int vcu, int G, const int tid, const bool dry) {
    const int lane = tid & 63, wave = tid >> 6;
    const int gw = vcu * 8 + wave, NGW = G * 8;
    unsigned char* ws = a.ws;
    bf16_t* proj = (bf16_t*)(ws + WS_PROJ);
    const float* rope = (const float*)(ws + WS_ROPE);
    {
        const float gak = a.in[I_AKN][l * 64 + lane], gck = a.in[I_CKN][l * 64 + lane];
        const int half = lane >> 5, side = (lane >> 4) & 1, i = lane & 15;
        for (int m0 = gw * 4; m0 < M; m0 += NGW * 4) {
            unsigned short raw[4][4];
#pragma unroll
            for (int r = 0; r < 4; ++r) { const bf16_t* row = proj + (size_t)(m0 + r) * INW;
                raw[r][0] = row[C_AK + lane]; raw[r][1] = row[C_AK + 64 + lane]; raw[r][2] = row[C_CK + lane]; raw[r][3] = row[C_CK + 64 + lane]; }
#pragma unroll
            for (int r = 0; r < 4; ++r) {
                const int m = m0 + r, t = m & (SEQ - 1);
                bf16_t* wrow = (dry ? (bf16_t*)(ws + WS_U) : proj) + (size_t)m * INW;
                const int pos = half ? (t & 63) : (t >> 6);
                const float cs = rope[(pos * 16 + i) * 2], sn = rope[(pos * 16 + i) * 2 + 1];
#pragma unroll
                for (int hh = 0; hh < 2; ++hh) {
                    float v = bf2f(raw[r][hh]);
                    const float ss = wave_sum(v * v);
                    v = v * rsqrtf(ss * (1.f / 64) + EPS) * gak;
                    const float pr = __shfl_xor(v, 16);
                    const float o = side ? (v * cs + pr * sn) : (v * cs - pr * sn);
                    wrow[C_AK + hh * 64 + lane] = (bf16_t)f2bf(o);
                }
#pragma unroll
                for (int hh = 0; hh < 2; ++hh) {
                    float v = bf2f(raw[r][2 + hh]);
                    const float ss = wave_sum(v * v);
                    v = v * rsqrtf(ss * (1.f / 64) + EPS) * gck;
                    wrow[C_CK + hh * 64 + lane] = (bf16_t)f2bf(v);
                }
            }
        }
    }
    {
        LAS bf16_t* scr = (LAS bf16_t*)(lds + wave * 9216);
        bf16_t* vt = (bf16_t*)(ws + WS_VT);
        for (int it = gw; it < NB * 4 * 32; it += NGW) {
            const int b = it >> 7, kv4 = (it >> 5) & 3, tb = it & 31;
            const int col0 = (kv4 < 2 ? C_AV : C_CV) + (kv4 & 1) * 64;
            const bf16_t* src = proj + ((size_t)b * SEQ + tb * 64) * INW + col0 + lane;
#pragma unroll
            for (int rb = 0; rb < 64; rb += 32) { unsigned short tmp[32];
#pragma unroll
              for (int r = 0; r < 32; ++r) tmp[r] = src[(size_t)(rb + r) * INW];
#pragma unroll
              for (int r = 0; r < 32; ++r) scr[(rb + r) * 66 + lane] = tmp[r]; }
            asm volatile("s_waitcnt lgkmcnt(0)" ::: "memory");
            bf16_t* dst = vt + (((size_t)b * 4 + kv4) * 64) * SEQ + tb * 64 + lane;
#pragma unroll 16
            for (int d = 0; d < 64; ++d) dst[(size_t)d * SEQ] = scr[lane * 66 + d];
            asm volatile("s_waitcnt lgkmcnt(0)" ::: "memory");
        }
    }
    {
        LAS bf16_t* klt = (LAS bf16_t*)(lds + wave * 9216);
        float* HL = (float*)(ws + WS_HL); float* HDp = (float*)(ws + WS_HD);
        const int r16 = lane & 15, q4 = lane >> 4;
        for (int it = gw; it < NB * 4 * 2 * 32; it += NGW) {
            const int c = it & 31, dir = (it >> 5) & 1, hh = (it >> 6) & 3, b = it >> 8;
            const float lb = hgrn_lb(a.in[I_BLB], dir, l, hh * 64 + lane);
            const size_t rbase = (size_t)b * SEQ + c * 64;
            const int fcol = (dir ? C_BFB : C_BFF) + hh * 64 + lane;
            unsigned fpk[32];
#pragma unroll
            for (int s = 0; s < 64; s += 2) { const int t0 = dir ? (63 - s) : s, t1 = dir ? (62 - s) : s + 1; fpk[s >> 1] = (unsigned)proj[(rbase + t0) * INW + fcol] | ((unsigned)proj[(rbase + t1) * INW + fcol] << 16); }
            float total = 0.f;
#pragma unroll
            for (int s = 63; s >= 0; --s) { float lf, kk; hgrn_fk((s & 1) ? bfhi(fpk[s >> 1]) : bflo(fpk[s >> 1]), lb, lf, kk);
                klt[lane * 72 + s] = (bf16_t)f2bf(kk * fast_exp2(total)); total += lf; }
            asm volatile("s_waitcnt lgkmcnt(0)" ::: "memory");
            HDp[(size_t)it * 64 + lane] = fast_exp2(total);
            const int vcol = C_BI + hh * 64;
            float* Lo = HL + (size_t)it * 4096;
#pragma unroll
            for (int mi = 0; mi < 4; ++mi) {
                bf16x8 af[2];
#pragma unroll
                for (int ks = 0; ks < 2; ++ks)
#pragma unroll
                    for (int j = 0; j < 8; ++j) { const int s = 32 * ks + 8 * q4 + j; const int tk = dir ? (63 - s) : s; af[ks][j] = (short)proj[(rbase + tk) * INW + vcol + 16 * mi + r16]; }
#pragma unroll
                for (int ni = 0; ni < 4; ++ni) {
                    f32x4 acc = (f32x4){0.f, 0.f, 0.f, 0.f};
#pragma unroll
                    for (int ks = 0; ks < 2; ++ks) { const bf16x8 bfr = *(const LAS bf16x8*)(klt + (16 * ni + r16) * 72 + 32 * ks + 8 * q4);
                        acc = __builtin_amdgcn_mfma_f32_16x16x32_bf16(af[ks], bfr, acc, 0, 0, 0); }
#pragma unroll
                    for (int j = 0; j < 4; ++j) Lo[(16 * mi + 4 * q4 + j) * 64 + 16 * ni + r16] = acc[j];
                }
            }
            asm volatile("s_waitcnt lgkmcnt(0)" ::: "memory");
        }
    }
}

constexpr int AT_KV = 18432;
constexpr int AT_TBL = 4 * AT_KV;
__device__ __forceinline__ int pi32(int m) { return (m & ~12) | ((m & 4) << 1) | ((m & 8) >> 1); }

template <bool BIAS>
__device__ __forceinline__ void attn_unit(lds_u8* lds, const bf16_t* proj, const bf16_t* vt, bf16_t* mix, const bf16_t* po_far, const float* pl, const float* gq, const float* gk, const float* rope,
                                          int b, int h, int qblk, int qcol0, int kcol0, int vsel0, int mixcol0, const int tid) {
    const int lane = tid & 63, wave = __builtin_amdgcn_readfirstlane(tid >> 6);
    const int r32 = lane & 31, hi = lane >> 5;
    const int kvh = h / 3;
    const int q0 = qblk * 256;
    const int qp = q0 + 32 * wave + r32;
    int tlo = 0, ntile = SEQ / 64;
    if (BIAS) { const int klo = q0 - 256 < 0 ? 0 : q0 - 256, khi_ = q0 + 255 + 256 > SEQ - 1 ? SEQ - 1 : q0 + 255 + 256; tlo = klo >> 6; ntile = (khi_ >> 6) - tlo + 1; }
    const bf16_t* kbase = proj + (size_t)b * SEQ * INW + kcol0 + kvh * 64;
    const bf16_t* vbase = vt + ((size_t)b * 4 + vsel0 + kvh) * 64 * SEQ;
    const int lrow_ = tid >> 3, lc16 = tid & 7;
    u32x4 kreg, vreg;
#define AT_LOAD(tile) do { const int key0_ = (tile) * 64; kreg = *(const u32x4*)(kbase + (size_t)(key0_ + lrow_) * INW + lc16 * 8); vreg = *(const u32x4*)(vbase + (size_t)lrow_ * SEQ + key0_ + lc16 * 8); } while (0)
#define AT_STORE(bufi) do { lds_u8* bb_ = lds + (bufi) * AT_KV; *(LAS u32x4*)(bb_ + lrow_ * 144 + lc16 * 16) = kreg; *(LAS u32x4*)(bb_ + 9216 + lrow_ * 144 + lc16 * 16) = vreg; } while (0)
    u32x4 qraw[4];
    { const bf16_t* qrow = proj + ((size_t)b * SEQ + qp) * INW + qcol0 + h * 64 + 8 * hi;
#pragma unroll
      for (int d0 = 0; d0 < 4; ++d0) qraw[d0] = *(const u32x4*)(qrow + 16 * d0); }
    AT_LOAD(tlo);
    const float gql = gq[lane], gkl = gk[lane];
    f32x4 gqv[4][2];
#pragma unroll
    for (int d0 = 0; d0 < 4; ++d0) { gqv[d0][0] = *(const f32x4*)(gq + 16 * d0 + 8 * hi); gqv[d0][1] = *(const f32x4*)(gq + 16 * d0 + 8 * hi + 4); }
    f32x4 rpr[4], rpc[4];
    if (!BIAS) { const int pr = qp >> 6, pc = qp & 63;
#pragma unroll
        for (int j4 = 0; j4 < 4; ++j4) { rpr[j4] = *(const f32x4*)(rope + (pr * 16 + 8 * hi) * 2 + 4 * j4); rpc[j4] = *(const f32x4*)(rope + (pc * 16 + 8 * hi) * 2 + 4 * j4); } }
    float ref;
    { float a = fabsf(gql), c = fabsf(gkl);
#pragma unroll
      for (int o = 1; o < 64; o <<= 1) { a = fmaxf(a, __shfl_xor(a, o)); c = fmaxf(c, __shfl_xor(c, o)); }
      ref = 64.0f * 0.125f * 1.4426950408889634f * 1.02f * a * c + (BIAS ? 1.6f : 0.0f); }
    if (BIAS) {
        LAS float* tbl = (LAS float*)(lds + AT_TBL);
        const float slope = fast_exp2(-(float)(h + 1) * (4.0f / 3.0f));
        for (int e = tid; e < 4096; e += NTHREADS) { const int d = e - 2048, ad = d < 0 ? -d : d;
            const int mult = ad > 256 ? 0 : (ad <= 64 ? 1 : 0) + ((ad & 3) == 0 ? 1 : 0) + ((ad & 15) == 0 ? 1 : 0);
            const float lg = mult == 3 ? 1.5849625007211562f : (mult == 2 ? 1.0f : 0.0f);
            tbl[e] = mult ? (lg - slope * (float)ad * 1.4426950408889634f - ref) : -1e30f; }
    }
    bf16x8 qr[4];
    {
        float v[4][8]; float ss = 0.f;
#pragma unroll
        for (int d0 = 0; d0 < 4; ++d0) { const u32x4 w = qraw[d0];
            v[d0][0] = bflo(w.x); v[d0][1] = bfhi(w.x); v[d0][2] = bflo(w.y); v[d0][3] = bfhi(w.y); v[d0][4] = bflo(w.z); v[d0][5] = bfhi(w.z); v[d0][6] = bflo(w.w); v[d0][7] = bfhi(w.w);
#pragma unroll
            for (int j = 0; j < 8; ++j) ss += v[d0][j] * v[d0][j]; }
        ss += __shfl_xor(ss, 32);
        const float rstd = rsqrtf(ss * (1.f / 64) + EPS);
#pragma unroll
        for (int d0 = 0; d0 < 4; ++d0)
#pragma unroll
            for (int j = 0; j < 8; ++j) v[d0][j] *= rstd * gqv[d0][j >> 2][j & 3];
        if (!BIAS) {
#pragma unroll
            for (int j = 0; j < 8; ++j) {
                { const float c = rpr[j >> 1][2 * (j & 1)], s = rpr[j >> 1][2 * (j & 1) + 1]; const float x1 = v[0][j], x2 = v[1][j]; v[0][j] = x1 * c - x2 * s; v[1][j] = x2 * c + x1 * s; }
                { const float c = rpc[j >> 1][2 * (j & 1)], s = rpc[j >> 1][2 * (j & 1) + 1]; const float x1 = v[2][j], x2 = v[3][j]; v[2][j] = x1 * c - x2 * s; v[3][j] = x2 * c + x1 * s; } }
        }
        const float qsc = 0.125f * 1.4426950408889634f;
#pragma unroll
        for (int d0 = 0; d0 < 4; ++d0) { u32x4 w; w.x = pk2(v[d0][0] * qsc, v[d0][1] * qsc); w.y = pk2(v[d0][2] * qsc, v[d0][3] * qsc); w.z = pk2(v[d0][4] * qsc, v[d0][5] * qsc); w.w = pk2(v[d0][6] * qsc, v[d0][7] * qsc);
            qr[d0] = __builtin_bit_cast(bf16x8, w); }
    }
    AT_STORE(0);
    __syncthreads();
    float lrow = 0.f;
    f32x16 o0, o1, negref;
#pragma unroll
    for (int i = 0; i < 16; ++i) { o0[i] = 0.f; o1[i] = 0.f; negref[i] = -ref; }
    const int krow = pi32(r32);
    for (int step = 0; step < ntile; ++step) {
        const bool ldn = (step + 1 < ntile);
        if (ldn) AT_LOAD(tlo + step + 1);
        {
            const lds_u8* kb = lds + (step & 1) * AT_KV;
            const lds_u8* vb = kb + 9216;
            f32x16 p0, p1;
            if (BIAS) {
                const LAS float* tbl = (const LAS float*)(lds + AT_TBL) + ((tlo + step) * 64 + 8 * hi - qp + 2048);
#pragma unroll
                for (int i = 0; i < 16; ++i) { p0[i] = tbl[(i & 7) + 16 * (i >> 3)]; p1[i] = tbl[(i & 7) + 16 * (i >> 3) + 32]; }
            } else { p0 = negref; p1 = negref; }
#pragma unroll
            for (int d0 = 0; d0 < 4; ++d0) {
                const bf16x8 k0 = *(const LAS bf16x8*)(kb + krow * 144 + 32 * d0 + 16 * hi);
                const bf16x8 k1 = *(const LAS bf16x8*)(kb + (32 + krow) * 144 + 32 * d0 + 16 * hi);
                p0 = __builtin_amdgcn_mfma_f32_32x32x16_bf16(k0, qr[d0], p0, 0, 0, 0);
                p1 = __builtin_amdgcn_mfma_f32_32x32x16_bf16(k1, qr[d0], p1, 0, 0, 0);
            }
            float rs0 = 0.f, rs1 = 0.f;
#pragma unroll
            for (int i = 0; i < 16; ++i) { p0[i] = fast_exp2(p0[i]); p1[i] = fast_exp2(p1[i]); rs0 += p0[i]; rs1 += p1[i]; }
            lrow += rs0 + rs1;
            bf16x8 pb[2][2];
#pragma unroll
            for (int ks = 0; ks < 2; ++ks) {
                u32x4 w; w.x = pk2(p0[8 * ks + 0], p0[8 * ks + 1]); w.y = pk2(p0[8 * ks + 2], p0[8 * ks + 3]); w.z = pk2(p0[8 * ks + 4], p0[8 * ks + 5]); w.w = pk2(p0[8 * ks + 6], p0[8 * ks + 7]);
                pb[0][ks] = __builtin_bit_cast(bf16x8, w);
                u32x4 w1; w1.x = pk2(p1[8 * ks + 0], p1[8 * ks + 1]); w1.y = pk2(p1[8 * ks + 2], p1[8 * ks + 3]); w1.z = pk2(p1[8 * ks + 4], p1[8 * ks + 5]); w1.w = pk2(p1[8 * ks + 6], p1[8 * ks + 7]);
                pb[1][ks] = __builtin_bit_cast(bf16x8, w1);
            }
#pragma unroll
            for (int sub = 0; sub < 2; ++sub)
#pragma unroll
                for (int ks = 0; ks < 2; ++ks) {
                    const bf16x8 v0 = *(const LAS bf16x8*)(vb + r32 * 144 + (32 * sub + 16 * ks + 8 * hi) * 2);
                    const bf16x8 v1 = *(const LAS bf16x8*)(vb + (32 + r32) * 144 + (32 * sub + 16 * ks + 8 * hi) * 2);
                    o0 = __builtin_amdgcn_mfma_f32_32x32x16_bf16(v0, pb[sub][ks], o0, 0, 0, 0);
                    o1 = __builtin_amdgcn_mfma_f32_32x32x16_bf16(v1, pb[sub][ks], o1, 0, 0, 0);
                }
        }
        if (ldn) AT_STORE((step + 1) & 1);
        __syncthreads();
    }
#undef AT_LOAD
#undef AT_STORE
    lrow += __shfl_xor(lrow, 32);
    {
        const size_t grow = (size_t)b * SEQ + qp;
        const bf16_t* fpo = BIAS ? po_far + grow * 384 + h * 64 + 4 * hi : nullptr;
        const float inv = 1.0f / (lrow + (BIAS ? pl[grow * 6 + h] : 0.0f));
        bf16_t* orow = mix + grow * DM + mixcol0 + h * 64 + 4 * hi;
#pragma unroll
        for (int g4 = 0; g4 < 4; ++g4) {
            u32x2 f0 = (u32x2){0u, 0u}, f1 = (u32x2){0u, 0u};
            if (BIAS) { f0 = *(const u32x2*)(fpo + 8 * g4); f1 = *(const u32x2*)(fpo + 32 + 8 * g4); }
            { const float x0 = (o0[4 * g4] + bflo(f0.x)) * inv, x1 = (o0[4 * g4 + 1] + bfhi(f0.x)) * inv, x2 = (o0[4 * g4 + 2] + bflo(f0.y)) * inv, x3 = (o0[4 * g4 + 3] + bfhi(f0.y)) * inv;
              u32x2 w; w.x = pk2(x0, x1); w.y = pk2(x2, x3); *(u32x2*)(orow + 8 * g4) = w; }
            { const float x0 = (o1[4 * g4] + bflo(f1.x)) * inv, x1 = (o1[4 * g4 + 1] + bfhi(f1.x)) * inv, x2 = (o1[4 * g4 + 2] + bflo(f1.y)) * inv, x3 = (o1[4 * g4 + 3] + bfhi(f1.y)) * inv;
              u32x2 w; w.x = pk2(x0, x1); w.y = pk2(x2, x3); *(u32x2*)(orow + 32 + 8 * g4) = w; }
        }
    }
}

__device__ __forceinline__ void attn_r16_unit(lds_u8* lds, const bf16_t* proj, bf16_t* po, float* pl, const float* gq, const float* gk, int b, int kvh, int rho, const int tid) {
    const int lane = tid & 63, wave = __builtin_amdgcn_readfirstlane(tid >> 6);
    const int qs = wave & 3, kh = wave >> 2, r32 = lane & 31, hi = lane >> 5;
    const int iq = 32 * qs + r32;
    const size_t qrow_g = (size_t)b * SEQ + rho + 16 * iq;
    const bf16_t* qrow0 = proj + qrow_g * INW + C_CQ + (kvh * 3) * 64 + 8 * hi;
    u32x4 qcur[4], qnxt[4];
#pragma unroll
    for (int d0 = 0; d0 < 4; ++d0) { qcur[d0] = *(const u32x4*)(qrow0 + 16 * d0); qnxt[d0] = qcur[d0]; }
    u32x4 kst[2], vst[2];
    const int th = tid & 255;
#pragma unroll
    for (int i_ = 0; i_ < 2; ++i_) { const int c_ = th + 256 * i_, row_ = c_ >> 3, c16_ = c_ & 7;
        const bf16_t* src = proj + ((size_t)b * SEQ + rho + 16 * (64 * kh + row_)) * INW + kvh * 64 + c16_ * 8;
        kst[i_] = *(const u32x4*)(src + C_CK); vst[i_] = *(const u32x4*)(src + C_CV); }
    const float gql = gq[lane], gkl = gk[lane];
    float ref;
    { float a = fabsf(gql), c = fabsf(gkl);
#pragma unroll
      for (int o = 1; o < 64; o <<= 1) { a = fmaxf(a, __shfl_xor(a, o)); c = fmaxf(c, __shfl_xor(c, o)); }
      ref = 64.0f * 0.125f * 1.4426950408889634f * 1.02f * a * c + 1.6f; }
    LAS float* tb = (LAS float*)(lds + 40960);
    for (int e = tid; e < 768; e += NTHREADS) { const int hq = e >> 8, d = (e & 255) - 128, ad = d < 0 ? -d : d; const float slope = fast_exp2(-(float)(kvh * 3 + hq + 1) * (4.0f / 3.0f));
        tb[e] = (ad > 16 && ad <= 64) ? (-slope * 16.0f * (float)ad * 1.4426950408889634f - ref) : -1e30f; }
    lds_u8* hb = lds + kh * AT_KV;
#pragma unroll
    for (int i_ = 0; i_ < 2; ++i_) { const int c_ = th + 256 * i_, row_ = c_ >> 3, c16_ = c_ & 7;
        *(LAS u32x4*)(hb + row_ * 144 + c16_ * 16) = kst[i_]; *(LAS u32x4*)(hb + 9216 + row_ * 144 + c16_ * 16) = vst[i_]; }
    __syncthreads();
    const int krow = pi32(r32);
    bf16x8 kf[8], vf[8];
#pragma unroll
    for (int d0 = 0; d0 < 4; ++d0) { kf[2 * d0] = *(const LAS bf16x8*)(hb + krow * 144 + 32 * d0 + 16 * hi); kf[2 * d0 + 1] = *(const LAS bf16x8*)(hb + (32 + krow) * 144 + 32 * d0 + 16 * hi); }
    { const LAS bf16_t* vbase = (const LAS bf16_t*)(hb + 9216);
#pragma unroll
      for (int sub = 0; sub < 2; ++sub)
#pragma unroll
        for (int ks = 0; ks < 2; ++ks)
#pragma unroll
            for (int j = 0; j < 8; ++j) { const int key = 32 * sub + 16 * ks + 8 * hi + j;
                vf[(sub * 2 + ks) * 2][j] = (short)vbase[key * 72 + r32]; vf[(sub * 2 + ks) * 2 + 1][j] = (short)vbase[key * 72 + 32 + r32]; } }
    __syncthreads();
    LAS float* cs = (LAS float*)(lds) + (qs * 64 + lane) * 35;
#pragma unroll 1
    for (int hq = 0; hq < 3; ++hq) {
        const int h = kvh * 3 + hq;
        if (hq < 2) {
#pragma unroll
            for (int d0 = 0; d0 < 4; ++d0) qnxt[d0] = *(const u32x4*)(qrow0 + (hq + 1) * 64 + 16 * d0); }
        bf16x8 qr[4];
        {
            f32x4 gqv[4][2];
#pragma unroll
            for (int d0 = 0; d0 < 4; ++d0) { gqv[d0][0] = *(const f32x4*)(gq + 16 * d0 + 8 * hi); gqv[d0][1] = *(const f32x4*)(gq + 16 * d0 + 8 * hi + 4); }
            float v[4][8]; float ss = 0.f;
#pragma unroll
            for (int d0 = 0; d0 < 4; ++d0) { const u32x4 w = qcur[d0];
                v[d0][0] = bflo(w.x); v[d0][1] = bfhi(w.x); v[d0][2] = bflo(w.y); v[d0][3] = bfhi(w.y); v[d0][4] = bflo(w.z); v[d0][5] = bfhi(w.z); v[d0][6] = bflo(w.w); v[d0][7] = bfhi(w.w);
#pragma unroll
                for (int j = 0; j < 8; ++j) ss += v[d0][j] * v[d0][j]; }
            ss += __shfl_xor(ss, 32);
            const float rstd = rsqrtf(ss * (1.f / 64) + EPS) * (0.125f * 1.4426950408889634f);
#pragma unroll
            for (int d0 = 0; d0 < 4; ++d0) { float y[8];
#pragma unroll
                for (int j = 0; j < 8; ++j) y[j] = v[d0][j] * rstd * gqv[d0][j >> 2][j & 3];
                u32x4 w; w.x = pk2(y[0], y[1]); w.y = pk2(y[2], y[3]); w.z = pk2(y[4], y[5]); w.w = pk2(y[6], y[7]); qr[d0] = __builtin_bit_cast(bf16x8, w); }
        }
        f32x16 p0, p1;
        { const LAS float* tbl = tb + hq * 256 + (64 * kh + 8 * hi - iq + 128);
#pragma unroll
          for (int i = 0; i < 16; ++i) { p0[i] = tbl[(i & 7) + 16 * (i >> 3)]; p1[i] = tbl[(i & 7) + 16 * (i >> 3) + 32]; } }
#pragma unroll
        for (int d0 = 0; d0 < 4; ++d0) {
            p0 = __builtin_amdgcn_mfma_f32_32x32x16_bf16(kf[2 * d0], qr[d0], p0, 0, 0, 0);
            p1 = __builtin_amdgcn_mfma_f32_32x32x16_bf16(kf[2 * d0 + 1], qr[d0], p1, 0, 0, 0);
        }
        float lrow = 0.f;
#pragma unroll
        for (int i = 0; i < 16; ++i) { p0[i] = fast_exp2(p0[i]); p1[i] = fast_exp2(p1[i]); lrow += p0[i] + p1[i]; }
        bf16x8 pb[2][2];
#pragma unroll
        for (int ks = 0; ks < 2; ++ks) {
            u32x4 w; w.x = pk2(p0[8 * ks + 0], p0[8 * ks + 1]); w.y = pk2(p0[8 * ks + 2], p0[8 * ks + 3]); w.z = pk2(p0[8 * ks + 4], p0[8 * ks + 5]); w.w = pk2(p0[8 * ks + 6], p0[8 * ks + 7]);
            pb[0][ks] = __builtin_bit_cast(bf16x8, w);
            u32x4 w1; w1.x = pk2(p1[8 * ks + 0], p1[8 * ks + 1]); w1.y = pk2(p1[8 * ks + 2], p1[8 * ks + 3]); w1.z = pk2(p1[8 * ks + 4], p1[8 * ks + 5]); w1.w = pk2(p1[8 * ks + 6], p1[8 * ks + 7]);
            pb[1][ks] = __builtin_bit_cast(bf16x8, w1);
        }
        f32x16 o0, o1;
#pragma unroll
        for (int i = 0; i < 16; ++i) { o0[i] = 0.f; o1[i] = 0.f; }
#pragma unroll
        for (int sub = 0; sub < 2; ++sub)
#pragma unroll
            for (int ks = 0; ks < 2; ++ks) {
                o0 = __builtin_amdgcn_mfma_f32_32x32x16_bf16(vf[(sub * 2 + ks) * 2], pb[sub][ks], o0, 0, 0, 0);
                o1 = __builtin_amdgcn_mfma_f32_32x32x16_bf16(vf[(sub * 2 + ks) * 2 + 1], pb[sub][ks], o1, 0, 0, 0);
            }
        lrow += __shfl_xor(lrow, 32);
        if (kh == 1) { cs[1] = lrow;
#pragma unroll
            for (int i = 0; i < 16; ++i) { cs[2 + i] = o0[i]; cs[18 + i] = o1[i]; } }
        __syncthreads();
        if (kh == 0) {
            bf16_t* orow = po + qrow_g * 384 + h * 64 + 4 * hi;
            if (hi == 0) pl[qrow_g * 6 + h] = lrow + cs[1];
#pragma unroll
            for (int g4 = 0; g4 < 4; ++g4) {
                { u32x2 w; w.x = pk2(o0[4 * g4] + cs[2 + 4 * g4], o0[4 * g4 + 1] + cs[3 + 4 * g4]); w.y = pk2(o0[4 * g4 + 2] + cs[4 + 4 * g4], o0[4 * g4 + 3] + cs[5 + 4 * g4]); *(u32x2*)(orow + 8 * g4) = w; }
                { u32x2 w; w.x = pk2(o1[4 * g4] + cs[18 + 4 * g4], o1[4 * g4 + 1] + cs[19 + 4 * g4]); w.y = pk2(o1[4 * g4 + 2] + cs[20 + 4 * g4], o1[4 * g4 + 3] + cs[21 + 4 * g4]); *(u32x2*)(orow + 32 + 8 * g4) = w; }
            }
        }
        __syncthreads();
#pragma unroll
        for (int d0 = 0; d0 < 4; ++d0) qcur[d0] = qnxt[d0];
    }
}

__device__ __forceinline__ void phase_scan(const Args& a, int vcu, int G, const int tid) {
    const float* HL = (const float*)(a.ws + WS_HL); const float* HDp = (const float*)(a.ws + WS_HD); bf16_t* HS = (bf16_t*)(a.ws + WS_HS);
    for (int e = vcu * NTHREADS + tid; e < 64 * 4096; e += G * NTHREADS) {
        const int seq = e >> 12, idx = e & 4095, k = idx & 63, dir = seq & 1;
        float st = 0.f;
        float hd[32], hl[32];
#pragma unroll
        for (int j = 0; j < 32; ++j) { const int c = dir ? 31 - j : j; const size_t o = (size_t)seq * 32 + c; hd[j] = HDp[o * 64 + k]; hl[j] = HL[o * 4096 + idx]; }
#pragma unroll
        for (int j = 0; j < 32; ++j) { const int c = dir ? 31 - j : j; const size_t o = (size_t)seq * 32 + c; HS[o * 4096 + idx] = (bf16_t)f2bf(st); st = hd[j] * st + hl[j]; }
    }
}

constexpr int HG_OACC = 0, HG_QS = 65536, HG_QD = HG_QS + 9216, HG_KD = HG_QD + 9216, HG_KE = HG_KD + 9216, HG_Q2 = HG_KE + 9216, HG_K2 = HG_Q2 + 4608,
              HG_VT = HG_K2 + 4608, HG_AT = HG_VT + 9216, HG_ST = HG_AT + 9216, HG_GT = HG_ST + 9216, HG_END = HG_GT + 2048;
static_assert(HG_END <= LDS_BYTES, "HGRN LDS map");

__device__ __forceinline__ void hgrn_out_item(const Args& a, lds_u8* lds, int l, int item, const int tid) {
    const int lane = tid & 63, wave = __builtin_amdgcn_readfirstlane(tid >> 6);
    const int k = lane, rg = wave;
    const int b = item >> 5, hh = (item >> 3) & 3, grp = item & 7;
    const int c0 = grp * 4;
    unsigned char* ws = a.ws;
    const bf16_t* proj = (const bf16_t*)(ws + WS_PROJ);
    const float* HL = (const float*)(ws + WS_HL); const float* HDp = (const float*)(ws + WS_HD);
    LAS float* oacc = (LAS float*)(lds + HG_OACC);
    LAS bf16_t* Qs = (LAS bf16_t*)(lds + HG_QS); LAS bf16_t* Qd = (LAS bf16_t*)(lds + HG_QD); LAS bf16_t* Kd = (LAS bf16_t*)(lds + HG_KD); LAS bf16_t* Ke = (LAS bf16_t*)(lds + HG_KE);
    LAS bf16_t* Q2 = (LAS bf16_t*)(lds + HG_Q2); LAS bf16_t* K2 = (LAS bf16_t*)(lds + HG_K2); LAS bf16_t* VT = (LAS bf16_t*)(lds + HG_VT); LAS bf16_t* AT = (LAS bf16_t*)(lds + HG_AT);
    LAS bf16_t* ST = (LAS bf16_t*)(lds + HG_ST); LAS float* gt = (LAS float*)(lds + HG_GT);
    const int r16 = lane & 15, q4 = lane >> 4;
    const float lbv0 = hgrn_lb(a.in[I_BLB], 0, l, hh * 64 + k), lbv1 = hgrn_lb(a.in[I_BLB], 1, l, hh * 64 + k);
    unsigned short rq[8], rf[8], rv[8];
#define HG_LOADRAW(dir_, c_) do { const size_t rb_ = (size_t)b * SEQ + (c_) * 64; _Pragma("unroll") for (int i = 0; i < 8; ++i) { const int s_ = 8 * rg + i; const int tk_ = (dir_) ? (63 - s_) : s_; \
        const bf16_t* rp_ = proj + (rb_ + tk_) * INW; rq[i] = rp_[C_BQ + hh * 64 + k]; rf[i] = rp_[((dir_) ? C_BFB : C_BFF) + hh * 64 + k]; rv[i] = rp_[C_BI + hh * 64 + k]; } } while (0)
    HG_LOADRAW(0, c0);
    float st[8];
#pragma unroll
    for (int i = 0; i < 8; ++i) st[i] = 0.f;
    for (int stp = 0; stp < 8; ++stp) {
        {
            const int dir = stp >> 2, ci = stp & 3;
            const float lb = dir ? lbv1 : lbv0;
            const size_t sbase = (((size_t)b * 4 + hh) * 2 + dir) * 32;
            const int c = dir ? (c0 + 3 - ci) : (c0 + ci);
            if (ci == 0) { const bf16_t* HSp = (const bf16_t*)(ws + WS_HS) + (sbase + c) * 4096 + (8 * wave) * 64 + k;
#pragma unroll
                for (int i = 0; i < 8; ++i) st[i] = bf2f(HSp[i * 64]); }
            float qv[8], lf[8], kk[8];
            u32x4 vpk;
#pragma unroll
            for (int i = 0; i < 8; ++i) { qv[i] = bf2f(rq[i]); hgrn_fk(bf2f(rf[i]), lb, lf[i], kk[i]); }
            vpk.x = rv[0] | ((unsigned)rv[1] << 16); vpk.y = rv[2] | ((unsigned)rv[3] << 16); vpk.z = rv[4] | ((unsigned)rv[5] << 16); vpk.w = rv[6] | ((unsigned)rv[7] << 16);
            const float dk = HDp[(sbase + c) * 64 + k];
            float Ln[8];
            { const float* Lp = HL + (sbase + c) * 4096 + (8 * wave) * 64 + k;
#pragma unroll
              for (int i = 0; i < 8; ++i) Ln[i] = Lp[i * 64]; }
            if (stp < 7) { const int nd = (stp + 1) >> 2, nci = (stp + 1) & 3; const int nc = nd ? (c0 + 3 - nci) : (c0 + nci); HG_LOADRAW(nd, nc); }
#pragma unroll
            for (int i = 1; i < 8; ++i) lf[i] += lf[i - 1];
            gt[rg * 64 + k] = lf[7];
#pragma unroll
            for (int i = 0; i < 8; ++i) ST[(8 * wave + i) * 72 + k] = (bf16_t)f2bf(st[i]);
            __syncthreads();
            float gsum[9]; gsum[0] = 0.f;
#pragma unroll
            for (int g = 0; g < 8; ++g) gsum[g + 1] = gsum[g] + gt[g * 64 + k];
            float off = 0.f, bS = 0.f, bE = 0.f;
#pragma unroll
            for (int g = 0; g < 8; ++g) { if (g == rg) off = gsum[g]; if (g == (rg & ~1)) { bS = gsum[g]; bE = gsum[g + 2]; } }
            const float b31 = gsum[4];
            const float eS = fast_exp2(bS), e2 = fast_exp2(rg >= 4 ? bS - b31 : b31 - bE);
#pragma unroll
            for (int i = 0; i < 8; ++i) {
                const int s = 8 * rg + i; const float bb = off + lf[i];
                const float qd = qv[i] * fast_exp2(bb - bS), ke = kk[i] * fast_exp2(bE - bb);
                Qd[s * 72 + k] = (bf16_t)f2bf(qd);
                Qs[s * 72 + k] = (bf16_t)f2bf(qd * eS);
                Kd[s * 72 + k] = (bf16_t)f2bf(kk[i] * fast_exp2(fminf(bS - bb, 115.f)));
                Ke[s * 72 + k] = (bf16_t)f2bf(ke);
                { const bool hi2 = rg >= 4; LAS bf16_t* T2 = hi2 ? Q2 + (s - 32) * 72 + k : K2 + s * 72 + k;
                  *T2 = (bf16_t)f2bf((hi2 ? qd : ke) * e2); }
            }
            *(LAS u32x4*)(VT + k * 72 + 8 * rg) = vpk;
            __syncthreads();
            {
                const int I = wave >> 1;
#pragma unroll
                for (int jj = 0; jj < 2; ++jj) {
                    const int J = 2 * (wave & 1) + jj;
                    f32x4 acc = (f32x4){0.f, 0.f, 0.f, 0.f};
                    if (J <= I) {
                        const LAS bf16_t* Ap; const LAS bf16_t* Bp;
                        if (J == I) { Ap = Qd + (16 * I + r16) * 72; Bp = Kd + (16 * J + r16) * 72; }
                        else if ((I >> 1) == (J >> 1)) { Ap = Qd + (16 * I + r16) * 72; Bp = Ke + (16 * J + r16) * 72; }
                        else { Ap = Q2 + (16 * (I - 2) + r16) * 72; Bp = K2 + (16 * J + r16) * 72; }
#pragma unroll
                        for (int ks = 0; ks < 2; ++ks) { const bf16x8 af = *(const LAS bf16x8*)(Ap + 32 * ks + 8 * q4); const bf16x8 bfr = *(const LAS bf16x8*)(Bp + 32 * ks + 8 * q4);
                            acc = __builtin_amdgcn_mfma_f32_16x16x32_bf16(af, bfr, acc, 0, 0, 0); }
                        if (J == I) {
#pragma unroll
                            for (int j = 0; j < 4; ++j) if (r16 > 4 * q4 + j) acc[j] = 0.f;
                        }
                    }
#pragma unroll
                    for (int j = 0; j < 4; ++j) AT[(16 * I + 4 * q4 + j) * 72 + 16 * J + r16] = (bf16_t)f2bf(acc[j]);
                }
            }
            __syncthreads();
            {
                const int mi = wave >> 1;
#pragma unroll
                for (int jj = 0; jj < 2; ++jj) {
                    const int ni = 2 * (wave & 1) + jj;
                    f32x4 acc = (f32x4){0.f, 0.f, 0.f, 0.f};
#pragma unroll
                    for (int ks = 0; ks < 2; ++ks) { const bf16x8 af = *(const LAS bf16x8*)(Qs + (16 * mi + r16) * 72 + 32 * ks + 8 * q4); const bf16x8 bfr = *(const LAS bf16x8*)(ST + (16 * ni + r16) * 72 + 32 * ks + 8 * q4);
                        acc = __builtin_amdgcn_mfma_f32_16x16x32_bf16(af, bfr, acc, 0, 0, 0); }
#pragma unroll
                    for (int ks = 0; ks < 2; ++ks) { const bf16x8 af = *(const LAS bf16x8*)(AT + (16 * mi + r16) * 72 + 32 * ks + 8 * q4); const bf16x8 bfr = *(const LAS bf16x8*)(VT + (16 * ni + r16) * 72 + 32 * ks + 8 * q4);
                        acc = __builtin_amdgcn_mfma_f32_16x16x32_bf16(af, bfr, acc, 0, 0, 0); }
#pragma unroll
                    for (int j = 0; j < 4; ++j) { const int t = 16 * mi + 4 * q4 + j; const int tl = (c - c0) * 64 + (dir ? (63 - t) : t);
                        LAS float* op = oacc + tl * 64 + 16 * ni + r16;
                        if (dir == 0) *op = acc[j]; else *op += acc[j]; }
                }
            }
#pragma unroll
            for (int i = 0; i < 8; ++i) st[i] = dk * st[i] + Ln[i];
            __syncthreads();
        }
    }
#undef HG_LOADRAW

    {
        const float gn = a.in[I_BON][l * 64 + lane];
        bf16_t* mix = (bf16_t*)(ws + WS_MIX);
        for (int rb = 0; rb < 32; rb += 8) {
            unsigned short gv[8];
#pragma unroll
            for (int r = 0; r < 8; ++r) gv[r] = proj[((size_t)b * SEQ + c0 * 64 + 32 * wave + rb + r) * INW + C_BG + hh * 64 + lane];
#pragma unroll
            for (int r = 0; r < 8; ++r) {
                const int tl = 32 * wave + rb + r;
                const size_t row = (size_t)b * SEQ + c0 * 64 + tl;
                const float o = oacc[tl * 64 + lane];
                const float ss = wave_sum(o * o);
                mix[row * DM + 384 + hh * 64 + lane] = (bf16_t)f2bf(o * rsqrtf(ss * (1.f / 64) + EPS) * gn * silu_f(bf2f(gv[r])));
            }
        }
    }
    __syncthreads();
}

__device__ __forceinline__ void phase_mixers(const Args& a, lds_u8* lds, int l, int vcu, int G, const int tid) {
    unsigned char* ws = a.ws;
    const bf16_t* proj = (const bf16_t*)(ws + WS_PROJ); const bf16_t* vt = (const bf16_t*)(ws + WS_VT); bf16_t* mix = (bf16_t*)(ws + WS_MIX);
    const float* rope = (const float*)(ws + WS_ROPE);
    for (int rp = 0; rp < ((PROBE_DUP & 256) ? 2 : 1); ++rp)
    for (int it = vcu; it < NB * 4 * 8; it += G) hgrn_out_item(a, lds, l, it, tid);
    const bf16_t* po_far = (const bf16_t*)(ws + WS_PO); const float* pl_far = (const float*)(ws + WS_PL);
    for (int u = vcu; u < 768; u += G) {
        const int mixer = u / 384, r = u % 384, b = r / 48, rr = r % 48, kvh = rr / 24, r3 = rr % 24, hq = r3 / 8, qblk = r3 % 8;
        const int h = kvh * 3 + hq;
        if (mixer == 0) attn_unit<false>(lds, proj, vt, mix, nullptr, nullptr, a.in[I_AQN] + l * 64, a.in[I_AKN] + l * 64, rope, b, h, qblk, C_AQ, C_AK, 0, 0, tid);
        else attn_unit<true>(lds, proj, vt, mix, po_far, pl_far, a.in[I_CQN] + l * 64, a.in[I_CKN] + l * 64, rope, b, h, qblk, C_CQ, C_CK, 2, 640, tid);
    }
}

__device__ __forceinline__ void phase_mixc(const Args& a, lds_u8* lds, int l, int vcu, int G, const int tid) {
    unsigned char* ws = a.ws;
    const bf16_t* proj = (const bf16_t*)(ws + WS_PROJ);
    bf16_t* po = (bf16_t*)(ws + WS_PO); float* pl = (float*)(ws + WS_PL);
    for (int u = vcu; u < 256; u += G) {
        const int b = u >> 5, kvh = (u >> 4) & 1, rho = u & 15;
        attn_r16_unit(lds, proj, po, pl, a.in[I_CQN] + l * 64, a.in[I_CKN] + l * 64, b, kvh, rho, tid);
    }
}

#define XB_TMO      128
#define XB_XCNT(j)  (256  + 64 * (j))
#define XB_XSUB(j)  (1280 + 64 * (j))
#define XB_XGEN(j)  (2304 + 64 * (j))
#define XB_TOP      3328
#define XB_TOPGEN   3392
#define XCD_BAR_WORDS 3456
#define XB_SPIN_CAP (1u << 18)
__device__ __forceinline__ unsigned xb_ld(unsigned* p)              { return __hip_atomic_load(p, __ATOMIC_RELAXED, __HIP_MEMORY_SCOPE_AGENT); }
__device__ __forceinline__ unsigned xb_add(unsigned* p, unsigned v) { return __hip_atomic_fetch_add(p, v, __ATOMIC_RELAXED, __HIP_MEMORY_SCOPE_AGENT); }
__device__ __forceinline__ unsigned xb_xcc_id() { return (unsigned)__builtin_amdgcn_s_getreg((3 << 11) | 20) & 0xFu; }
#define XB_SPIN(cond, bar) do { unsigned _sp = 0; while (cond) { __builtin_amdgcn_s_sleep(1); \
    if ((++_sp & 255u) == 0u) { if (xb_ld(&(bar)[XB_TMO])) break; if (_sp > XB_SPIN_CAP) { atomicAdd(&(bar)[XB_TMO], 1u); break; } } } } while (0)
struct XcdBarrier { unsigned* bar; unsigned x; volatile LAS unsigned* st; int wave; };
__device__ __forceinline__ int lane_id() { return (int)__builtin_amdgcn_mbcnt_hi(~0u, __builtin_amdgcn_mbcnt_lo(~0u, 0u)); }
__device__ __forceinline__ XcdBarrier xcd_barrier_post(unsigned* bar, volatile LAS unsigned* st, int wave) {
    XcdBarrier b; b.bar = bar; b.x = xb_xcc_id(); b.st = st; b.wave = wave;
    if (wave == 0 && lane_id() == 0) (void)xb_add(&bar[XB_XCNT(b.x)], 1u);
    return b;
}
__device__ __forceinline__ void xcd_barrier_complete(unsigned* bar, unsigned x, unsigned& nloc, unsigned& nx) {
    const unsigned G = gridDim.x * gridDim.y * gridDim.z;
    unsigned sum, cnt, mine, sp = 0u;
    for (;;) {
        sum = 0u; cnt = 0u; mine = 0u;
#pragma unroll
        for (unsigned j = 0; j < 16; ++j) { const unsigned c = xb_ld(&bar[XB_XCNT(j)]); sum += c; cnt += (c > 0u) ? 1u : 0u; mine = (j == x) ? c : mine; }
        if (sum == G) break;
        __builtin_amdgcn_s_sleep(1);
        if ((++sp & 255u) == 0u) { if (xb_ld(&bar[XB_TMO])) break; if (sp > XB_SPIN_CAP) { atomicAdd(&bar[XB_TMO], 1u); break; } }
    }
    nloc = mine > 0u ? mine : 1u; nx = cnt > 0u ? cnt : 1u;
}
__device__ __forceinline__ void xcd_barrier(const XcdBarrier& b) {
    asm volatile("s_waitcnt vmcnt(0)" ::: "memory");
    __syncthreads();
    if (b.wave == 0 && lane_id() == 0) {
        unsigned* bar = b.bar;
        __builtin_amdgcn_s_waitcnt(0);
        asm volatile("buffer_inv sc1" ::: "memory");
        unsigned nloc = b.st[0], nx = b.st[1];
        if (nloc == 0u) { xcd_barrier_complete(bar, b.x, nloc, nx); b.st[0] = nloc; b.st[1] = nx; }
        const unsigned old = xb_add(&bar[XB_XSUB(b.x)], 1u);
        const unsigned gen = old / nloc;
        if (old + 1u == (gen + 1u) * nloc) {
            __builtin_amdgcn_fence(__ATOMIC_RELEASE, "agent");
            asm volatile("s_waitcnt vmcnt(0)" ::: "memory");
            const unsigned og = xb_add(&bar[XB_TOP], 1u);
            const unsigned tg = og / nx;
            if (og + 1u == (tg + 1u) * nx) xb_add(&bar[XB_TOPGEN], 1u);
            else XB_SPIN(xb_ld(&bar[XB_TOPGEN]) == tg, bar);
            xb_add(&bar[XB_XGEN(b.x)], 1u);
            asm volatile("s_waitcnt vmcnt(0)" ::: "memory");
        } else {
            XB_SPIN(xb_ld(&bar[XB_XGEN(b.x)]) == gen, bar);
            asm volatile("s_waitcnt vmcnt(0)" ::: "memory");
        }
    }
    __syncthreads();
}
__device__ __forceinline__ void panel_norm(unsigned* cnt, const bf16_t* x, const float* g, const float* mod_l, int which_sh, bf16_t* h, int pm, int pn, const int tid) {
    asm volatile("s_waitcnt vmcnt(0)" ::: "memory");
    __syncthreads();
    if (tid == 0) {
        __builtin_amdgcn_fence(__ATOMIC_RELEASE, "agent");
        asm volatile("s_waitcnt vmcnt(0)" ::: "memory");
        (void)xb_add(cnt, 1u);
        unsigned sp = 0u;
        while (xb_ld(cnt) < 4u) { __builtin_amdgcn_s_sleep(1); if (++sp > (1u << 22)) break; }
        __builtin_amdgcn_fence(__ATOMIC_ACQUIRE, "agent");
        asm volatile("s_waitcnt vmcnt(0)" ::: "memory");
    }
    __syncthreads();
    const int lane = tid & 63, wave = tid >> 6;
    for (int r = 0; r < 8; r += 4) norm_rows4_bf(x, g, mod_l, which_sh, h, pm * 256 + pn * 64 + wave * 8 + r, lane);
}
constexpr int MISC_OFF = LDS_BYTES - 64;

constexpr int NPHASES = 2 + 9 * DEPTH - 1;

typedef const Args __attribute__((address_space(4))) KArgs;
template <int KMASK> __global__ void __launch_bounds__(NTHREADS, 2) fwd_kernel_t(Args a0) {
    extern __shared__ __attribute__((aligned(16))) unsigned char lds_raw[];
    lds_u8* lds = (lds_u8*)lds_raw;
    const int G = gridDim.x;
    unsigned char* ws = a0.ws;
    const int ph_lo = a0.ph_lo, ph_hi = a0.ph_hi;
    const float* mod = (const float*)(ws + WS_MOD);
    const int wave_s = __builtin_amdgcn_readfirstlane((int)(threadIdx.x >> 6));
    if (wave_s == 0 && lane_id() < 16) ((LAS unsigned*)(lds + MISC_OFF))[lane_id()] = 0u;
    __syncthreads();
    XcdBarrier bar = xcd_barrier_post((unsigned*)(ws + WS_CTL) + 4096, (volatile LAS unsigned*)(lds + MISC_OFF), wave_s);
    const bool fuse_norm = MK_ONE_LAUNCH && !PROBE_DUP && (G == 256);
    for (int ph = ph_lo; ph < ph_hi; ++ph) {
        KArgs* kap = (KArgs*)__builtin_amdgcn_kernarg_segment_ptr(); asm volatile("" : "+s"(kap));
        Args a;
#pragma unroll
        for (int i_ = 0; i_ < 17; ++i_) a.in[i_] = kap->in[i_];
        a.out = kap->out; a.ws = kap->ws; a.ph_lo = ph_lo; a.ph_hi = ph_hi;
        if (fuse_norm && ph >= 2 && ((ph - 2) % 9 == 5 || (ph - 2) % 9 == 8)) continue;
        int kbit = 0;
        if (PROBE_DUP) { if (ph == 0) kbit = 1; else if (ph == 1) kbit = 2; else { const int s_ = (ph - 2) % 9; kbit = s_ == 0 ? 4 : (s_ == 4 || s_ == 7) ? 8 : s_ == 1 ? 16 : s_ == 3 ? 32 : s_ == 6 ? 64 : s_ == 2 ? 128 : 2; } }
        const int nrep = (PROBE_DUP & kbit) ? 2 : 1;
        for (int rep = 0; rep < nrep; ++rep) {
        const bool dry = (rep + 1 < nrep); if (rep) __syncthreads();
        int tid = threadIdx.x; asm volatile("" : "+v"(tid));
        int bx = blockIdx.x; asm volatile("" : "+s"(bx));
        const int vcu = (G % 8 == 0) ? (bx % 8) * (G / 8) + bx / 8 : bx;
        if (ph == 0) { if (KMASK & 1) phase_prologue(a, lds, vcu, G, tid, bx); }
        else if (ph == 1) { if (KMASK & 2) phase_norm(a.in[I_X], a.in[I_NORMG], mod, 0, (bf16_t*)(ws + WS_H), vcu, G, tid); }
        else {
            const int l = (ph - 2) / 9, s = (ph - 2) % 9;
            const float* mod_l = mod + (size_t)l * 8 * 6144;
            if ((KMASK & 4) && s == 0) {
                const pg8::Gemm g{(const bf16_t*)(ws + WS_H), (const bf16_t*)(ws + WS_WIN) + (size_t)l * INW * DM, M, INW, DM}; const pg8::EpiStore E{(bf16_t*)(ws + WS_PROJ), INW};
                pg8::StaticOrder S; S.init(g.M, g.N, G, bx);
                pg8::gemm_phase<pg8::EpiStore, pg8::StaticOrder>(lds, g, S, E, tid);
            } else if ((KMASK & 64) && s == 6) {
                const pg8::Gemm g{(const bf16_t*)(ws + WS_H), (const bf16_t*)(ws + WS_WUP) + (size_t)l * UPW * DM, M, UPW, DM};
                const pg8::EpiConvGate E{(bf16_t*)(ws + WS_ACT), a.in[I_CONVW] + (size_t)l * 3 * UPW, a.in[I_CONVB] + (size_t)l * UPW};
                pg8::StaticOrder S; S.init(g.M, g.N, G, bx, 1);
                pg8::gemm_phase<pg8::EpiConvGate, pg8::StaticOrder>(lds, g, S, E, tid);
            } else if ((KMASK & 8) && (s == 4 || s == 7)) {
                pg8::Gemm g; pg8::EpiResid E;
                const bool nfuse = fuse_norm && !dry && !(s == 7 && l == DEPTH - 1);
                if (s == 4) { g = pg8::Gemm{(const bf16_t*)(ws + WS_MIX), (const bf16_t*)(ws + WS_WOUT) + (size_t)l * DM * DM, M, DM, DM};
                    E = pg8::EpiResid{ws, l == 0 ? a.in[I_X] : nullptr, nullptr, a.in[I_NORMG], l, 0, nfuse ? 1 : 0}; }
                else { g = pg8::Gemm{(const bf16_t*)(ws + WS_ACT), (const bf16_t*)(ws + WS_WDN) + (size_t)l * DM * FF, M, DM, FF};
                    E = pg8::EpiResid{ws, nullptr, (l == DEPTH - 1) ? a.out : nullptr, a.in[I_NORMG], l, 1, nfuse ? 1 : 0}; }
                pg8::StaticOrder S; S.init(g.M, g.N, G, bx);
                pg8::gemm_phase<pg8::EpiResid, pg8::StaticOrder>(lds, g, S, E, tid);
            } else if ((KMASK & 16) && s == 1) phase_prep(a, lds, l, vcu, G, tid, dry);
            else if ((KMASK & 16) && s == 2) { phase_scan(a, vcu, G, tid); phase_mixc(a, lds, l, vcu, G, tid); }
            else if ((KMASK & 32) && s == 3) phase_mixers(a, lds, l, vcu, G, tid);
            else if ((KMASK & 2) && s == 5) phase_norm_bf((const bf16_t*)(ws + WS_XB), a.in[I_NORMG] + (size_t)(l * 2 + 1) * DM, mod_l, 3, (bf16_t*)(ws + WS_H), vcu, G, tid);
            else if ((KMASK & 2) && s == 8) phase_norm_bf((const bf16_t*)(ws + WS_XB), a.in[I_NORMG] + (size_t)((l + 1) * 2) * DM, mod_l + 8 * 6144, 0, (bf16_t*)(ws + WS_H), vcu, G, tid);
        }
        }
        if (ph + 1 < ph_hi) xcd_barrier(bar);
    }
}

typedef void (*kern_t)(Args);
static int phase_kind(int ph) { if (ph == 0) return 0; if (ph == 1) return 1; const int s = (ph - 2) % 9; return s == 0 ? 2 : s == 4 || s == 7 ? 3 : s == 1 || s == 2 ? 4 : s == 3 ? 5 : s == 6 ? 6 : 1; }
extern "C" void kernel_launch(void* const* d_in, const int* in_sizes, int n_in, void* d_out, int out_size, void* d_ws, size_t ws_size, hipStream_t stream) {
    static int grid = 0;
#if MK_ONE_LAUNCH
    static const kern_t kerns[1] = {fwd_kernel_t<127>}; constexpr int NK = 1;
#else
    static const kern_t kerns[7] = {fwd_kernel_t<1>, fwd_kernel_t<2>, fwd_kernel_t<4>, fwd_kernel_t<8>, fwd_kernel_t<16>, fwd_kernel_t<32>, fwd_kernel_t<64>}; constexpr int NK = 7;
#endif
    if (grid == 0) {
        if (n_in != 17 || out_size != M * DM || ws_size < WS_END) { fprintf(stderr, "kernel_launch: unexpected shapes (n_in %d, out %d, ws %zu)\n", n_in, out_size, ws_size); grid = -1; return; }
        int dev = 0, cus = 0;
        if (hipGetDevice(&dev) != hipSuccess || hipDeviceGetAttribute(&cus, hipDeviceAttributeMultiprocessorCount, dev) != hipSuccess) { grid = -1; return; }
        for (int i = 0; i < NK; ++i)
            if (hipFuncSetAttribute((const void*)kerns[i], hipFuncAttributeMaxDynamicSharedMemorySize, LDS_BYTES) != hipSuccess) { fprintf(stderr, "kernel_launch: hipFuncSetAttribute failed\n"); grid = -1; return; }
        int per_cu = 0;
        if (hipOccupancyMaxActiveBlocksPerMultiprocessor(&per_cu, (const void*)kerns[0], NTHREADS, LDS_BYTES) != hipSuccess || per_cu < 1) { fprintf(stderr, "kernel_launch: occupancy query says %d\n", per_cu); (void)hipGetLastError(); }
        grid = cus;
    }
    if (grid < 0) return;
    Args a{};
    for (int i = 0; i < 17; ++i) a.in[i] = (const float*)d_in[i];
    a.out = (float*)d_out; a.ws = (unsigned char*)d_ws;
#if MK_ONE_LAUNCH
    if (hipMemsetAsync((char*)d_ws + WS_CTL, 0, 65536, stream) != hipSuccess) { fprintf(stderr, "kernel_launch: memset failed\n"); return; }
    a.ph_lo = 0; a.ph_hi = NPHASES;
    void* args[] = {&a};
    hipError_t e = hipLaunchCooperativeKernel((const void*)kerns[0], dim3(grid), dim3(NTHREADS), args, LDS_BYTES, stream);
    if (e != hipSuccess) fprintf(stderr, "cooperative launch failed: %s (grid %d)\n", hipGetErrorString(e), grid);
#else
    for (int ph = 0; ph < NPHASES; ++ph) {
        a.ph_lo = ph; a.ph_hi = ph + 1;
        hipLaunchKernelGGL(kerns[phase_kind(ph)], dim3(grid), dim3(NTHREADS), LDS_BYTES, stream, a);
    }
#endif
}
```

```cpp
#include <hip/hip_runtime.h>
#include <hip/hip_cooperative_groups.h>
#include <cstdio>
#include <cstdint>
namespace cg = cooperative_groups;

#ifndef PROBE_DUP
#define PROBE_DUP 0
#endif
#ifndef MK_ONE_LAUNCH
#define MK_ONE_LAUNCH 1
#endif

#define LAS __attribute__((address_space(3)))
typedef unsigned short bf16_t;
typedef short bf16x8 __attribute__((ext_vector_type(8)));
typedef float f32x4 __attribute__((ext_vector_type(4)));
typedef float f32x16 __attribute__((ext_vector_type(16)));
typedef unsigned u32x4 __attribute__((ext_vector_type(4)));
typedef unsigned u32x2 __attribute__((ext_vector_type(2)));
typedef LAS unsigned char lds_u8;

constexpr int NB = 8, SEQ = 2048, DM = 1024, M = NB * SEQ, DEPTH = 4, INW = 2560, FF = 2816, UPW = 2 * FF;
constexpr float EPS = 1e-6f;
constexpr int C_AQ = 0, C_AK = 384, C_AV = 512, C_BQ = 640, C_BFF = 896, C_BFB = 1152, C_BI = 1408, C_BG = 1664, C_CQ = 1920, C_CK = 2304, C_CV = 2432;

constexpr size_t MiB = 1u << 20;
constexpr size_t WS_CTL = 0;
constexpr size_t WS_MOD = 1 * MiB;
constexpr size_t WS_ROPE = 2 * MiB;
constexpr size_t WS_WIN = 4 * MiB;
constexpr size_t WS_WOUT = 24 * MiB;
constexpr size_t WS_WUP = 32 * MiB;
constexpr size_t WS_WDN = 76 * MiB;
constexpr size_t WS_H = 98 * MiB;
constexpr size_t WS_PROJ = 130 * MiB;
constexpr size_t WS_MIX = 210 * MiB;
constexpr size_t WS_HL = 242 * MiB;
constexpr size_t WS_HD = 274 * MiB;
constexpr size_t WS_VT = 275 * MiB;
constexpr size_t WS_ACT = 190 * MiB;
constexpr size_t WS_HS = 283 * MiB;
constexpr size_t WS_PO = 300 * MiB;
constexpr size_t WS_PL = 326 * MiB;
constexpr size_t WS_XB = 332 * MiB;
constexpr size_t WS_U = 330 * MiB;
constexpr size_t WS_END = 366 * MiB;

constexpr int LDS_BYTES = 147456;
constexpr int NTHREADS = 512;

typedef float f32x2_t __attribute__((ext_vector_type(2))); typedef __bf16 bf16x2_t __attribute__((ext_vector_type(2)));
__device__ __forceinline__ unsigned pk2(float lo, float hi) { f32x2_t v = {lo, hi}; bf16x2_t b = __builtin_convertvector(v, bf16x2_t); return __builtin_bit_cast(unsigned, b); }
__device__ __forceinline__ unsigned f2bf(float f) { return pk2(f, 0.f) & 0xffffu; }
__device__ __forceinline__ float bf2f(unsigned short h) { return __builtin_bit_cast(float, (unsigned)h << 16); }
__device__ __forceinline__ float bflo(unsigned w) { return __builtin_bit_cast(float, w << 16); }
__device__ __forceinline__ float bfhi(unsigned w) { return __builtin_bit_cast(float, w & 0xffff0000u); }
__device__ __forceinline__ float wave_sum(float v) {
#pragma unroll
    for (int o = 1; o < 64; o <<= 1) v += __shfl_xor(v, o);
    return v;
}
__device__ __forceinline__ float fast_exp2(float x) { return __builtin_amdgcn_exp2f(x); }
__device__ __forceinline__ float fast_exp(float x) { return __builtin_amdgcn_exp2f(x * 1.4426950408889634f); }
__device__ __forceinline__ float silu_f(float x) { return x * __builtin_amdgcn_rcpf(1.0f + fast_exp2(-1.4426950408889634f * x)); }

__device__ __forceinline__ float dpp_ror1(float v) { return __builtin_bit_cast(float, __builtin_amdgcn_update_dpp(0, __builtin_bit_cast(int, v), 0x121, 0xf, 0xf, true)); }
__device__ __forceinline__ float dpp_ror15(float v) { return __builtin_bit_cast(float, __builtin_amdgcn_update_dpp(0, __builtin_bit_cast(int, v), 0x12f, 0xf, 0xf, true)); }
__device__ __forceinline__ float dpp_shr1(float old, float v) { return __builtin_bit_cast(float, __builtin_amdgcn_update_dpp(__builtin_bit_cast(int, old), __builtin_bit_cast(int, v), 0x111, 0xf, 0xf, false)); }
__device__ __forceinline__ float dpp_shl1(float old, float v) { return __builtin_bit_cast(float, __builtin_amdgcn_update_dpp(__builtin_bit_cast(int, old), __builtin_bit_cast(int, v), 0x101, 0xf, 0xf, false)); }

namespace pg8 {
constexpr int BM = 256, BK = 64, HALF = 128, HTB = HALF * BK * 2, STAGE_BYTES = 8 * HTB, NXCD = 8, WGM = 8;
__host__ __device__ __forceinline__ int lds_byte(int r, int c) { const int st = (r >> 4) * 2 + (c >> 5), rr = r & 15, cc = c & 31, ob = rr * 64 + cc * 2; return st * 1024 + (ob ^ (((ob >> 9) & 1) << 5)); }
__host__ __device__ __forceinline__ void stage_rc(int b, int& R, int& C) { const int st = b / 1024, sb = b % 1024, swz = sb ^ (((sb >> 9) & 1) << 5); R = (st >> 1) * 16 + swz / 64; C = (st & 1) * 32 + (swz % 64) / 2; }
__host__ __device__ __forceinline__ int perm32(int rho) { const int n = rho >> 4, i = rho & 15; return 8 * (i >> 2) + 4 * n + (i & 3); }

struct Unit { int pm, pn, ar; };
struct Gemm { const bf16_t* A; const bf16_t* Bt; int M, N, K; };

struct StaticOrder {
    int nM, nN, nwg, G, c, conv, Mrows;
    __host__ __device__ void init(int M_, int N_, int G_, int c_, int conv_ = 0) { conv = conv_; Mrows = M_; nM = conv_ ? (M_ + 253) / 254 : M_ / BM; nN = N_ / BM; nwg = nM * nN; G = G_; c = c_; }
    __host__ __device__ bool next(int i, Unit& u) const {
        const long L = (long)i * G + c; if (L >= nwg) return false;
        int wgid = (int)L; { const int q = nwg / NXCD, r = nwg % NXCD, xcd = wgid % NXCD, off = wgid / NXCD; wgid = (xcd < r ? xcd * (q + 1) : r * (q + 1) + (xcd - r) * q) + off; }
        const int nig = WGM * nN, gid = wgid / nig, fm = gid * WGM, gsz = (nM - fm) < WGM ? (nM - fm) : WGM;
        u.pm = fm + ((wgid % nig) % gsz); u.pn = (wgid % nig) / gsz;
        if (conv) { int s = 254 * u.pm - 1; s = s < 0 ? 0 : s; u.ar = s > Mrows - BM ? Mrows - BM : s; } else u.ar = u.pm * BM;
        return true;
    }
};

struct EpiStore {
    static constexpr bool PERM = true;
    bf16_t* O; int ldc;
    __device__ __forceinline__ void operator()(const f32x4 (&acc)[2][2][4][2], const Unit& u, int wr, int wc, int fr, int fq, lds_u8*) const {
        const int row0 = u.pm * BM + wr * 64 + fr, col0 = u.pn * BM + wc * 32 + 8 * fq;
#pragma unroll
        for (int ai = 0; ai < 2; ++ai)
#pragma unroll
            for (int m = 0; m < 4; ++m) { bf16_t* rowp = O + (size_t)(row0 + ai * HALF + m * 16) * ldc + col0;
#pragma unroll
                for (int bj = 0; bj < 2; ++bj) { const f32x4 v0 = acc[ai][bj][m][0], v1 = acc[ai][bj][m][1];
                    u32x4 w; w.x = pk2(v0[0], v0[1]); w.y = pk2(v0[2], v0[3]); w.z = pk2(v1[0], v1[1]); w.w = pk2(v1[2], v1[3]);
                    *(u32x4*)(rowp + bj * HALF) = w; } }
    }
};
struct EpiResid {
    static constexpr bool PERM = true;
    unsigned char* ws; const float* xin32; float* out32; const float* normg;
    int l, second, nfuse;
    __device__ __forceinline__ void operator()(f32x4 (&acc)[2][2][4][2], const Unit& u, int wr, int wc, int fr, int fq, lds_u8* lds) const {
        const int col0 = u.pn * BM + wc * 32 + 8 * fq;
        const int bidx = (u.pm * BM) / SEQ;
        bf16_t* const xb16 = (bf16_t*)(ws + WS_XB);
        const float* const modl = (const float*)(ws + WS_MOD) + (size_t)l * 8 * 6144;
        const float* const gate = modl + (second ? 5 : 2) * DM;
        const float* const ng = normg + (size_t)(second ? (l + 1) * 2 : l * 2 + 1) * DM;
        const float* const nmod = second ? modl + 8 * 6144 : modl + 3 * DM;
        const int nidx = nfuse ? l * 2 + second : -1;
        const float* gb = gate + (size_t)bidx * 6144 + col0;
        f32x4 gv[2][2];
#pragma unroll
        for (int bj = 0; bj < 2; ++bj)
#pragma unroll
            for (int n = 0; n < 2; ++n) gv[bj][n] = *(const f32x4*)(gb + bj * HALF + 4 * n);
#pragma unroll
        for (int ai = 0; ai < 2; ++ai)
#pragma unroll
            for (int m = 0; m < 4; ++m) { const size_t off = (size_t)(u.pm * BM + ai * HALF + wr * 64 + m * 16 + fr) * DM + col0;
#pragma unroll
                for (int bj = 0; bj < 2; ++bj) {
                    f32x4 x0, x1;
                    if (xin32) { x0 = *(const f32x4*)(xin32 + off + bj * HALF); x1 = *(const f32x4*)(xin32 + off + bj * HALF + 4); }
                    else { const u32x4 w = *(const u32x4*)(xb16 + off + bj * HALF); x0 = (f32x4){bflo(w.x), bfhi(w.x), bflo(w.y), bfhi(w.y)}; x1 = (f32x4){bflo(w.z), bfhi(w.z), bflo(w.w), bfhi(w.w)}; }
                    const f32x4 y0 = x0 + gv[bj][0] * acc[ai][bj][m][0], y1 = x1 + gv[bj][1] * acc[ai][bj][m][1];
                    acc[ai][bj][m][0] = y0; acc[ai][bj][m][1] = y1;
                    if (out32) { __builtin_nontemporal_store(y0, (f32x4*)(out32 + off + bj * HALF)); __builtin_nontemporal_store(y1, (f32x4*)(out32 + off + bj * HALF + 4)); }
                    else { u32x4 w; w.x = pk2(y0[0], y0[1]); w.y = pk2(y0[2], y0[3]); w.z = pk2(y1[0], y1[1]); w.w = pk2(y1[2], y1[3]); *(u32x4*)(xb16 + off + bj * HALF) = w; }
                } }
        if (nidx < 0) return;
        asm volatile("" : "+v"(fr), "+v"(fq));
        bf16_t* const hn = (bf16_t*)(ws + WS_H); float* const slots = (float*)(ws + WS_CTL + 512 * 1024); unsigned* const cnt = (unsigned*)(ws + WS_CTL) + 8192 + nidx * 1024;
        LAS float* P = (LAS float*)(lds + STAGE_BYTES);
        LAS float* S = P + 1024;
#pragma unroll
        for (int ai = 0; ai < 2; ++ai)
#pragma unroll
            for (int m = 0; m < 4; ++m) { float s = 0.f;
#pragma unroll
                for (int bj = 0; bj < 2; ++bj)
#pragma unroll
                    for (int n = 0; n < 2; ++n) { const f32x4 v = acc[ai][bj][m][n]; s += (v[0] * v[0] + v[1] * v[1]) + (v[2] * v[2] + v[3] * v[3]); }
                s += __shfl_xor(s, 16); s += __shfl_xor(s, 32);
                if (fq == 0) P[(ai * HALF + wr * 64 + m * 16 + fr) * 4 + wc] = s; }
        asm volatile("s_waitcnt lgkmcnt(0)" ::: "memory"); __builtin_amdgcn_s_barrier(); asm volatile("" ::: "memory");
        const int tid = (wr * 4 + wc) * 64 + fr + 16 * fq;
        unsigned* slot_u = (unsigned*)slots + ((size_t)u.pm * BM) * 4;
        if (tid < 256) { const float t = (P[tid * 4] + P[tid * 4 + 1]) + (P[tid * 4 + 2] + P[tid * 4 + 3]);
            __hip_atomic_store(slot_u + tid * 4 + u.pn, __builtin_bit_cast(unsigned, t), __ATOMIC_RELAXED, __HIP_MEMORY_SCOPE_AGENT); }
        asm volatile("s_waitcnt vmcnt(0)" ::: "memory"); __builtin_amdgcn_s_barrier(); asm volatile("" ::: "memory");
        if (tid == 0) {
            unsigned* c = cnt + u.pm * 16;
            (void)__hip_atomic_fetch_add(c, 1u, __ATOMIC_RELAXED, __HIP_MEMORY_SCOPE_AGENT);
            unsigned sp = 0u;
            while (__hip_atomic_load(c, __ATOMIC_RELAXED, __HIP_MEMORY_SCOPE_AGENT) < 4u) { __builtin_amdgcn_s_sleep(1); if (++sp > (1u << 22)) break; }
            asm volatile("s_waitcnt vmcnt(0)" ::: "memory");
        }
        __builtin_amdgcn_s_barrier(); asm volatile("" ::: "memory");
        if (tid < 256) { float t = 0.f;
#pragma unroll
            for (int p = 0; p < 4; ++p) t += __builtin_bit_cast(float, __hip_atomic_load(slot_u + tid * 4 + p, __ATOMIC_RELAXED, __HIP_MEMORY_SCOPE_AGENT));
            S[tid] = rsqrtf(t * (1.f / DM) + EPS); }
        asm volatile("s_waitcnt lgkmcnt(0)" ::: "memory"); __builtin_amdgcn_s_barrier(); asm volatile("" ::: "memory");
        const float* shp = nmod + (size_t)bidx * 6144 + col0; const float* scp = shp + DM; const float* gp = ng + col0;
#pragma unroll
        for (int bj = 0; bj < 2; ++bj)
#pragma unroll
            for (int n = 0; n < 2; ++n) {
                const f32x4 gn = *(const f32x4*)(gp + bj * HALF + 4 * n) * (*(const f32x4*)(scp + bj * HALF + 4 * n) + 1.0f), sn = *(const f32x4*)(shp + bj * HALF + 4 * n);
#pragma unroll
                for (int ai = 0; ai < 2; ++ai)
#pragma unroll
                    for (int m = 0; m < 4; ++m) { const int rl = ai * HALF + wr * 64 + m * 16 + fr; const float rstd = S[rl];
                        const f32x4 h0 = acc[ai][bj][m][n] * rstd * gn + sn;
                        u32x2 w; w.x = pk2(h0[0], h0[1]); w.y = pk2(h0[2], h0[3]);
                        *(u32x2*)(hn + (size_t)(u.pm * BM + rl) * DM + col0 + bj * HALF + 4 * n) = w; }
            }
    }
};

struct EpiConvGate {
    static constexpr bool PERM = true;
    bf16_t* act; const float* cw; const float* cb;
    __device__ __forceinline__ void operator()(const f32x4 (&acc)[2][2][4][2], const Unit& u, int wr, int wc, int fr, int fq, lds_u8* lds) const {
        LAS float* xch = (LAS float*)(lds + STAGE_BYTES);
        int colw = wc * 32 + 8 * fq; asm volatile("" : "+v"(colw));
#pragma unroll
        for (int ai = 0; ai < 2; ++ai) { const int rho = 2 * ai + wr;
#pragma unroll
            for (int bj = 0; bj < 2; ++bj)
#pragma unroll
                for (int n = 0; n < 2; ++n) {
                    if (fr == 0) *(LAS f32x4*)(xch + (rho * 2) * 256 + bj * 128 + colw + 4 * n) = acc[ai][bj][0][n];
                    if (fr == 15) *(LAS f32x4*)(xch + (rho * 2 + 1) * 256 + bj * 128 + colw + 4 * n) = acc[ai][bj][3][n]; } }
        asm volatile("s_waitcnt lgkmcnt(0)" ::: "memory"); __builtin_amdgcn_s_barrier(); asm volatile("" ::: "memory");
        const int jcol = u.pn * 128 + colw;
        const int olo = 254 * u.pm, ohi = (olo + 254 < M) ? olo + 254 : M;
#pragma unroll
        for (int n = 0; n < 2; ++n) {
            const int ja = jcol + 4 * n, jb = FF + ja;
            const f32x4 wa0 = *(const f32x4*)(cw + ja), wa1 = *(const f32x4*)(cw + UPW + ja), wa2 = *(const f32x4*)(cw + 2 * UPW + ja), ba = *(const f32x4*)(cb + ja);
            const f32x4 wb0 = *(const f32x4*)(cw + jb), wb1 = *(const f32x4*)(cw + UPW + jb), wb2 = *(const f32x4*)(cw + 2 * UPW + jb), bb = *(const f32x4*)(cb + jb);
#pragma unroll
            for (int ai = 0; ai < 2; ++ai) {
                const int rho = 2 * ai + wr;
                const f32x4 z4 = (f32x4){0.f, 0.f, 0.f, 0.f};
#pragma unroll
                for (int m = 0; m < 4; ++m) {
                    f32x4 Xa = z4, Xb = z4, Ya = z4, Yb = z4;
                    if (m == 0 && rho > 0) { Xa = *(const LAS f32x4*)(xch + ((rho - 1) * 2 + 1) * 256 + colw + 4 * n); Xb = *(const LAS f32x4*)(xch + ((rho - 1) * 2 + 1) * 256 + 128 + colw + 4 * n); }
                    if (m == 3 && rho < 3) { Ya = *(const LAS f32x4*)(xch + ((rho + 1) * 2) * 256 + colw + 4 * n); Yb = *(const LAS f32x4*)(xch + ((rho + 1) * 2) * 256 + 128 + colw + 4 * n); }
                    const int gr = u.ar + ai * HALF + wr * 64 + m * 16 + fr;
                    const int t = gr & (SEQ - 1);
                    const bool hasp = t != 0, hasn = t != SEQ - 1;
                    const f32x4 va = acc[ai][0][m][n], vb = acc[ai][1][m][n];
                    f32x4 pa, pb, na, nb;
#pragma unroll
                    for (int j = 0; j < 4; ++j) {
                        pa[j] = dpp_shr1(m > 0 ? dpp_ror1(acc[ai][0][m > 0 ? m - 1 : 0][n][j]) : Xa[j], va[j]);
                        pb[j] = dpp_shr1(m > 0 ? dpp_ror1(acc[ai][1][m > 0 ? m - 1 : 0][n][j]) : Xb[j], vb[j]);
                        na[j] = dpp_shl1(m < 3 ? dpp_ror15(acc[ai][0][m < 3 ? m + 1 : 3][n][j]) : Ya[j], va[j]);
                        nb[j] = dpp_shl1(m < 3 ? dpp_ror15(acc[ai][1][m < 3 ? m + 1 : 3][n][j]) : Yb[j], vb[j]);
                    }
                    const float fp = hasp ? 1.0f : 0.0f, fn = hasn ? 1.0f : 0.0f;
                    const f32x4 ca = ba + (wa0 * fp) * pa + wa1 * va + (wa2 * fn) * na;
                    const f32x4 cbv = bb + (wb0 * fp) * pb + wb1 * vb + (wb2 * fn) * nb;
                    const f32x4 ex = ca * -1.4426950408889634f;
                    f32x4 sg;
#pragma unroll
                    for (int j = 0; j < 4; ++j) sg[j] = __builtin_amdgcn_rcpf(1.0f + fast_exp2(ex[j]));
                    const f32x4 r = ca * sg * cbv;
                    if (gr >= olo && gr < ohi) { u32x2 w; w.x = pk2(r[0], r[1]); w.y = pk2(r[2], r[3]); *(u32x2*)(act + (size_t)gr * FF + ja) = w; }
                }
            }
        }
    }
};

template <class Epi, class Sched>
__device__ __forceinline__ void gemm_phase(lds_u8* lds, const Gemm g, const Sched& S, const Epi& E, const int tid) {
    const int wid = __builtin_amdgcn_readfirstlane(tid >> 6), lane = tid & 63, wr = wid >> 2, wc = wid & 3, fr = lane & 15, fq = lane >> 4;
    const int K = g.K, nt = K / BK;
    unsigned voffA[2], voffB[2];
#pragma unroll
    for (int i = 0; i < 2; ++i) { int R, C; stage_rc(tid * 16 + i * 8192, R, C); const int Rb = Epi::PERM ? ((R & ~31) + perm32(R & 31)) : R;
        voffA[i] = (unsigned)(R * K + C) * 2u; voffB[i] = (unsigned)(Rb * K + C) * 2u; }
    const size_t kstep = (size_t)(BK * 2);
    const size_t hstep = (size_t)HALF * K * 2;
    const size_t tstep = 2 * hstep;
    const unsigned ldsw = (unsigned)wid * 1024u;
    const int aoff = lds_byte(wr * 64 + fr, fq * 8), boff = lds_byte(wc * 32 + fr, fq * 8);
#define PG8_SA(b, h) (((b) * 2 + (h)) * HTB)
#define PG8_SB(b, h) ((4 + (b) * 2 + (h)) * HTB)
#define PG8_STAGE(bufoff, gbase, voff) do { _Pragma("unroll") for (int _i = 0; _i < 2; ++_i) \
        __builtin_amdgcn_global_load_lds((const unsigned*)((const char*)(gbase) + (voff)[_i]), (LAS unsigned*)(lds + (bufoff) + ldsw + _i * 8192), 16, 0, 0); } while (0)
#define PG8_LDA(dst, b, h) do { _Pragma("unroll") for (int m = 0; m < 4; ++m) _Pragma("unroll") for (int k = 0; k < 2; ++k) dst[m][k] = *(const LAS bf16x8*)(lds + PG8_SA(b, h) + aoff + m * 2048 + k * 1024); } while (0)
#define PG8_LDB(dst, b, h) do { _Pragma("unroll") for (int n = 0; n < 2; ++n) _Pragma("unroll") for (int k = 0; k < 2; ++k) dst[n][k] = *(const LAS bf16x8*)(lds + PG8_SB(b, h) + boff + n * 2048 + k * 1024); } while (0)
#define PG8_MMA(ai, bj, At, Bt) do { __builtin_amdgcn_s_setprio(1); _Pragma("unroll") for (int m = 0; m < 4; ++m) _Pragma("unroll") for (int n = 0; n < 2; ++n) _Pragma("unroll") for (int k = 0; k < 2; ++k) \
        acc[ai][bj][m][n] = __builtin_amdgcn_mfma_f32_16x16x32_bf16(Bt[n][k], At[m][k], acc[ai][bj][m][n], 0, 0, 0); __builtin_amdgcn_s_setprio(0); } while (0)
#define PG8_WAIT_V(n) asm volatile("s_waitcnt vmcnt(" #n ")" ::: "memory")
#define PG8_WAIT_L(n) asm volatile("s_waitcnt lgkmcnt(" #n ")" ::: "memory")
#define PG8_BAR __builtin_amdgcn_s_barrier()
#define PG8_SCHED __builtin_amdgcn_sched_barrier(0)
    Unit cur, nxt; int ui = 0;
    if (!S.next(0, cur)) return;
    f32x4 acc[2][2][4][2];
#pragma unroll
    for (int a = 0; a < 2; ++a)
#pragma unroll
        for (int b = 0; b < 2; ++b)
#pragma unroll
            for (int m = 0; m < 4; ++m)
#pragma unroll
                for (int n = 0; n < 2; ++n) acc[a][b][m][n] = (f32x4){0.f, 0.f, 0.f, 0.f};
    bf16x8 At[4][2], B0[2][2], B1[2][2];
    const char* cA = (const char*)g.A + (size_t)cur.ar * (size_t)(K * 2); const char* cB = (const char*)g.Bt + (size_t)cur.pn * tstep;
    PG8_STAGE(PG8_SB(0, 0), cB, voffB); PG8_STAGE(PG8_SB(0, 1), cB + hstep, voffB); PG8_STAGE(PG8_SA(0, 0), cA, voffA); PG8_STAGE(PG8_SA(0, 1), cA + hstep, voffA);
    if (wr == 1) PG8_BAR;
    PG8_WAIT_V(2); PG8_BAR;
    PG8_STAGE(PG8_SB(1, 0), cB + kstep, voffB); PG8_STAGE(PG8_SA(1, 0), cA + kstep, voffA); PG8_STAGE(PG8_SB(1, 1), cB + hstep + kstep, voffB);
    PG8_WAIT_V(6); PG8_BAR;
    for (;;) {
        const bool has_next = S.next(ui + 1, nxt);
        const char* nA = has_next ? (const char*)g.A + (size_t)nxt.ar * (size_t)(K * 2) : cA; const char* nB = has_next ? (const char*)g.Bt + (size_t)nxt.pn * tstep : cB;
        for (int t = 0; t < nt; t += 2) {
            const bool last = (t == nt - 2);
            const char* a1 = cA + (size_t)(t + 1) * kstep;
            const char* a2 = last ? nA : cA + (size_t)(t + 2) * kstep; const char* b2 = last ? nB : cB + (size_t)(t + 2) * kstep;
            const char* a3 = a2 + kstep; const char* b3 = b2 + kstep;
            PG8_LDB(B0, 0, 0); PG8_LDB(B1, 0, 1); PG8_SCHED; PG8_LDA(At, 0, 0); PG8_STAGE(PG8_SA(1, 1), a1 + hstep, voffA);
            PG8_WAIT_V(8); PG8_WAIT_L(0); PG8_BAR; PG8_MMA(0, 0, At, B0); PG8_MMA(0, 1, At, B1); PG8_BAR; PG8_SCHED;
            PG8_LDA(At, 0, 1); PG8_STAGE(PG8_SB(0, 0), b2, voffB); PG8_STAGE(PG8_SB(0, 1), b2 + hstep, voffB); PG8_STAGE(PG8_SA(0, 0), a2, voffA);
            PG8_WAIT_V(8); PG8_WAIT_L(0); PG8_BAR; PG8_MMA(1, 0, At, B0); PG8_MMA(1, 1, At, B1); PG8_BAR; PG8_SCHED;
            PG8_LDB(B0, 1, 0); PG8_LDB(B1, 1, 1); PG8_SCHED; PG8_LDA(At, 1, 0); PG8_STAGE(PG8_SA(0, 1), a2 + hstep, voffA);
            PG8_WAIT_V(8); PG8_WAIT_L(0); PG8_BAR; PG8_MMA(0, 0, At, B0); PG8_MMA(0, 1, At, B1); PG8_BAR; PG8_SCHED;
            PG8_LDA(At, 1, 1); PG8_STAGE(PG8_SB(1, 0), b3, voffB); PG8_STAGE(PG8_SB(1, 1), b3 + hstep, voffB); PG8_STAGE(PG8_SA(1, 0), a3, voffA);
            PG8_WAIT_V(8); PG8_WAIT_L(0); PG8_BAR; PG8_MMA(1, 0, At, B0); PG8_MMA(1, 1, At, B1); PG8_BAR; PG8_SCHED;
        }
        if (wr == 0) PG8_BAR;
        E(acc, cur, wr, wc, fr, fq, lds);
        if (!has_next) break;
#pragma unroll
        for (int a = 0; a < 2; ++a)
#pragma unroll
            for (int b = 0; b < 2; ++b)
#pragma unroll
                for (int m = 0; m < 4; ++m)
#pragma unroll
                    for (int n = 0; n < 2; ++n) acc[a][b][m][n] = (f32x4){0.f, 0.f, 0.f, 0.f};
        cur = nxt; cA = nA; cB = nB; ++ui;
        if (wr == 1) PG8_BAR;
    }
    PG8_WAIT_V(0);
    PG8_BAR;
#undef PG8_SA
#undef PG8_SB
#undef PG8_STAGE
#undef PG8_LDA
#undef PG8_LDB
#undef PG8_MMA
#undef PG8_WAIT_V
#undef PG8_WAIT_L
#undef PG8_BAR
#undef PG8_SCHED
}
}

struct Args {
    const float* in[17];
    float* out; unsigned char* ws;
    int ph_lo, ph_hi;
};
enum { I_X = 0, I_C, I_WADA, I_BADA, I_NORMG, I_WIN, I_AQN, I_AKN, I_BLB, I_BON, I_CQN, I_CKN, I_WOUT, I_WUP, I_CONVW, I_CONVB, I_WDOWN };

__device__ __forceinline__ void p0_transpose_item(const float* W, int K, int N, bf16_t* WT, int mode, LAS float* scr, int item, int lane) {
    const int nblk = N / 32, kb = item / nblk, nb = item % nblk, k0 = 64 * kb, n0 = 32 * nb;
    int rbase = n0;
    if (mode == 1) { const int isb = n0 / FF, j0 = n0 % FF; rbase = 256 * (j0 / 128) + (j0 % 128) + 128 * isb; }
    { float tmp[32];
#pragma unroll
      for (int i = 0; i < 32; ++i) { const int kk = 2 * i + (lane >> 5); tmp[i] = __builtin_nontemporal_load(&W[(size_t)(k0 + kk) * N + n0 + (lane & 31)]); }
#pragma unroll
      for (int i = 0; i < 32; ++i) { const int kk = 2 * i + (lane >> 5); scr[kk * 33 + (lane & 31)] = tmp[i]; } }
    asm volatile("s_waitcnt lgkmcnt(0)" ::: "memory");
    const int c = lane & 7;
#pragma unroll
    for (int j = 0; j < 4; ++j) { const int n = (lane >> 3) + 8 * j; const LAS float* s = scr + (8 * c) * 33 + n;
        u32x4 o; o.x = pk2(s[0 * 33], s[1 * 33]); o.y = pk2(s[2 * 33], s[3 * 33]); o.z = pk2(s[4 * 33], s[5 * 33]); o.w = pk2(s[6 * 33], s[7 * 33]);
        *(u32x4*)(WT + (size_t)(rbase + n) * K + k0 + 8 * c) = o; }
    asm volatile("s_waitcnt lgkmcnt(0)" ::: "memory");
}

__device__ __forceinline__ void phase_prologue(const Args& a, lds_u8* lds, int vcu, int G, const int tid, const int bx) {
    const int lane = tid & 63, wave = tid >> 6;
    unsigned char* ws = a.ws;
    if (bx == 0) {
        float* tb = (float*)(ws + WS_ROPE);
        for (int e = tid; e < 1024; e += NTHREADS) { const int pos = e >> 4, i = e & 15; const float inv = exp2f(-(float)i * (13.287712379549449f / 16.0f)); const float ang = (float)pos * inv;
            tb[2 * e] = cosf(ang); tb[2 * e + 1] = sinf(ang); }
    }
    {
        LAS float* sc = (LAS float*)(lds + 0);
        LAS float* red = (LAS float*)(lds + 32768);
        bool have = false;
        for (int it = vcu; it < DEPTH * 96; it += G) {
            if (!have) { const float* c = a.in[I_C];
                for (int e = tid; e < NB * DM; e += NTHREADS) { const int b = e >> 10, k = e & 1023; sc[k * 8 + b] = silu_f(c[e]); }
                have = true; __syncthreads(); }
            const int l = it / 96, n0 = 64 * (it % 96);
            const float* wp = a.in[I_WADA] + ((size_t)l * DM + 128 * wave) * 6144 + n0 + lane;
            float acc[8];
#pragma unroll
            for (int b = 0; b < 8; ++b) acc[b] = 0.f;
#pragma unroll 32
            for (int kk = 0; kk < 128; ++kk) { const float wv = __builtin_nontemporal_load(&wp[(size_t)kk * 6144]); const LAS f32x4* s4 = (const LAS f32x4*)(sc + (128 * wave + kk) * 8); const f32x4 s0 = s4[0], s1 = s4[1];
                acc[0] += s0[0] * wv; acc[1] += s0[1] * wv; acc[2] += s0[2] * wv; acc[3] += s0[3] * wv; acc[4] += s1[0] * wv; acc[5] += s1[1] * wv; acc[6] += s1[2] * wv; acc[7] += s1[3] * wv; }
#pragma unroll
            for (int b = 0; b < 8; ++b) red[(wave * 8 + b) * 64 + lane] = acc[b];
            __syncthreads();
            { const int b = tid >> 6, col = tid & 63; float s = 0.f;
#pragma unroll
              for (int w = 0; w < 8; ++w) s += red[(w * 8 + b) * 64 + col];
              ((float*)(ws + WS_MOD))[((size_t)l * 8 + b) * 6144 + n0 + col] = s + a.in[I_BADA][(size_t)l * 6144 + n0 + col]; }
            __syncthreads();
        }
        __syncthreads();
    }
    {
        LAS float* scr = (LAS float*)(lds + wave * 8448);
        const int gw = vcu * 8 + wave, NGW = G * 8;
        constexpr int I_IN = 16 * (INW / 32), I_OUT = 16 * (DM / 32), I_UP = 16 * (UPW / 32), I_DN = (FF / 64) * (DM / 32), I_LAYER = I_IN + I_OUT + I_UP + I_DN;
        const int nheavy = (DEPTH * 96 > G && DEPTH * 96 < 2 * G) ? DEPTH * 96 - G : 0, nlight = G - nheavy;
        const int npre = nheavy ? 3 * nlight * 8 : 0;
        for (int pass = 0; pass < 2; ++pass) {
            int it0, ie, st;
            if (pass == 0) { if (!nheavy || vcu < nheavy) continue; it0 = (vcu - nheavy) * 8 + wave; ie = npre; st = nlight * 8; }
            else { it0 = npre + gw; ie = DEPTH * I_LAYER; st = NGW; }
            for (int it = it0; it < ie; it += st) {
                const int l = it / I_LAYER; int r = it % I_LAYER;
                if (r < I_IN) { p0_transpose_item(a.in[I_WIN] + (size_t)l * DM * INW, DM, INW, (bf16_t*)(ws + WS_WIN) + (size_t)l * INW * DM, 0, scr, r, lane); continue; } r -= I_IN;
                if (r < I_OUT) { p0_transpose_item(a.in[I_WOUT] + (size_t)l * DM * DM, DM, DM, (bf16_t*)(ws + WS_WOUT) + (size_t)l * DM * DM, 0, scr, r, lane); continue; } r -= I_OUT;
                if (r < I_UP) { p0_transpose_item(a.in[I_WUP] + (size_t)l * DM * UPW, DM, UPW, (bf16_t*)(ws + WS_WUP) + (size_t)l * UPW * DM, 1, scr, r, lane); continue; } r -= I_UP;
                p0_transpose_item(a.in[I_WDOWN] + (size_t)l * FF * DM, FF, DM, (bf16_t*)(ws + WS_WDN) + (size_t)l * DM * FF, 0, scr, r, lane);
            }
        }
    }
}

__device__ __forceinline__ void norm_rows4(const float* x, const float* g, const float* mod_l  , int which_sh, bf16_t* h, int m0, int lane) {
    const int b = m0 / SEQ;
    const f32x4* gr = (const f32x4*)g + lane;
    const f32x4* shr = (const f32x4*)(mod_l + (size_t)b * 6144 + which_sh * DM) + lane;
    const f32x4* scr = (const f32x4*)(mod_l + (size_t)b * 6144 + (which_sh + 1) * DM) + lane;
    f32x4 v[4][4];
#pragma unroll
    for (int r = 0; r < 4; ++r) { const f32x4* xr = (const f32x4*)(x + (size_t)(m0 + r) * DM) + lane;
#pragma unroll
        for (int j = 0; j < 4; ++j) v[r][j] = xr[64 * j]; }
    f32x4 gs[4], sh[4];
#pragma unroll
    for (int j = 0; j < 4; ++j) { gs[j] = gr[64 * j] * (scr[64 * j] + 1.0f); sh[j] = shr[64 * j]; }
#pragma unroll
    for (int r = 0; r < 4; ++r) {
        float s = 0.f;
#pragma unroll
        for (int j = 0; j < 4; ++j) s += (v[r][j].x * v[r][j].x + v[r][j].y * v[r][j].y) + (v[r][j].z * v[r][j].z + v[r][j].w * v[r][j].w);
        const float rstd = rsqrtf(wave_sum(s) * (1.f / DM) + EPS);
        u32x2* o8 = (u32x2*)(h + (size_t)(m0 + r) * DM) + lane;
#pragma unroll
        for (int j = 0; j < 4; ++j) { const f32x4 y = v[r][j] * rstd * gs[j] + sh[j];
            u32x2 w; w.x = pk2(y.x, y.y); w.y = pk2(y.z, y.w); o8[64 * j] = w; }
    }
}
__device__ __forceinline__ void norm_rows4_bf(const bf16_t* x, const float* g, const float* mod_l  , int which_sh, bf16_t* h, int m0, int lane) {
    const int b = m0 / SEQ;
    const float* shp = mod_l + (size_t)b * 6144 + which_sh * DM; const float* scp = shp + DM;
    u32x4 raw[4][2];
#pragma unroll
    for (int r = 0; r < 4; ++r) { const u32x4* xr = (const u32x4*)(x + (size_t)(m0 + r) * DM) + lane; raw[r][0] = xr[0]; raw[r][1] = xr[64]; }
    f32x4 gs[2][2], sh[2][2];
#pragma unroll
    for (int c = 0; c < 2; ++c)
#pragma unroll
        for (int q = 0; q < 2; ++q) { const int col = 512 * c + 8 * lane + 4 * q; gs[c][q] = *(const f32x4*)(g + col) * (*(const f32x4*)(scp + col) + 1.0f); sh[c][q] = *(const f32x4*)(shp + col); }
#pragma unroll
    for (int r = 0; r < 4; ++r) {
        f32x4 v[2][2]; float s = 0.f;
#pragma unroll
        for (int c = 0; c < 2; ++c) { const u32x4 w = raw[r][c]; v[c][0] = (f32x4){bflo(w.x), bfhi(w.x), bflo(w.y), bfhi(w.y)}; v[c][1] = (f32x4){bflo(w.z), bfhi(w.z), bflo(w.w), bfhi(w.w)};
#pragma unroll
            for (int q = 0; q < 2; ++q) s += (v[c][q].x * v[c][q].x + v[c][q].y * v[c][q].y) + (v[c][q].z * v[c][q].z + v[c][q].w * v[c][q].w); }
        const float rstd = rsqrtf(wave_sum(s) * (1.f / DM) + EPS);
        u32x4* o16 = (u32x4*)(h + (size_t)(m0 + r) * DM) + lane;
#pragma unroll
        for (int c = 0; c < 2; ++c) { const f32x4 y0 = v[c][0] * rstd * gs[c][0] + sh[c][0], y1 = v[c][1] * rstd * gs[c][1] + sh[c][1];
            u32x4 w; w.x = pk2(y0.x, y0.y); w.y = pk2(y0.z, y0.w); w.z = pk2(y1.x, y1.y); w.w = pk2(y1.z, y1.w); o16[64 * c] = w; }
    }
}
__device__ __forceinline__ void phase_norm_bf(const bf16_t* x, const float* g, const float* mod_l, int which_sh, bf16_t* h, int vcu, int G, const int tid) {
    const int lane = tid & 63, wave = tid >> 6;
    const int gw = vcu * 8 + wave, NGW = G * 8;
    for (int m0 = gw * 4; m0 < M; m0 += NGW * 4) norm_rows4_bf(x, g, mod_l, which_sh, h, m0, lane);
}
__device__ __forceinline__ void phase_norm(const float* x, const float* g, const float* mod_l, int which_sh, bf16_t* h, int vcu, int G, const int tid) {
    const int lane = tid & 63, wave = tid >> 6;
    const int gw = vcu * 8 + wave, NGW = G * 8;
    for (int m0 = gw * 4; m0 < M; m0 += NGW * 4) norm_rows4(x, g, mod_l, which_sh, h, m0, lane);
}

__device__ __forceinline__ float hgrn_lb(const float* b_lb, int dir, int l, int col) {
    const float* p = b_lb + (size_t)dir * DEPTH * 256 + col;
    const float v0 = p[0], v1 = p[256], v2 = p[512], v3 = p[768];
    const float mx = fmaxf(fmaxf(v0, v1), fmaxf(v2, v3));
    const float e0 = __expf(v0 - mx), e1 = __expf(v1 - mx), e2 = __expf(v2 - mx), e3 = __expf(v3 - mx);
    const float s = e0 + e1 + e2 + e3;
    float acc = 0.f; if (l >= 1) acc += e1; if (l >= 2) acc += e2; if (l >= 3) acc += e3;
    return acc / s;
}
__device__ __forceinline__ void hgrn_fk(float xpre, float lb, float& lf, float& kk) {
    float f = lb + (1.0f - lb) * __builtin_amdgcn_rcpf(1.0f + fast_exp2(-1.4426950408889634f * xpre));
    f = fmaxf(f, 1e-6f);
    lf = __builtin_amdgcn_logf(f); kk = 1.0f - f;
}

__device__ __forceinline__ void phase_prep(const Args& a, lds_u8* lds, int l, int vcu, int G, const int tid, const bool dry) {
    const int lane = tid & 63, wave = tid >> 6;
    const int gw = vcu * 8 + wave, NGW = G * 8;
    unsigned char* ws = a.ws;
    bf16_t* proj = (bf16_t*)(ws + WS_PROJ);
    const float* rope = (const float*)(ws + WS_ROPE);
    {
        const float gak = a.in[I_AKN][l * 64 + lane], gck = a.in[I_CKN][l * 64 + lane];
        const int half = lane >> 5, side = (lane >> 4) & 1, i = lane & 15;
        for (int m0 = gw * 4; m0 < M; m0 += NGW * 4) {
            unsigned short raw[4][4];
#pragma unroll
            for (int r = 0; r < 4; ++r) { const bf16_t* row = proj + (size_t)(m0 + r) * INW;
                raw[r][0] = row[C_AK + lane]; raw[r][1] = row[C_AK + 64 + lane]; raw[r][2] = row[C_CK + lane]; raw[r][3] = row[C_CK + 64 + lane]; }
#pragma unroll
            for (int r = 0; r < 4; ++r) {
                const int m = m0 + r, t = m & (SEQ - 1);
                bf16_t* wrow = (dry ? (bf16_t*)(ws + WS_U) : proj) + (size_t)m * INW;
                const int pos = half ? (t & 63) : (t >> 6);
                const float cs = rope[(pos * 16 + i) * 2], sn = rope[(pos * 16 + i) * 2 + 1];
#pragma unroll
                for (int hh = 0; hh < 2; ++hh) {
                    float v = bf2f(raw[r][hh]);
                    const float ss = wave_sum(v * v);
                    v = v * rsqrtf(ss * (1.f / 64) + EPS) * gak;
                    const float pr = __shfl_xor(v, 16);
                    const float o = side ? (v * cs + pr * sn) : (v * cs - pr * sn);
                    wrow[C_AK + hh * 64 + lane] = (bf16_t)f2bf(o);
                }
#pragma unroll
                for (int hh = 0; hh < 2; ++hh) {
                    float v = bf2f(raw[r][2 + hh]);
                    const float ss = wave_sum(v * v);
                    v = v * rsqrtf(ss * (1.f / 64) + EPS) * gck;
                    wrow[C_CK + hh * 64 + lane] = (bf16_t)f2bf(v);
                }
            }
        }
    }
    {
        LAS bf16_t* scr = (LAS bf16_t*)(lds + wave * 9216);
        bf16_t* vt = (bf16_t*)(ws + WS_VT);
        for (int it = gw; it < NB * 4 * 32; it += NGW) {
            const int b = it >> 7, kv4 = (it >> 5) & 3, tb = it & 31;
            const int col0 = (kv4 < 2 ? C_AV : C_CV) + (kv4 & 1) * 64;
            const bf16_t* src = proj + ((size_t)b * SEQ + tb * 64) * INW + col0 + lane;
#pragma unroll
            for (int rb = 0; rb < 64; rb += 32) { unsigned short tmp[32];
#pragma unroll
              for (int r = 0; r < 32; ++r) tmp[r] = src[(size_t)(rb + r) * INW];
#pragma unroll
              for (int r = 0; r < 32; ++r) scr[(rb + r) * 66 + lane] = tmp[r]; }
            asm volatile("s_waitcnt lgkmcnt(0)" ::: "memory");
            bf16_t* dst = vt + (((size_t)b * 4 + kv4) * 64) * SEQ + tb * 64 + lane;
#pragma unroll 16
            for (int d = 0; d < 64; ++d) dst[(size_t)d * SEQ] = scr[lane * 66 + d];
            asm volatile("s_waitcnt lgkmcnt(0)" ::: "memory");
        }
    }
    {
        LAS bf16_t* klt = (LAS bf16_t*)(lds + wave * 9216);
        float* HL = (float*)(ws + WS_HL); float* HDp = (float*)(ws + WS_HD);
        const int r16 = lane & 15, q4 = lane >> 4;
        for (int it = gw; it < NB * 4 * 2 * 32; it += NGW) {
            const int c = it & 31, dir = (it >> 5) & 1, hh = (it >> 6) & 3, b = it >> 8;
            const float lb = hgrn_lb(a.in[I_BLB], dir, l, hh * 64 + lane);
            const size_t rbase = (size_t)b * SEQ + c * 64;
            const int fcol = (dir ? C_BFB : C_BFF) + hh * 64 + lane;
            unsigned fpk[32];
#pragma unroll
            for (int s = 0; s < 64; s += 2) { const int t0 = dir ? (63 - s) : s, t1 = dir ? (62 - s) : s + 1; fpk[s >> 1] = (unsigned)proj[(rbase + t0) * INW + fcol] | ((unsigned)proj[(rbase + t1) * INW + fcol] << 16); }
            float total = 0.f;
#pragma unroll
            for (int s = 63; s >= 0; --s) { float lf, kk; hgrn_fk((s & 1) ? bfhi(fpk[s >> 1]) : bflo(fpk[s >> 1]), lb, lf, kk);
                klt[lane * 72 + s] = (bf16_t)f2bf(kk * fast_exp2(total)); total += lf; }
            asm volatile("s_waitcnt lgkmcnt(0)" ::: "memory");
            HDp[(size_t)it * 64 + lane] = fast_exp2(total);
            const int vcol = C_BI + hh * 64;
            float* Lo = HL + (size_t)it * 4096;
#pragma unroll
            for (int mi = 0; mi < 4; ++mi) {
                bf16x8 af[2];
#pragma unroll
                for (int ks = 0; ks < 2; ++ks)
#pragma unroll
                    for (int j = 0; j < 8; ++j) { const int s = 32 * ks + 8 * q4 + j; const int tk = dir ? (63 - s) : s; af[ks][j] = (short)proj[(rbase + tk) * INW + vcol + 16 * mi + r16]; }
#pragma unroll
                for (int ni = 0; ni < 4; ++ni) {
                    f32x4 acc = (f32x4){0.f, 0.f, 0.f, 0.f};
#pragma unroll
                    for (int ks = 0; ks < 2; ++ks) { const bf16x8 bfr = *(const LAS bf16x8*)(klt + (16 * ni + r16) * 72 + 32 * ks + 8 * q4);
                        acc = __builtin_amdgcn_mfma_f32_16x16x32_bf16(af[ks], bfr, acc, 0, 0, 0); }
#pragma unroll
                    for (int j = 0; j < 4; ++j) Lo[(16 * mi + 4 * q4 + j) * 64 + 16 * ni + r16] = acc[j];
                }
            }
            asm volatile("s_waitcnt lgkmcnt(0)" ::: "memory");
        }
    }
}

constexpr int AT_KV = 18432;
constexpr int AT_TBL = 4 * AT_KV;
__device__ __forceinline__ int pi32(int m) { return (m & ~12) | ((m & 4) << 1) | ((m & 8) >> 1); }

template <bool BIAS>
__device__ __forceinline__ void attn_unit(lds_u8* lds, const bf16_t* proj, const bf16_t* vt, bf16_t* mix, const bf16_t* po_far, const float* pl, const float* gq, const float* gk, const float* rope,
                                          int b, int h, int qblk, int qcol0, int kcol0, int vsel0, int mixcol0, const int tid) {
    const int lane = tid & 63, wave = __builtin_amdgcn_readfirstlane(tid >> 6);
    const int r32 = lane & 31, hi = lane >> 5;
    const int kvh = h / 3;
    const int q0 = qblk * 256;
    const int qp = q0 + 32 * wave + r32;
    int tlo = 0, ntile = SEQ / 64;
    if (BIAS) { const int klo = q0 - 256 < 0 ? 0 : q0 - 256, khi_ = q0 + 255 + 256 > SEQ - 1 ? SEQ - 1 : q0 + 255 + 256; tlo = klo >> 6; ntile = (khi_ >> 6) - tlo + 1; }
    const bf16_t* kbase = proj + (size_t)b * SEQ * INW + kcol0 + kvh * 64;
    const bf16_t* vbase = vt + ((size_t)b * 4 + vsel0 + kvh) * 64 * SEQ;
    const int lrow_ = tid >> 3, lc16 = tid & 7;
    u32x4 kreg, vreg;
#define AT_LOAD(tile) do { const int key0_ = (tile) * 64; kreg = *(const u32x4*)(kbase + (size_t)(key0_ + lrow_) * INW + lc16 * 8); vreg = *(const u32x4*)(vbase + (size_t)lrow_ * SEQ + key0_ + lc16 * 8); } while (0)
#define AT_STORE(bufi) do { lds_u8* bb_ = lds + (bufi) * AT_KV; *(LAS u32x4*)(bb_ + lrow_ * 144 + lc16 * 16) = kreg; *(LAS u32x4*)(bb_ + 9216 + lrow_ * 144 + lc16 * 16) = vreg; } while (0)
    u32x4 qraw[4];
    { const bf16_t* qrow = proj + ((size_t)b * SEQ + qp) * INW + qcol0 + h * 64 + 8 * hi;
#pragma unroll
      for (int d0 = 0; d0 < 4; ++d0) qraw[d0] = *(const u32x4*)(qrow + 16 * d0); }
    AT_LOAD(tlo);
    const float gql = gq[lane], gkl = gk[lane];
    f32x4 gqv[4][2];
#pragma unroll
    for (int d0 = 0; d0 < 4; ++d0) { gqv[d0][0] = *(const f32x4*)(gq + 16 * d0 + 8 * hi); gqv[d0][1] = *(const f32x4*)(gq + 16 * d0 + 8 * hi + 4); }
    f32x4 rpr[4], rpc[4];
    if (!BIAS) { const int pr = qp >> 6, pc = qp & 63;
#pragma unroll
        for (int j4 = 0; j4 < 4; ++j4) { rpr[j4] = *(const f32x4*)(rope + (pr * 16 + 8 * hi) * 2 + 4 * j4); rpc[j4] = *(const f32x4*)(rope + (pc * 16 + 8 * hi) * 2 + 4 * j4); } }
    float ref;
    { float a = fabsf(gql), c = fabsf(gkl);
#pragma unroll
      for (int o = 1; o < 64; o <<= 1) { a = fmaxf(a, __shfl_xor(a, o)); c = fmaxf(c, __shfl_xor(c, o)); }
      ref = 64.0f * 0.125f * 1.4426950408889634f * 1.02f * a * c + (BIAS ? 1.6f : 0.0f); }
    if (BIAS) {
        LAS float* tbl = (LAS float*)(lds + AT_TBL);
        const float slope = fast_exp2(-(float)(h + 1) * (4.0f / 3.0f));
        for (int e = tid; e < 4096; e += NTHREADS) { const int d = e - 2048, ad = d < 0 ? -d : d;
            const int mult = ad > 256 ? 0 : (ad <= 64 ? 1 : 0) + ((ad & 3) == 0 ? 1 : 0) + ((ad & 15) == 0 ? 1 : 0);
            const float lg = mult == 3 ? 1.5849625007211562f : (mult == 2 ? 1.0f : 0.0f);
            tbl[e] = mult ? (lg - slope * (float)ad * 1.4426950408889634f - ref) : -1e30f; }
    }
    bf16x8 qr[4];
    {
        float v[4][8]; float ss = 0.f;
#pragma unroll
        for (int d0 = 0; d0 < 4; ++d0) { const u32x4 w = qraw[d0];
            v[d0][0] = bflo(w.x); v[d0][1] = bfhi(w.x); v[d0][2] = bflo(w.y); v[d0][3] = bfhi(w.y); v[d0][4] = bflo(w.z); v[d0][5] = bfhi(w.z); v[d0][6] = bflo(w.w); v[d0][7] = bfhi(w.w);
#pragma unroll
            for (int j = 0; j < 8; ++j) ss += v[d0][j] * v[d0][j]; }
        ss += __shfl_xor(ss, 32);
        const float rstd = rsqrtf(ss * (1.f / 64) + EPS);
#pragma unroll
        for (int d0 = 0; d0 < 4; ++d0)
#pragma unroll
            for (int j = 0; j < 8; ++j) v[d0][j] *= rstd * gqv[d0][j >> 2][j & 3];
        if (!BIAS) {
#pragma unroll
            for (int j = 0; j < 8; ++j) {
                { const float c = rpr[j >> 1][2 * (j & 1)], s = rpr[j >> 1][2 * (j & 1) + 1]; const float x1 = v[0][j], x2 = v[1][j]; v[0][j] = x1 * c - x2 * s; v[1][j] = x2 * c + x1 * s; }
                { const float c = rpc[j >> 1][2 * (j & 1)], s = rpc[j >> 1][2 * (j & 1) + 1]; const float x1 = v[2][j], x2 = v[3][j]; v[2][j] = x1 * c - x2 * s; v[3][j] = x2 * c + x1 * s; } }
        }
        const float qsc = 0.125f * 1.4426950408889634f;
#pragma unroll
        for (int d0 = 0; d0 < 4; ++d0) { u32x4 w; w.x = pk2(v[d0][0] * qsc, v[d0][1] * qsc); w.y = pk2(v[d0][2] * qsc, v[d0][3] * qsc); w.z = pk2(v[d0][4] * qsc, v[d0][5] * qsc); w.w = pk2(v[d0][6] * qsc, v[d0][7] * qsc);
            qr[d0] = __builtin_bit_cast(bf16x8, w); }
    }
    AT_STORE(0);
    __syncthreads();
    float lrow = 0.f;
    f32x16 o0, o1, negref;
#pragma unroll
    for (int i = 0; i < 16; ++i) { o0[i] = 0.f; o1[i] = 0.f; negref[i] = -ref; }
    const int krow = pi32(r32);
    for (int step = 0; step < ntile; ++step) {
        const bool ldn = (step + 1 < ntile);
        if (ldn) AT_LOAD(tlo + step + 1);
        {
            const lds_u8* kb = lds + (step & 1) * AT_KV;
            const lds_u8* vb = kb + 9216;
            f32x16 p0, p1;
            if (BIAS) {
                const LAS float* tbl = (const LAS float*)(lds + AT_TBL) + ((tlo + step) * 64 + 8 * hi - qp + 2048);
#pragma unroll
                for (int i = 0; i < 16; ++i) { p0[i] = tbl[(i & 7) + 16 * (i >> 3)]; p1[i] = tbl[(i & 7) + 16 * (i >> 3) + 32]; }
            } else { p0 = negref; p1 = negref; }
#pragma unroll
            for (int d0 = 0; d0 < 4; ++d0) {
                const bf16x8 k0 = *(const LAS bf16x8*)(kb + krow * 144 + 32 * d0 + 16 * hi);
                const bf16x8 k1 = *(const LAS bf16x8*)(kb + (32 + krow) * 144 + 32 * d0 + 16 * hi);
                p0 = __builtin_amdgcn_mfma_f32_32x32x16_bf16(k0, qr[d0], p0, 0, 0, 0);
                p1 = __builtin_amdgcn_mfma_f32_32x32x16_bf16(k1, qr[d0], p1, 0, 0, 0);
            }
            float rs0 = 0.f, rs1 = 0.f;
#pragma unroll
            for (int i = 0; i < 16; ++i) { p0[i] = fast_exp2(p0[i]); p1[i] = fast_exp2(p1[i]); rs0 += p0[i]; rs1 += p1[i]; }
            lrow += rs0 + rs1;
            bf16x8 pb[2][2];
#pragma unroll
            for (int ks = 0; ks < 2; ++ks) {
                u32x4 w; w.x = pk2(p0[8 * ks + 0], p0[8 * ks + 1]); w.y = pk2(p0[8 * ks + 2], p0[8 * ks + 3]); w.z = pk2(p0[8 * ks + 4], p0[8 * ks + 5]); w.w = pk2(p0[8 * ks + 6], p0[8 * ks + 7]);
                pb[0][ks] = __builtin_bit_cast(bf16x8, w);
                u32x4 w1; w1.x = pk2(p1[8 * ks + 0], p1[8 * ks + 1]); w1.y = pk2(p1[8 * ks + 2], p1[8 * ks + 3]); w1.z = pk2(p1[8 * ks + 4], p1[8 * ks + 5]); w1.w = pk2(p1[8 * ks + 6], p1[8 * ks + 7]);
                pb[1][ks] = __builtin_bit_cast(bf16x8, w1);
            }
#pragma unroll
            for (int sub = 0; sub < 2; ++sub)
#pragma unroll
                for (int ks = 0; ks < 2; ++ks) {
                    const bf16x8 v0 = *(const LAS bf16x8*)(vb + r32 * 144 + (32 * sub + 16 * ks + 8 * hi) * 2);
                    const bf16x8 v1 = *(const LAS bf16x8*)(vb + (32 + r32) * 144 + (32 * sub + 16 * ks + 8 * hi) * 2);
                    o0 = __builtin_amdgcn_mfma_f32_32x32x16_bf16(v0, pb[sub][ks], o0, 0, 0, 0);
                    o1 = __builtin_amdgcn_mfma_f32_32x32x16_bf16(v1, pb[sub][ks], o1, 0, 0, 0);
                }
        }
        if (ldn) AT_STORE((step + 1) & 1);
        __syncthreads();
    }
#undef AT_LOAD
#undef AT_STORE
    lrow += __shfl_xor(lrow, 32);
    {
        const size_t grow = (size_t)b * SEQ + qp;
        const bf16_t* fpo = BIAS ? po_far + grow * 384 + h * 64 + 4 * hi : nullptr;
        const float inv = 1.0f / (lrow + (BIAS ? pl[grow * 6 + h] : 0.0f));
        bf16_t* orow = mix + grow * DM + mixcol0 + h * 64 + 4 * hi;
#pragma unroll
        for (int g4 = 0; g4 < 4; ++g4) {
            u32x2 f0 = (u32x2){0u, 0u}, f1 = (u32x2){0u, 0u};
            if (BIAS) { f0 = *(const u32x2*)(fpo + 8 * g4); f1 = *(const u32x2*)(fpo + 32 + 8 * g4); }
            { const float x0 = (o0[4 * g4] + bflo(f0.x)) * inv, x1 = (o0[4 * g4 + 1] + bfhi(f0.x)) * inv, x2 = (o0[4 * g4 + 2] + bflo(f0.y)) * inv, x3 = (o0[4 * g4 + 3] + bfhi(f0.y)) * inv;
              u32x2 w; w.x = pk2(x0, x1); w.y = pk2(x2, x3); *(u32x2*)(orow + 8 * g4) = w; }
            { const float x0 = (o1[4 * g4] + bflo(f1.x)) * inv, x1 = (o1[4 * g4 + 1] + bfhi(f1.x)) * inv, x2 = (o1[4 * g4 + 2] + bflo(f1.y)) * inv, x3 = (o1[4 * g4 + 3] + bfhi(f1.y)) * inv;
              u32x2 w; w.x = pk2(x0, x1); w.y = pk2(x2, x3); *(u32x2*)(orow + 32 + 8 * g4) = w; }
        }
    }
}

__device__ __forceinline__ void attn_r16_unit(lds_u8* lds, const bf16_t* proj, bf16_t* po, float* pl, const float* gq, const float* gk, int b, int kvh, int rho, const int tid) {
    const int lane = tid & 63, wave = __builtin_amdgcn_readfirstlane(tid >> 6);
    const int qs = wave & 3, kh = wave >> 2, r32 = lane & 31, hi = lane >> 5;
    const int iq = 32 * qs + r32;
    const size_t qrow_g = (size_t)b * SEQ + rho + 16 * iq;
    const bf16_t* qrow0 = proj + qrow_g * INW + C_CQ + (kvh * 3) * 64 + 8 * hi;
    u32x4 qcur[4], qnxt[4];
#pragma unroll
    for (int d0 = 0; d0 < 4; ++d0) { qcur[d0] = *(const u32x4*)(qrow0 + 16 * d0); qnxt[d0] = qcur[d0]; }
    u32x4 kst[2], vst[2];
    const int th = tid & 255;
#pragma unroll
    for (int i_ = 0; i_ < 2; ++i_) { const int c_ = th + 256 * i_, row_ = c_ >> 3, c16_ = c_ & 7;
        const bf16_t* src = proj + ((size_t)b * SEQ + rho + 16 * (64 * kh + row_)) * INW + kvh * 64 + c16_ * 8;
        kst[i_] = *(const u32x4*)(src + C_CK); vst[i_] = *(const u32x4*)(src + C_CV); }
    const float gql = gq[lane], gkl = gk[lane];
    float ref;
    { float a = fabsf(gql), c = fabsf(gkl);
#pragma unroll
      for (int o = 1; o < 64; o <<= 1) { a = fmaxf(a, __shfl_xor(a, o)); c = fmaxf(c, __shfl_xor(c, o)); }
      ref = 64.0f * 0.125f * 1.4426950408889634f * 1.02f * a * c + 1.6f; }
    LAS float* tb = (LAS float*)(lds + 40960);
    for (int e = tid; e < 768; e += NTHREADS) { const int hq = e >> 8, d = (e & 255) - 128, ad = d < 0 ? -d : d; const float slope = fast_exp2(-(float)(kvh * 3 + hq + 1) * (4.0f / 3.0f));
        tb[e] = (ad > 16 && ad <= 64) ? (-slope * 16.0f * (float)ad * 1.4426950408889634f - ref) : -1e30f; }
    lds_u8* hb = lds + kh * AT_KV;
#pragma unroll
    for (int i_ = 0; i_ < 2; ++i_) { const int c_ = th + 256 * i_, row_ = c_ >> 3, c16_ = c_ & 7;
        *(LAS u32x4*)(hb + row_ * 144 + c16_ * 16) = kst[i_]; *(LAS u32x4*)(hb + 9216 + row_ * 144 + c16_ * 16) = vst[i_]; }
    __syncthreads();
    const int krow = pi32(r32);
    bf16x8 kf[8], vf[8];
#pragma unroll
    for (int d0 = 0; d0 < 4; ++d0) { kf[2 * d0] = *(const LAS bf16x8*)(hb + krow * 144 + 32 * d0 + 16 * hi); kf[2 * d0 + 1] = *(const LAS bf16x8*)(hb + (32 + krow) * 144 + 32 * d0 + 16 * hi); }
    { const LAS bf16_t* vbase = (const LAS bf16_t*)(hb + 9216);
#pragma unroll
      for (int sub = 0; sub < 2; ++sub)
#pragma unroll
        for (int ks = 0; ks < 2; ++ks)
#pragma unroll
            for (int j = 0; j < 8; ++j) { const int key = 32 * sub + 16 * ks + 8 * hi + j;
                vf[(sub * 2 + ks) * 2][j] = (short)vbase[key * 72 + r32]; vf[(sub * 2 + ks) * 2 + 1][j] = (short)vbase[key * 72 + 32 + r32]; } }
    __syncthreads();
    LAS float* cs = (LAS float*)(lds) + (qs * 64 + lane) * 35;
#pragma unroll 1
    for (int hq = 0; hq < 3; ++hq) {
        const int h = kvh * 3 + hq;
        if (hq < 2) {
#pragma unroll
            for (int d0 = 0; d0 < 4; ++d0) qnxt[d0] = *(const u32x4*)(qrow0 + (hq + 1) * 64 + 16 * d0); }
        bf16x8 qr[4];
        {
            f32x4 gqv[4][2];
#pragma unroll
            for (int d0 = 0; d0 < 4; ++d0) { gqv[d0][0] = *(const f32x4*)(gq + 16 * d0 + 8 * hi); gqv[d0][1] = *(const f32x4*)(gq + 16 * d0 + 8 * hi + 4); }
            float v[4][8]; float ss = 0.f;
#pragma unroll
            for (int d0 = 0; d0 < 4; ++d0) { const u32x4 w = qcur[d0];
                v[d0][0] = bflo(w.x); v[d0][1] = bfhi(w.x); v[d0][2] = bflo(w.y); v[d0][3] = bfhi(w.y); v[d0][4] = bflo(w.z); v[d0][5] = bfhi(w.z); v[d0][6] = bflo(w.w); v[d0][7] = bfhi(w.w);
#pragma unroll
                for (int j = 0; j < 8; ++j) ss += v[d0][j] * v[d0][j]; }
            ss += __shfl_xor(ss, 32);
            const float rstd = rsqrtf(ss * (1.f / 64) + EPS) * (0.125f * 1.4426950408889634f);
#pragma unroll
            for (int d0 = 0; d0 < 4; ++d0) { float y[8];
#pragma unroll
                for (int j = 0; j < 8; ++j) y[j] = v[d0][j] * rstd * gqv[d0][j >> 2][j & 3];
                u32x4 w; w.x = pk2(y[0], y[1]); w.y = pk2(y[2], y[3]); w.z = pk2(y[4], y[5]); w.w = pk2(y[6], y[7]); qr[d0] = __builtin_bit_cast(bf16x8, w); }
        }
        f32x16 p0, p1;
        { const LAS float* tbl = tb + hq * 256 + (64 * kh + 8 * hi - iq + 128);
#pragma unroll
          for (int i = 0; i < 16; ++i) { p0[i] = tbl[(i & 7) + 16 * (i >> 3)]; p1[i] = tbl[(i & 7) + 16 * (i >> 3) + 32]; } }
#pragma unroll
        for (int d0 = 0; d0 < 4; ++d0) {
            p0 = __builtin_amdgcn_mfma_f32_32x32x16_bf16(kf[2 * d0], qr[d0], p0, 0, 0, 0);
            p1 = __builtin_amdgcn_mfma_f32_32x32x16_bf16(kf[2 * d0 + 1], qr[d0], p1, 0, 0, 0);
        }
        float lrow = 0.f;
#pragma unroll
        for (int i = 0; i < 16; ++i) { p0[i] = fast_exp2(p0[i]); p1[i] = fast_exp2(p1[i]); lrow += p0[i] + p1[i]; }
        bf16x8 pb[2][2];
#pragma unroll
        for (int ks = 0; ks < 2; ++ks) {
            u32x4 w; w.x = pk2(p0[8 * ks + 0], p0[8 * ks + 1]); w.y = pk2(p0[8 * ks + 2], p0[8 * ks + 3]); w.z = pk2(p0[8 * ks + 4], p0[8 * ks + 5]); w.w = pk2(p0[8 * ks + 6], p0[8 * ks + 7]);
            pb[0][ks] = __builtin_bit_cast(bf16x8, w);
            u32x4 w1; w1.x = pk2(p1[8 * ks + 0], p1[8 * ks + 1]); w1.y = pk2(p1[8 * ks + 2], p1[8 * ks + 3]); w1.z = pk2(p1[8 * ks + 4], p1[8 * ks + 5]); w1.w = pk2(p1[8 * ks + 6], p1[8 * ks + 7]);
            pb[1][ks] = __builtin_bit_cast(bf16x8, w1);
        }
        f32x16 o0, o1;
#pragma unroll
        for (int i = 0; i < 16; ++i) { o0[i] = 0.f; o1[i] = 0.f; }
#pragma unroll
        for (int sub = 0; sub < 2; ++sub)
#pragma unroll
            for (int ks = 0; ks < 2; ++ks) {
                o0 = __builtin_amdgcn_mfma_f32_32x32x16_bf16(vf[(sub * 2 + ks) * 2], pb[sub][ks], o0, 0, 0, 0);
                o1 = __builtin_amdgcn_mfma_f32_32x32x16_bf16(vf[(sub * 2 + ks) * 2 + 1], pb[sub][ks], o1, 0, 0, 0);
            }
        lrow += __shfl_xor(lrow, 32);
        if (kh == 1) { cs[1] = lrow;
#pragma unroll
            for (int i = 0; i < 16; ++i) { cs[2 + i] = o0[i]; cs[18 + i] = o1[i]; } }
        __syncthreads();
        if (kh == 0) {
            bf16_t* orow = po + qrow_g * 384 + h * 64 + 4 * hi;
            if (hi == 0) pl[qrow_g * 6 + h] = lrow + cs[1];
#pragma unroll
            for (int g4 = 0; g4 < 4; ++g4) {
                { u32x2 w; w.x = pk2(o0[4 * g4] + cs[2 + 4 * g4], o0[4 * g4 + 1] + cs[3 + 4 * g4]); w.y = pk2(o0[4 * g4 + 2] + cs[4 + 4 * g4], o0[4 * g4 + 3] + cs[5 + 4 * g4]); *(u32x2*)(orow + 8 * g4) = w; }
                { u32x2 w; w.x = pk2(o1[4 * g4] + cs[18 + 4 * g4], o1[4 * g4 + 1] + cs[19 + 4 * g4]); w.y = pk2(o1[4 * g4 + 2] + cs[20 + 4 * g4], o1[4 * g4 + 3] + cs[21 + 4 * g4]); *(u32x2*)(orow + 32 + 8 * g4) = w; }
            }
        }
        __syncthreads();
#pragma unroll
        for (int d0 = 0; d0 < 4; ++d0) qcur[d0] = qnxt[d0];
    }
}

__device__ __forceinline__ void phase_scan(const Args& a, int vcu, int G, const int tid) {
    const float* HL = (const float*)(a.ws + WS_HL); const float* HDp = (const float*)(a.ws + WS_HD); bf16_t* HS = (bf16_t*)(a.ws + WS_HS);
    for (int e = vcu * NTHREADS + tid; e < 64 * 4096; e += G * NTHREADS) {
        const int seq = e >> 12, idx = e & 4095, k = idx & 63, dir = seq & 1;
        float st = 0.f;
        float hd[32], hl[32];
#pragma unroll
        for (int j = 0; j < 32; ++j) { const int c = dir ? 31 - j : j; const size_t o = (size_t)seq * 32 + c; hd[j] = HDp[o * 64 + k]; hl[j] = HL[o * 4096 + idx]; }
#pragma unroll
        for (int j = 0; j < 32; ++j) { const int c = dir ? 31 - j : j; const size_t o = (size_t)seq * 32 + c; HS[o * 4096 + idx] = (bf16_t)f2bf(st); st = hd[j] * st + hl[j]; }
    }
}

constexpr int HG_OACC = 0, HG_QS = 65536, HG_QD = HG_QS + 9216, HG_KD = HG_QD + 9216, HG_KE = HG_KD + 9216, HG_Q2 = HG_KE + 9216, HG_K2 = HG_Q2 + 4608,
              HG_VT = HG_K2 + 4608, HG_AT = HG_VT + 9216, HG_ST = HG_AT + 9216, HG_GT = HG_ST + 9216, HG_END = HG_GT + 2048;
static_assert(HG_END <= LDS_BYTES, "HGRN LDS map");

__device__ __forceinline__ void hgrn_out_item(const Args& a, lds_u8* lds, int l, int item, const int tid) {
    const int lane = tid & 63, wave = __builtin_amdgcn_readfirstlane(tid >> 6);
    const int k = lane, rg = wave;
    const int b = item >> 5, hh = (item >> 3) & 3, grp = item & 7;
    const int c0 = grp * 4;
    unsigned char* ws = a.ws;
    const bf16_t* proj = (const bf16_t*)(ws + WS_PROJ);
    const float* HL = (const float*)(ws + WS_HL); const float* HDp = (const float*)(ws + WS_HD);
    LAS float* oacc = (LAS float*)(lds + HG_OACC);
    LAS bf16_t* Qs = (LAS bf16_t*)(lds + HG_QS); LAS bf16_t* Qd = (LAS bf16_t*)(lds + HG_QD); LAS bf16_t* Kd = (LAS bf16_t*)(lds + HG_KD); LAS bf16_t* Ke = (LAS bf16_t*)(lds + HG_KE);
    LAS bf16_t* Q2 = (LAS bf16_t*)(lds + HG_Q2); LAS bf16_t* K2 = (LAS bf16_t*)(lds + HG_K2); LAS bf16_t* VT = (LAS bf16_t*)(lds + HG_VT); LAS bf16_t* AT = (LAS bf16_t*)(lds + HG_AT);
    LAS bf16_t* ST = (LAS bf16_t*)(lds + HG_ST); LAS float* gt = (LAS float*)(lds + HG_GT);
    const int r16 = lane & 15, q4 = lane >> 4;
    const float lbv0 = hgrn_lb(a.in[I_BLB], 0, l, hh * 64 + k), lbv1 = hgrn_lb(a.in[I_BLB], 1, l, hh * 64 + k);
    unsigned short rq[8], rf[8], rv[8];
#define HG_LOADRAW(dir_, c_) do { const size_t rb_ = (size_t)b * SEQ + (c_) * 64; _Pragma("unroll") for (int i = 0; i < 8; ++i) { const int s_ = 8 * rg + i; const int tk_ = (dir_) ? (63 - s_) : s_; \
        const bf16_t* rp_ = proj + (rb_ + tk_) * INW; rq[i] = rp_[C_BQ + hh * 64 + k]; rf[i] = rp_[((dir_) ? C_BFB : C_BFF) + hh * 64 + k]; rv[i] = rp_[C_BI + hh * 64 + k]; } } while (0)
    HG_LOADRAW(0, c0);
    float st[8];
#pragma unroll
    for (int i = 0; i < 8; ++i) st[i] = 0.f;
    for (int stp = 0; stp < 8; ++stp) {
        {
            const int dir = stp >> 2, ci = stp & 3;
            const float lb = dir ? lbv1 : lbv0;
            const size_t sbase = (((size_t)b * 4 + hh) * 2 + dir) * 32;
            const int c = dir ? (c0 + 3 - ci) : (c0 + ci);
            if (ci == 0) { const bf16_t* HSp = (const bf16_t*)(ws + WS_HS) + (sbase + c) * 4096 + (8 * wave) * 64 + k;
#pragma unroll
                for (int i = 0; i < 8; ++i) st[i] = bf2f(HSp[i * 64]); }
            float qv[8], lf[8], kk[8];
            u32x4 vpk;
#pragma unroll
            for (int i = 0; i < 8; ++i) { qv[i] = bf2f(rq[i]); hgrn_fk(bf2f(rf[i]), lb, lf[i], kk[i]); }
            vpk.x = rv[0] | ((unsigned)rv[1] << 16); vpk.y = rv[2] | ((unsigned)rv[3] << 16); vpk.z = rv[4] | ((unsigned)rv[5] << 16); vpk.w = rv[6] | ((unsigned)rv[7] << 16);
            const float dk = HDp[(sbase + c) * 64 + k];
            float Ln[8];
            { const float* Lp = HL + (sbase + c) * 4096 + (8 * wave) * 64 + k;
#pragma unroll
              for (int i = 0; i < 8; ++i) Ln[i] = Lp[i * 64]; }
            if (stp < 7) { const int nd = (stp + 1) >> 2, nci = (stp + 1) & 3; const int nc = nd ? (c0 + 3 - nci) : (c0 + nci); HG_LOADRAW(nd, nc); }
#pragma unroll
            for (int i = 1; i < 8; ++i) lf[i] += lf[i - 1];
            gt[rg * 64 + k] = lf[7];
#pragma unroll
            for (int i = 0; i < 8; ++i) ST[(8 * wave + i) * 72 + k] = (bf16_t)f2bf(st[i]);
            __syncthreads();
            float gsum[9]; gsum[0] = 0.f;
#pragma unroll
            for (int g = 0; g < 8; ++g) gsum[g + 1] = gsum[g] + gt[g * 64 + k];
            float off = 0.f, bS = 0.f, bE = 0.f;
#pragma unroll
            for (int g = 0; g < 8; ++g) { if (g == rg) off = gsum[g]; if (g == (rg & ~1)) { bS = gsum[g]; bE = gsum[g + 2]; } }
            const float b31 = gsum[4];
            const float eS = fast_exp2(bS), e2 = fast_exp2(rg >= 4 ? bS - b31 : b31 - bE);
#pragma unroll
            for (int i = 0; i < 8; ++i) {
                const int s = 8 * rg + i; const float bb = off + lf[i];
                const float qd = qv[i] * fast_exp2(bb - bS), ke = kk[i] * fast_exp2(bE - bb);
                Qd[s * 72 + k] = (bf16_t)f2bf(qd);
                Qs[s * 72 + k] = (bf16_t)f2bf(qd * eS);
                Kd[s * 72 + k] = (bf16_t)f2bf(kk[i] * fast_exp2(fminf(bS - bb, 115.f)));
                Ke[s * 72 + k] = (bf16_t)f2bf(ke);
                { const bool hi2 = rg >= 4; LAS bf16_t* T2 = hi2 ? Q2 + (s - 32) * 72 + k : K2 + s * 72 + k;
                  *T2 = (bf16_t)f2bf((hi2 ? qd : ke) * e2); }
            }
            *(LAS u32x4*)(VT + k * 72 + 8 * rg) = vpk;
            __syncthreads();
            {
                const int I = wave >> 1;
#pragma unroll
                for (int jj = 0; jj < 2; ++jj) {
                    const int J = 2 * (wave & 1) + jj;
                    f32x4 acc = (f32x4){0.f, 0.f, 0.f, 0.f};
                    if (J <= I) {
                        const LAS bf16_t* Ap; const LAS bf16_t* Bp;
                        if (J == I) { Ap = Qd + (16 * I + r16) * 72; Bp = Kd + (16 * J + r16) * 72; }
                        else if ((I >> 1) == (J >> 1)) { Ap = Qd + (16 * I + r16) * 72; Bp = Ke + (16 * J + r16) * 72; }
                        else { Ap = Q2 + (16 * (I - 2) + r16) * 72; Bp = K2 + (16 * J + r16) * 72; }
#pragma unroll
                        for (int ks = 0; ks < 2; ++ks) { const bf16x8 af = *(const LAS bf16x8*)(Ap + 32 * ks + 8 * q4); const bf16x8 bfr = *(const LAS bf16x8*)(Bp + 32 * ks + 8 * q4);
                            acc = __builtin_amdgcn_mfma_f32_16x16x32_bf16(af, bfr, acc, 0, 0, 0); }
                        if (J == I) {
#pragma unroll
                            for (int j = 0; j < 4; ++j) if (r16 > 4 * q4 + j) acc[j] = 0.f;
                        }
                    }
#pragma unroll
                    for (int j = 0; j < 4; ++j) AT[(16 * I + 4 * q4 + j) * 72 + 16 * J + r16] = (bf16_t)f2bf(acc[j]);
                }
            }
            __syncthreads();
            {
                const int mi = wave >> 1;
#pragma unroll
                for (int jj = 0; jj < 2; ++jj) {
                    const int ni = 2 * (wave & 1) + jj;
                    f32x4 acc = (f32x4){0.f, 0.f, 0.f, 0.f};
#pragma unroll
                    for (int ks = 0; ks < 2; ++ks) { const bf16x8 af = *(const LAS bf16x8*)(Qs + (16 * mi + r16) * 72 + 32 * ks + 8 * q4); const bf16x8 bfr = *(const LAS bf16x8*)(ST + (16 * ni + r16) * 72 + 32 * ks + 8 * q4);
                        acc = __builtin_amdgcn_mfma_f32_16x16x32_bf16(af, bfr, acc, 0, 0, 0); }
#pragma unroll
                    for (int ks = 0; ks < 2; ++ks) { const bf16x8 af = *(const LAS bf16x8*)(AT + (16 * mi + r16) * 72 + 32 * ks + 8 * q4); const bf16x8 bfr = *(const LAS bf16x8*)(VT + (16 * ni + r16) * 72 + 32 * ks + 8 * q4);
                        acc = __builtin_amdgcn_mfma_f32_16x16x32_bf16(af, bfr, acc, 0, 0, 0); }
#pragma unroll
                    for (int j = 0; j < 4; ++j) { const int t = 16 * mi + 4 * q4 + j; const int tl = (c - c0) * 64 + (dir ? (63 - t) : t);
                        LAS float* op = oacc + tl * 64 + 16 * ni + r16;
                        if (dir == 0) *op = acc[j]; else *op += acc[j]; }
                }
            }
#pragma unroll
            for (int i = 0; i < 8; ++i) st[i] = dk * st[i] + Ln[i];
            __syncthreads();
        }
    }
#undef HG_LOADRAW

    {
        const float gn = a.in[I_BON][l * 64 + lane];
        bf16_t* mix = (bf16_t*)(ws + WS_MIX);
        for (int rb = 0; rb < 32; rb += 8) {
            unsigned short gv[8];
#pragma unroll
            for (int r = 0; r < 8; ++r) gv[r] = proj[((size_t)b * SEQ + c0 * 64 + 32 * wave + rb + r) * INW + C_BG + hh * 64 + lane];
#pragma unroll
            for (int r = 0; r < 8; ++r) {
                const int tl = 32 * wave + rb + r;
                const size_t row = (size_t)b * SEQ + c0 * 64 + tl;
                const float o = oacc[tl * 64 + lane];
                const float ss = wave_sum(o * o);
                mix[row * DM + 384 + hh * 64 + lane] = (bf16_t)f2bf(o * rsqrtf(ss * (1.f / 64) + EPS) * gn * silu_f(bf2f(gv[r])));
            }
        }
    }
    __syncthreads();
}

__device__ __forceinline__ void phase_mixers(const Args& a, lds_u8* lds, int l, int vcu, int G, const int tid) {
    unsigned char* ws = a.ws;
    const bf16_t* proj = (const bf16_t*)(ws + WS_PROJ); const bf16_t* vt = (const bf16_t*)(ws + WS_VT); bf16_t* mix = (bf16_t*)(ws + WS_MIX);
    const float* rope = (const float*)(ws + WS_ROPE);
    for (int rp = 0; rp < ((PROBE_DUP & 256) ? 2 : 1); ++rp)
    for (int it = vcu; it < NB * 4 * 8; it += G) hgrn_out_item(a, lds, l, it, tid);
    const bf16_t* po_far = (const bf16_t*)(ws + WS_PO); const float* pl_far = (const float*)(ws + WS_PL);
    for (int u = vcu; u < 768; u += G) {
        const int mixer = u / 384, r = u % 384, b = r / 48, rr = r % 48, kvh = rr / 24, r3 = rr % 24, hq = r3 / 8, qblk = r3 % 8;
        const int h = kvh * 3 + hq;
        if (mixer == 0) attn_unit<false>(lds, proj, vt, mix, nullptr, nullptr, a.in[I_AQN] + l * 64, a.in[I_AKN] + l * 64, rope, b, h, qblk, C_AQ, C_AK, 0, 0, tid);
        else attn_unit<true>(lds, proj, vt, mix, po_far, pl_far, a.in[I_CQN] + l * 64, a.in[I_CKN] + l * 64, rope, b, h, qblk, C_CQ, C_CK, 2, 640, tid);
    }
}

__device__ __forceinline__ void phase_mixc(const Args& a, lds_u8* lds, int l, int vcu, int G, const int tid) {
    unsigned char* ws = a.ws;
    const bf16_t* proj = (const bf16_t*)(ws + WS_PROJ);
    bf16_t* po = (bf16_t*)(ws + WS_PO); float* pl = (float*)(ws + WS_PL);
    for (int u = vcu; u < 256; u += G) {
        const int b = u >> 5, kvh = (u >> 4) & 1, rho = u & 15;
        attn_r16_unit(lds, proj, po, pl, a.in[I_CQN] + l * 64, a.in[I_CKN] + l * 64, b, kvh, rho, tid);
    }
}

#define XB_TMO      128
#define XB_XCNT(j)  (256  + 64 * (j))
#define XB_XSUB(j)  (1280 + 64 * (j))
#define XB_XGEN(j)  (2304 + 64 * (j))
#define XB_TOP      3328
#define XB_TOPGEN   3392
#define XCD_BAR_WORDS 3456
#define XB_SPIN_CAP (1u << 18)
__device__ __forceinline__ unsigned xb_ld(unsigned* p)              { return __hip_atomic_load(p, __ATOMIC_RELAXED, __HIP_MEMORY_SCOPE_AGENT); }
__device__ __forceinline__ unsigned xb_add(unsigned* p, unsigned v) { return __hip_atomic_fetch_add(p, v, __ATOMIC_RELAXED, __HIP_MEMORY_SCOPE_AGENT); }
__device__ __forceinline__ unsigned xb_xcc_id() { return (unsigned)__builtin_amdgcn_s_getreg((3 << 11) | 20) & 0xFu; }
#define XB_SPIN(cond, bar) do { unsigned _sp = 0; while (cond) { __builtin_amdgcn_s_sleep(1); \
    if ((++_sp & 255u) == 0u) { if (xb_ld(&(bar)[XB_TMO])) break; if (_sp > XB_SPIN_CAP) { atomicAdd(&(bar)[XB_TMO], 1u); break; } } } } while (0)
struct XcdBarrier { unsigned* bar; unsigned x; volatile LAS unsigned* st; int wave; };
__device__ __forceinline__ int lane_id() { return (int)__builtin_amdgcn_mbcnt_hi(~0u, __builtin_amdgcn_mbcnt_lo(~0u, 0u)); }
__device__ __forceinline__ XcdBarrier xcd_barrier_post(unsigned* bar, volatile LAS unsigned* st, int wave) {
    XcdBarrier b; b.bar = bar; b.x = xb_xcc_id(); b.st = st; b.wave = wave;
    if (wave == 0 && lane_id() == 0) (void)xb_add(&bar[XB_XCNT(b.x)], 1u);
    return b;
}
__device__ __forceinline__ void xcd_barrier_complete(unsigned* bar, unsigned x, unsigned& nloc, unsigned& nx) {
    const unsigned G = gridDim.x * gridDim.y * gridDim.z;
    unsigned sum, cnt, mine, sp = 0u;
    for (;;) {
        sum = 0u; cnt = 0u; mine = 0u;
#pragma unroll
        for (unsigned j = 0; j < 16; ++j) { const unsigned c = xb_ld(&bar[XB_XCNT(j)]); sum += c; cnt += (c > 0u) ? 1u : 0u; mine = (j == x) ? c : mine; }
        if (sum == G) break;
        __builtin_amdgcn_s_sleep(1);
        if ((++sp & 255u) == 0u) { if (xb_ld(&bar[XB_TMO])) break; if (sp > XB_SPIN_CAP) { atomicAdd(&bar[XB_TMO], 1u); break; } }
    }
    nloc = mine > 0u ? mine : 1u; nx = cnt > 0u ? cnt : 1u;
}
__device__ __forceinline__ void xcd_barrier(const XcdBarrier& b) {
    asm volatile("s_waitcnt vmcnt(0)" ::: "memory");
    __syncthreads();
    if (b.wave == 0 && lane_id() == 0) {
        unsigned* bar = b.bar;
        __builtin_amdgcn_s_waitcnt(0);
        asm volatile("buffer_inv sc1" ::: "memory");
        unsigned nloc = b.st[0], nx = b.st[1];
        if (nloc == 0u) { xcd_barrier_complete(bar, b.x, nloc, nx); b.st[0] = nloc; b.st[1] = nx; }
        const unsigned old = xb_add(&bar[XB_XSUB(b.x)], 1u);
        const unsigned gen = old / nloc;
        if (old + 1u == (gen + 1u) * nloc) {
            __builtin_amdgcn_fence(__ATOMIC_RELEASE, "agent");
            asm volatile("s_waitcnt vmcnt(0)" ::: "memory");
            const unsigned og = xb_add(&bar[XB_TOP], 1u);
            const unsigned tg = og / nx;
            if (og + 1u == (tg + 1u) * nx) xb_add(&bar[XB_TOPGEN], 1u);
            else XB_SPIN(xb_ld(&bar[XB_TOPGEN]) == tg, bar);
            xb_add(&bar[XB_XGEN(b.x)], 1u);
            asm volatile("s_waitcnt vmcnt(0)" ::: "memory");
        } else {
            XB_SPIN(xb_ld(&bar[XB_XGEN(b.x)]) == gen, bar);
            asm volatile("s_waitcnt vmcnt(0)" ::: "memory");
        }
    }
    __syncthreads();
}
__device__ __forceinline__ void panel_norm(unsigned* cnt, const bf16_t* x, const float* g, const float* mod_l, int which_sh, bf16_t* h, int pm, int pn, const int tid) {
    asm volatile("s_waitcnt vmcnt(0)" ::: "memory");
    __syncthreads();
    if (tid == 0) {
        __builtin_amdgcn_fence(__ATOMIC_RELEASE, "agent");
        asm volatile("s_waitcnt vmcnt(0)" ::: "memory");
        (void)xb_add(cnt, 1u);
        unsigned sp = 0u;
        while (xb_ld(cnt) < 4u) { __builtin_amdgcn_s_sleep(1); if (++sp > (1u << 22)) break; }
        __builtin_amdgcn_fence(__ATOMIC_ACQUIRE, "agent");
        asm volatile("s_waitcnt vmcnt(0)" ::: "memory");
    }
    __syncthreads();
    const int lane = tid & 63, wave = tid >> 6;
    for (int r = 0; r < 8; r += 4) norm_rows4_bf(x, g, mod_l, which_sh, h, pm * 256 + pn * 64 + wave * 8 + r, lane);
}
constexpr int MISC_OFF = LDS_BYTES - 64;

constexpr int NPHASES = 2 + 9 * DEPTH - 1;

typedef const Args __attribute__((address_space(4))) KArgs;
template <int KMASK> __global__ void __launch_bounds__(NTHREADS, 2) fwd_kernel_t(Args a0) {
    extern __shared__ __attribute__((aligned(16))) unsigned char lds_raw[];
    lds_u8* lds = (lds_u8*)lds_raw;
    const int G = gridDim.x;
    unsigned char* ws = a0.ws;
    const int ph_lo = a0.ph_lo, ph_hi = a0.ph_hi;
    const float* mod = (const float*)(ws + WS_MOD);
    const int wave_s = __builtin_amdgcn_readfirstlane((int)(threadIdx.x >> 6));
    if (wave_s == 0 && lane_id() < 16) ((LAS unsigned*)(lds + MISC_OFF))[lane_id()] = 0u;
    __syncthreads();
    XcdBarrier bar = xcd_barrier_post((unsigned*)(ws + WS_CTL) + 4096, (volatile LAS unsigned*)(lds + MISC_OFF), wave_s);
    const bool fuse_norm = MK_ONE_LAUNCH && !PROBE_DUP && (G == 256);
    for (int ph = ph_lo; ph < ph_hi; ++ph) {
        KArgs* kap = (KArgs*)__builtin_amdgcn_kernarg_segment_ptr(); asm volatile("" : "+s"(kap));
        Args a;
#pragma unroll
        for (int i_ = 0; i_ < 17; ++i_) a.in[i_] = kap->in[i_];
        a.out = kap->out; a.ws = kap->ws; a.ph_lo = ph_lo; a.ph_hi = ph_hi;
        if (fuse_norm && ph >= 2 && ((ph - 2) % 9 == 5 || (ph - 2) % 9 == 8)) continue;
        int kbit = 0;
        if (PROBE_DUP) { if (ph == 0) kbit = 1; else if (ph == 1) kbit = 2; else { const int s_ = (ph - 2) % 9; kbit = s_ == 0 ? 4 : (s_ == 4 || s_ == 7) ? 8 : s_ == 1 ? 16 : s_ == 3 ? 32 : s_ == 6 ? 64 : s_ == 2 ? 128 : 2; } }
        const int nrep = (PROBE_DUP & kbit) ? 2 : 1;
        for (int rep = 0; rep < nrep; ++rep) {
        const bool dry = (rep + 1 < nrep); if (rep) __syncthreads();
        int tid = threadIdx.x; asm volatile("" : "+v"(tid));
        int bx = blockIdx.x; asm volatile("" : "+s"(bx));
        const int vcu = (G % 8 == 0) ? (bx % 8) * (G / 8) + bx / 8 : bx;
        if (ph == 0) { if (KMASK & 1) phase_prologue(a, lds, vcu, G, tid, bx); }
        else if (ph == 1) { if (KMASK & 2) phase_norm(a.in[I_X], a.in[I_NORMG], mod, 0, (bf16_t*)(ws + WS_H), vcu, G, tid); }
        else {
            const int l = (ph - 2) / 9, s = (ph - 2) % 9;
            const float* mod_l = mod + (size_t)l * 8 * 6144;
            if ((KMASK & 4) && s == 0) {
                const pg8::Gemm g{(const bf16_t*)(ws + WS_H), (const bf16_t*)(ws + WS_WIN) + (size_t)l * INW * DM, M, INW, DM}; const pg8::EpiStore E{(bf16_t*)(ws + WS_PROJ), INW};
                pg8::StaticOrder S; S.init(g.M, g.N, G, bx);
                pg8::gemm_phase<pg8::EpiStore, pg8::StaticOrder>(lds, g, S, E, tid);
            } else if ((KMASK & 64) && s == 6) {
                const pg8::Gemm g{(const bf16_t*)(ws + WS_H), (const bf16_t*)(ws + WS_WUP) + (size_t)l * UPW * DM, M, UPW, DM};
                const pg8::EpiConvGate E{(bf16_t*)(ws + WS_ACT), a.in[I_CONVW] + (size_t)l * 3 * UPW, a.in[I_CONVB] + (size_t)l * UPW};
                pg8::StaticOrder S; S.init(g.M, g.N, G, bx, 1);
                pg8::gemm_phase<pg8::EpiConvGate, pg8::StaticOrder>(lds, g, S, E, tid);
            } else if ((KMASK & 8) && (s == 4 || s == 7)) {
                pg8::Gemm g; pg8::EpiResid E;
                const bool nfuse = fuse_norm && !dry && !(s == 7 && l == DEPTH - 1);
                if (s == 4) { g = pg8::Gemm{(const bf16_t*)(ws + WS_MIX), (const bf16_t*)(ws + WS_WOUT) + (size_t)l * DM * DM, M, DM, DM};
                    E = pg8::EpiResid{ws, l == 0 ? a.in[I_X] : nullptr, nullptr, a.in[I_NORMG], l, 0, nfuse ? 1 : 0}; }
                else { g = pg8::Gemm{(const bf16_t*)(ws + WS_ACT), (const bf16_t*)(ws + WS_WDN) + (size_t)l * DM * FF, M, DM, FF};
                    E = pg8::EpiResid{ws, nullptr, (l == DEPTH - 1) ? a.out : nullptr, a.in[I_NORMG], l, 1, nfuse ? 1 : 0}; }
                pg8::StaticOrder S; S.init(g.M, g.N, G, bx);
                pg8::gemm_phase<pg8::EpiResid, pg8::StaticOrder>(lds, g, S, E, tid);
            } else if ((KMASK & 16) && s == 1) phase_prep(a, lds, l, vcu, G, tid, dry);
            else if ((KMASK & 16) && s == 2) { phase_scan(a, vcu, G, tid); phase_mixc(a, lds, l, vcu, G, tid); }
            else if ((KMASK & 32) && s == 3) phase_mixers(a, lds, l, vcu, G, tid);
            else if ((KMASK & 2) && s == 5) phase_norm_bf((const bf16_t*)(ws + WS_XB), a.in[I_NORMG] + (size_t)(l * 2 + 1) * DM, mod_l, 3, (bf16_t*)(ws + WS_H), vcu, G, tid);
            else if ((KMASK & 2) && s == 8) phase_norm_bf((const bf16_t*)(ws + WS_XB), a.in[I_NORMG] + (size_t)((l + 1) * 2) * DM, mod_l + 8 * 6144, 0, (bf16_t*)(ws + WS_H), vcu, G, tid);
        }
        }
        if (ph + 1 < ph_hi) xcd_barrier(bar);
    }
}

typedef void (*kern_t)(Args);
static int phase_kind(int ph) { if (ph == 0) return 0; if (ph == 1) return 1; const int s = (ph - 2) % 9; return s == 0 ? 2 : s == 4 || s == 7 ? 3 : s == 1 || s == 2 ? 4 : s == 3 ? 5 : s == 6 ? 6 : 1; }
extern "C" void kernel_launch(void* const* d_in, const int* in_sizes, int n_in, void* d_out, int out_size, void* d_ws, size_t ws_size, hipStream_t stream) {
    static int grid = 0;
#if MK_ONE_LAUNCH
    static const kern_t kerns[1] = {fwd_kernel_t<127>}; constexpr int NK = 1;
#else
    static const kern_t kerns[7] = {fwd_kernel_t<1>, fwd_kernel_t<2>, fwd_kernel_t<4>, fwd_kernel_t<8>, fwd_kernel_t<16>, fwd_kernel_t<32>, fwd_kernel_t<64>}; constexpr int NK = 7;
#endif
    if (grid == 0) {
        if (n_in != 17 || out_size != M * DM || ws_size < WS_END) { fprintf(stderr, "kernel_launch: unexpected shapes (n_in %d, out %d, ws %zu)\n", n_in, out_size, ws_size); grid = -1; return; }
        int dev = 0, cus = 0;
        if (hipGetDevice(&dev) != hipSuccess || hipDeviceGetAttribute(&cus, hipDeviceAttributeMultiprocessorCount, dev) != hipSuccess) { grid = -1; return; }
        for (int i = 0; i < NK; ++i)
            if (hipFuncSetAttribute((const void*)kerns[i], hipFuncAttributeMaxDynamicSharedMemorySize, LDS_BYTES) != hipSuccess) { fprintf(stderr, "kernel_launch: hipFuncSetAttribute failed\n"); grid = -1; return; }
        int per_cu = 0;
        if (hipOccupancyMaxActiveBlocksPerMultiprocessor(&per_cu, (const void*)kerns[0], NTHREADS, LDS_BYTES) != hipSuccess || per_cu < 1) { fprintf(stderr, "kernel_launch: occupancy query says %d\n", per_cu); (void)hipGetLastError(); }
        grid = cus;
    }
    if (grid < 0) return;
    Args a{};
    for (int i = 0; i < 17; ++i) a.in[i] = (const float*)d_in[i];
    a.out = (float*)d_out; a.ws = (unsigned char*)d_ws;
#if MK_ONE_LAUNCH
    if (hipMemsetAsync((char*)d_ws + WS_CTL, 0, 65536, stream) != hipSuccess) { fprintf(stderr, "kernel_launch: memset failed\n"); return; }
    a.ph_lo = 0; a.ph_hi = NPHASES;
    void* args[] = {&a};
    hipError_t e = hipLaunchCooperativeKernel((const void*)kerns[0], dim3(grid), dim3(NTHREADS), args, LDS_BYTES, stream);
    if (e != hipSuccess) fprintf(stderr, "cooperative launch failed: %s (grid %d)\n", hipGetErrorString(e), grid);
#else
    for (int ph = 0; ph < NPHASES; ++ph) {
        a.ph_lo = ph; a.ph_hi = ph + 1;
        hipLaunchKernelGGL(kerns[phase_kind(ph)], dim3(grid), dim3(NTHREADS), LDS_BYTES, stream, a);
    }
#endif
}
```
